# Optimizing an MI355X kernel written in HIP

```python
import math
import jax
import jax.numpy as jnp
from jax import lax
import numpy as np

D_MODEL = 1024
BATCH = 2
SEQ = 8192
DEPTH = 2

CTX_LEN = 256
GRID_W = 64
D_MIX = D_MODEL
MLA_HEADS = 4
MLA_W = D_MIX // 2
MLA_DV = MLA_W // MLA_HEADS
MLA_NOPE = 128
MLA_ROPE = 64
Q_LORA = 384
KV_LORA = 256
DIFF_HEADS = 4
DIFF_W = D_MIX // 4
DIFF_DV = DIFF_W // DIFF_HEADS
DIFF_DQK = DIFF_DV // 2
CHUNK_W = D_MIX - MLA_W - DIFF_W
CHUNK_GROUPS = 4
CHUNK_GW = CHUNK_W // CHUNK_GROUPS
CHUNK = 128
D_FF = 2816
CONV_W = 3
Q_BLOCK = 128
ROPE_BASE = 10000.0
EPS = 1e-6
DN_ALPHA = (2 * DEPTH) ** 0.25
DN_BETA = (8 * DEPTH) ** -0.25
MLA_SCALE = (MLA_NOPE + MLA_ROPE) ** -0.5
DIFF_SCALE = DIFF_DQK ** -0.5
IN_SPLITS = [Q_LORA,
             Q_LORA + KV_LORA,
             Q_LORA + KV_LORA + MLA_ROPE,
             Q_LORA + KV_LORA + MLA_ROPE + DIFF_W,
             Q_LORA + KV_LORA + MLA_ROPE + 2 * DIFF_W,
             Q_LORA + KV_LORA + MLA_ROPE + 3 * DIFF_W]
IN_W = Q_LORA + KV_LORA + MLA_ROPE + 3 * DIFF_W + 2 * CHUNK_W

kernel_name = "hymba_mla_diff_chunkmlp_convffn_deepnorm_dit"

PARAM_NAMES = ["ada_w", "ada_b", "w_in", "mla_gq", "mla_wuq", "mla_gkv", "mla_wukv",
               "diff_lq1", "diff_lk1", "diff_lq2", "diff_lk2", "diff_subln_g",
               "sgu_ln_g", "sgu_ln_b", "sgu_ws", "sgu_bs", "w_o", "ln1_g", "ln1_b",
               "ffn_wup", "ffn_convw", "ffn_convb", "ffn_wdown", "ln2_g", "ln2_b"]


def layer_norm(x, g, b):
    xf = x.astype(jnp.float32)
    mu = jnp.mean(xf, -1, keepdims=True)
    var = jnp.mean(jnp.square(xf - mu), -1, keepdims=True)
    return ((xf - mu) * lax.rsqrt(var + EPS)).astype(x.dtype) * g + b


def rms_norm(x, g):
    xf = x.astype(jnp.float32)
    return (xf * lax.rsqrt(jnp.mean(xf * xf, -1, keepdims=True) + EPS)).astype(x.dtype) * g


def rope_1d(x, pos):
    n = x.shape[-1] // 2
    inv = ROPE_BASE ** (-jnp.arange(n, dtype=jnp.float32) / n)
    ang = pos.astype(jnp.float32)[:, None] * inv[None, :]
    cos = jnp.cos(ang)[None, :, None, :].astype(x.dtype)
    sin = jnp.sin(ang)[None, :, None, :].astype(x.dtype)
    x1, x2 = x[..., :n], x[..., n:]
    return jnp.concatenate([x1 * cos - x2 * sin, x2 * cos + x1 * sin], -1)


def axial_rope(x, rows, cols):
    half = x.shape[-1] // 2
    return jnp.concatenate([rope_1d(x[..., :half], rows), rope_1d(x[..., half:], cols)], -1)


def attention(q, k, v, scale):
    B, Sq, H, Dk = q.shape
    Dv = v.shape[-1]
    nblk = Sq // Q_BLOCK
    qb = jnp.moveaxis(q.reshape(B, nblk, Q_BLOCK, H, Dk), 1, 0)

    def one_block(qblk):
        s = jnp.einsum('bqhd,bkhd->bhqk', qblk, k).astype(jnp.float32) * scale
        p = jax.nn.softmax(s, axis=-1).astype(v.dtype)
        return jnp.einsum('bhqk,bkhd->bqhd', p, v)

    o = lax.map(one_block, qb)
    return jnp.moveaxis(o, 0, 1).reshape(B, Sq, H, Dv)


def project_stream(z, p, rows, cols):
    B, S, _ = z.shape
    if rows is None:
        rot = lambda t: t
    else:
        rot = lambda t: axial_rope(t, rows, cols)
    q_lat, kv_lat, k_r, dq, dk, dv, zch = jnp.split(z, IN_SPLITS, axis=-1)
    qm = (rms_norm(q_lat, p["mla_gq"]) @ p["mla_wuq"]).reshape(B, S, MLA_HEADS, MLA_NOPE + MLA_ROPE)
    qm = jnp.concatenate([qm[..., :MLA_NOPE], rot(qm[..., MLA_NOPE:])], -1)
    kvm = (rms_norm(kv_lat, p["mla_gkv"]) @ p["mla_wukv"]).reshape(B, S, MLA_HEADS, MLA_NOPE + MLA_DV)
    kr = rot(k_r[:, :, None, :])
    km = jnp.concatenate([kvm[..., :MLA_NOPE], jnp.broadcast_to(kr, (B, S, MLA_HEADS, MLA_ROPE))], -1)
    vm = kvm[..., MLA_NOPE:]

    def two_maps(t):
        t = t.reshape(B, S, DIFF_HEADS, 2, DIFF_DQK)
        return rot(jnp.swapaxes(t, 2, 3).reshape(B, S, 2 * DIFF_HEADS, DIFF_DQK))

    qd = two_maps(dq)
    kd = two_maps(dk)
    vd = jnp.tile(dv.reshape(B, S, DIFF_HEADS, DIFF_DV), (1, 1, 2, 1))
    return qm, km, vm, qd, kd, vd, zch


def chunk_mix(z, p):
    z = jax.nn.gelu(z)
    u, v = jnp.split(z, 2, axis=-1)
    v = layer_norm(v, p["sgu_ln_g"], p["sgu_ln_b"])
    B, S, _ = v.shape
    vg = v.reshape(B, S // CHUNK, CHUNK, CHUNK_GROUPS, CHUNK_GW)
    mixed = jnp.einsum('gpq,bnqgc->bnpgc', p["sgu_ws"], vg) + p["sgu_bs"].T[None, None, :, :, None]
    return u * mixed.reshape(B, S, CHUNK_W)


def mixer(h, hc, rows, cols, p, layer_idx, need_ctx):
    qm, km, vm, qd, kd, vd, zch = project_stream(h @ p["w_in"], p, rows, cols)
    qmc, kmc, vmc, qdc, kdc, vdc, zchc = project_stream(hc @ p["w_in"], p, None, None)
    lam_init = 0.8 - 0.6 * math.exp(-0.3 * layer_idx)
    lam = (jnp.exp(jnp.sum(p["diff_lq1"] * p["diff_lk1"]))
           - jnp.exp(jnp.sum(p["diff_lq2"] * p["diff_lk2"])) + lam_init)

    def merge(o_m, o_d, z_c):
        Bn, Sn = o_m.shape[:2]
        d = o_d[:, :, :DIFF_HEADS] - lam * o_d[:, :, DIFF_HEADS:]
        d = rms_norm(d, p["diff_subln_g"]) * (1.0 - lam_init)
        y = jnp.concatenate([o_m.reshape(Bn, Sn, MLA_W), d.reshape(Bn, Sn, DIFF_W), chunk_mix(z_c, p)], -1)
        return y @ p["w_o"]

    o_m = attention(qm, jnp.concatenate([kmc, km], 1), jnp.concatenate([vmc, vm], 1), MLA_SCALE)
    o_d = attention(qd, jnp.concatenate([kdc, kd], 1), jnp.concatenate([vdc, vd], 1), DIFF_SCALE)
    y = merge(o_m, o_d, zch)
    yc = None
    if need_ctx:
        yc = merge(attention(qmc, kmc, vmc, MLA_SCALE), attention(qdc, kdc, vdc, DIFF_SCALE), zchc)
    return y, yc


def dwconv3(h, w, b):
    hp = jnp.pad(h, ((0, 0), (1, 1), (0, 0)))
    return hp[:, :-2] * w[0] + hp[:, 1:-1] * w[1] + hp[:, 2:] * w[2] + b


def conv_ffn(h, p):
    u = dwconv3(h @ p["ffn_wup"], p["ffn_convw"], p["ffn_convb"])
    gate, val = jnp.split(u, 2, axis=-1)
    return (jax.nn.silu(gate) * val) @ p["ffn_wdown"]


def layer(x, xc, mod, modc, rows, cols, p, layer_idx, need_ctx):
    sh1, sc1, g1, sh2, sc2, g2 = jnp.split(mod, 6, axis=-1)
    csh1, csc1, cg1, csh2, csc2, cg2 = jnp.split(modc, 6, axis=-1)
    y, yc = mixer(x * (1.0 + sc1) + sh1, xc * (1.0 + csc1) + csh1, rows, cols, p, layer_idx, need_ctx)
    x = layer_norm(DN_ALPHA * x + g1 * y, p["ln1_g"], p["ln1_b"])
    x = layer_norm(DN_ALPHA * x + g2 * conv_ffn(x * (1.0 + sc2) + sh2, p), p["ln2_g"], p["ln2_b"])
    if need_ctx:
        xc = layer_norm(DN_ALPHA * xc + cg1 * yc, p["ln1_g"], p["ln1_b"])
        xc = layer_norm(DN_ALPHA * xc + cg2 * conv_ffn(xc * (1.0 + csc2) + csh2, p), p["ln2_g"], p["ln2_b"])
    return x, xc


def setup_inputs(seed: int = 0) -> dict:
    key = jax.random.key(seed)
    ks = iter(jax.random.split(key, 40))
    f32 = jnp.float32
    nrm = lambda shape, s: jax.random.normal(next(ks), shape, f32) * s
    gain = lambda shape: 1.0 + nrm(shape, 0.02)
    L = DEPTH
    return {
        "x": nrm((BATCH, SEQ, D_MODEL), 1.0),
        "c": nrm((BATCH, D_MODEL), 1.0),
        "ctx": nrm((BATCH, CTX_LEN, D_MODEL), 1.0),
        "c_ctx": nrm((D_MODEL,), 1.0),
        "ada_w": nrm((L, D_MODEL, 6 * D_MODEL), 0.5 * D_MODEL ** -0.5),
        "ada_b": nrm((L, 6 * D_MODEL), 0.02),
        "w_in": nrm((L, D_MODEL, IN_W), D_MODEL ** -0.5),
        "mla_gq": gain((L, Q_LORA)),
        "mla_wuq": nrm((L, Q_LORA, MLA_HEADS * (MLA_NOPE + MLA_ROPE)), Q_LORA ** -0.5),
        "mla_gkv": gain((L, KV_LORA)),
        "mla_wukv": nrm((L, KV_LORA, MLA_HEADS * (MLA_NOPE + MLA_DV)), KV_LORA ** -0.5),
        "diff_lq1": nrm((L, DIFF_DQK), 0.1),
        "diff_lk1": nrm((L, DIFF_DQK), 0.1),
        "diff_lq2": nrm((L, DIFF_DQK), 0.1),
        "diff_lk2": nrm((L, DIFF_DQK), 0.1),
        "diff_subln_g": gain((L, DIFF_DV)),
        "sgu_ln_g": gain((L, CHUNK_W)),
        "sgu_ln_b": nrm((L, CHUNK_W), 0.02),
        "sgu_ws": nrm((L, CHUNK_GROUPS, CHUNK, CHUNK), CHUNK ** -0.5),
        "sgu_bs": gain((L, CHUNK_GROUPS, CHUNK)),
        "w_o": nrm((L, D_MIX, D_MODEL), DN_BETA * D_MIX ** -0.5),
        "ln1_g": gain((L, D_MODEL)),
        "ln1_b": nrm((L, D_MODEL), 0.02),
        "ffn_wup": nrm((L, D_MODEL, 2 * D_FF), D_MODEL ** -0.5),
        "ffn_convw": nrm((L, CONV_W, 2 * D_FF), CONV_W ** -0.5),
        "ffn_convb": nrm((L, 2 * D_FF), 0.01),
        "ffn_wdown": nrm((L, D_FF, D_MODEL), DN_BETA * D_FF ** -0.5),
        "ln2_g": gain((L, D_MODEL)),
        "ln2_b": nrm((L, D_MODEL), 0.02),
    }


def reference(x, c, ctx, c_ctx, ada_w, ada_b, w_in, mla_gq, mla_wuq, mla_gkv, mla_wukv,
              diff_lq1, diff_lk1, diff_lq2, diff_lk2, diff_subln_g, sgu_ln_g, sgu_ln_b, sgu_ws, sgu_bs,
              w_o, ln1_g, ln1_b, ffn_wup, ffn_convw, ffn_convb, ffn_wdown, ln2_g, ln2_b):
    S = x.shape[1]
    ROWS = S // GRID_W
    rows = jnp.repeat(jnp.arange(ROWS, dtype=jnp.int32), GRID_W)
    cols = jnp.tile(jnp.arange(GRID_W, dtype=jnp.int32), ROWS)
    stacked = [ada_w, ada_b, w_in, mla_gq, mla_wuq, mla_gkv, mla_wukv,
               diff_lq1, diff_lk1, diff_lq2, diff_lk2, diff_subln_g,
               sgu_ln_g, sgu_ln_b, sgu_ws, sgu_bs, w_o, ln1_g, ln1_b,
               ffn_wup, ffn_convw, ffn_convb, ffn_wdown, ln2_g, ln2_b]
    s_c = jax.nn.silu(c)
    s_cc = jax.nn.silu(c_ctx)
    xc = ctx
    for l in range(DEPTH):
        p = {name: arr[l] for name, arr in zip(PARAM_NAMES, stacked)}
        mod = (s_c @ p["ada_w"] + p["ada_b"])[:, None, :]
        modc = (s_cc @ p["ada_w"] + p["ada_b"])[None, None, :]
        x, xc = layer(x, xc, mod, modc, rows, cols, p, l, l < DEPTH - 1)
    return x
```

```cpp
#include <hip/hip_runtime.h>
#include <hip/hip_cooperative_groups.h>
#include <stdint.h>
#include <cstdio>
namespace cg = cooperative_groups;

typedef unsigned short bf16_t;
typedef short bf16x8 __attribute__((ext_vector_type(8)));
typedef float f32x16 __attribute__((ext_vector_type(16)));
typedef float f32x4 __attribute__((ext_vector_type(4)));
typedef float f32x2 __attribute__((ext_vector_type(2)));
typedef unsigned u32x4 __attribute__((ext_vector_type(4)));
typedef unsigned u32x2 __attribute__((ext_vector_type(2)));

constexpr int DM = 1024, NBATCH = 2, SEQ = 8192, CTX = 256, SB = SEQ + CTX  , T = NBATCH * SB  ;
constexpr int INW = 1984, DFF = 2816, NLAYER = 2;
constexpr int KP = 1088;
constexpr float EPS = 1e-6f;
constexpr float DN_ALPHA = 1.4142135623730951f;
constexpr float LOG2E = 1.4426950408889634f;
constexpr float QS_MLA = 0.07216878364870322f * LOG2E;
constexpr float QS_DIFF = 0.17677669529663687f * LOG2E;

constexpr size_t al256(size_t x) { return (x + 255) / 256 * 256; }
constexpr size_t W_IN = 0;
constexpr size_t W_UQ = W_IN + 2048ull * KP;
constexpr size_t W_UKV = W_UQ + 768ull * 384;
constexpr size_t W_O = W_UKV + 1024ull * 256;
constexpr size_t W_UP = W_O + 1024ull * KP;
constexpr size_t W_DN = W_UP + 5632ull * KP;
constexpr size_t W_SG = W_DN + 1024ull * 2816;
constexpr size_t W_LAYER = W_SG + 4ull * 128 * 128;
constexpr size_t OFF_W = 0;
constexpr size_t OFF_MOD = al256(OFF_W + W_LAYER * 2 * NLAYER);
constexpr size_t OFF_CS16 = al256(OFF_MOD + 2ull * 3 * 6144 * 4);
constexpr size_t OFF_CS8 = al256(OFF_CS16 + 128ull * 16 * 8);
constexpr size_t OFF_CTXRES = al256(OFF_CS8 + 128ull * 8 * 8);
constexpr size_t OFF_HMOD = al256(OFF_CTXRES + 512ull * 1024 * 4);
constexpr size_t OFF_R = al256(OFF_HMOD + (size_t)T * KP * 2);
constexpr size_t OFF_ZQ = OFF_R;
constexpr size_t OFF_KR = al256(OFF_ZQ + (size_t)T * 640 * 2);
constexpr size_t OFF_QD = al256(OFF_KR + (size_t)T * 64 * 2);
constexpr size_t OFF_KD = al256(OFF_QD + (size_t)T * 256 * 2);
constexpr size_t OFF_VDT = al256(OFF_KD + (size_t)T * 256 * 2);
constexpr size_t OFF_ZC = al256(OFF_VDT + (size_t)T * 256 * 2);
constexpr size_t OFF_QM = al256(OFF_ZC + (size_t)T * 512 * 2);
constexpr size_t OFF_KM = al256(OFF_QM + (size_t)T * 768 * 2);
constexpr size_t OFF_VMT = al256(OFF_KM + (size_t)T * 512 * 2);
constexpr size_t OFF_Y = al256(OFF_VMT + (size_t)T * 512 * 2);
constexpr size_t OFF_END = al256(OFF_Y + (size_t)T * KP * 2);
constexpr size_t OFF_A2 = OFF_R;
static_assert(OFF_A2 + (size_t)T * 2816 * 2 <= OFF_END, "A2 alias fits");
constexpr size_t OFF_SSQ = OFF_END + 16384;
static_assert(OFF_SSQ + (size_t)T * 8 <= 268435456ull, "workspace fits 256 MiB");

constexpr int LDS_A_STAGE = 256 * 144, LDS_B_STAGE = 128 * 144;
constexpr int LDS_GEMM = 2 * (LDS_A_STAGE + LDS_B_STAGE);
constexpr int LDS_RSTD = 3 * 49152;
constexpr int LDS_BYTES = 3 * 49152 + 1024 + 16;

struct Params {
  const float *x, *c, *ctx, *c_ctx, *ada_w, *ada_b, *w_in, *mla_gq, *mla_wuq, *mla_gkv, *mla_wukv;
  const float *lq1, *lk1, *lq2, *lk2, *subln_g, *sgu_ln_g, *sgu_ln_b, *sgu_ws, *sgu_bs, *w_o, *ln1_g, *ln1_b;
  const float *ffn_wup, *ffn_convw, *ffn_convb, *ffn_wdown, *ln2_g, *ln2_b;
  float* out; char* ws;
};
typedef const __attribute__((address_space(4))) Params* PP;
__device__ __forceinline__ PP launder(PP q) { asm volatile("" : "+s"(q)); return q; }

__device__ __forceinline__ int get_tid() { int t = threadIdx.x; asm volatile("" : "+v"(t)); return t; }
__device__ __forceinline__ int get_bid() { int t = blockIdx.x; asm volatile("" : "+s"(t)); return t; }
typedef __bf16 bf16x2_t __attribute__((ext_vector_type(2)));
__device__ __forceinline__ unsigned cvtpk(float lo, float hi) { f32x2 v = {lo, hi}; bf16x2_t b = __builtin_convertvector(v, bf16x2_t); return __builtin_bit_cast(unsigned, b); }
__device__ __forceinline__ bf16_t f2bf(float x) { return (bf16_t)(cvtpk(x, 0.f) & 0xffffu); }
__device__ __forceinline__ float bf2f(bf16_t v) { return __uint_as_float(((unsigned)v) << 16); }
__device__ __forceinline__ float bflo(unsigned w) { return __uint_as_float(w << 16); }
__device__ __forceinline__ float bfhi(unsigned w) { return __uint_as_float(w & 0xffff0000u); }
__device__ __forceinline__ int crow(int r, int hi) { return (r & 3) + 8 * (r >> 2) + 4 * hi; }
__device__ __forceinline__ float fexp2(float x) { return __builtin_amdgcn_exp2f(x); }
__device__ __forceinline__ float silu_f(float x) { return x * __builtin_amdgcn_rcpf(1.f + __expf(-x)); }
__device__ __forceinline__ float gelu_tanh(float x) {
  const float u = 0.7978845608028654f * (x + 0.044715f * x * x * x);
  return x * __builtin_amdgcn_rcpf(1.f + __expf(-2.f * u));
}
__device__ __forceinline__ float* xrow(PP pp, int t) {
  const int b = t / SB, j = t - b * SB;
  return j < CTX ? (float*)(pp->ws + OFF_CTXRES) + (size_t)(b * CTX + j) * DM : pp->out + (size_t)(b * SEQ + j - CTX) * DM;
}

constexpr int G_STAGE = 256 * 128 + 128 * 128;
template <class RowMap, class Epi>
__device__ __forceinline__ void gemm_tile(const bf16_t* __restrict__ A, int lda, RowMap rowmap, const bf16_t* __restrict__ Bt, int ldb, int col0, int K,
                                          char* lds, Epi epi) {
  const int tid = get_tid(), lane = tid & 63, wid = tid >> 6, wm = wid >> 1, wn = wid & 1, l31 = lane & 31, hi = lane >> 5;
  const int lr = tid >> 3, lc = tid & 7, kc = lc ^ ((lr >> 1) & 7);
  const bf16_t* ap0 = A + (size_t)rowmap(lr) * lda + kc * 8;
  const bf16_t* ap1 = A + (size_t)rowmap(lr + 64) * lda + kc * 8;
  const bf16_t* ap2 = A + (size_t)rowmap(lr + 128) * lda + kc * 8;
  const bf16_t* ap3 = A + (size_t)rowmap(lr + 192) * lda + kc * 8;
  const bf16_t* bp0 = Bt + (size_t)(col0 + lr) * ldb + kc * 8;
  const bf16_t* bp1 = Bt + (size_t)(col0 + lr + 64) * ldb + kc * 8;
  f32x16 acc[2][2];
#pragma unroll
  for (int i = 0; i < 2; ++i)
#pragma unroll
    for (int j = 0; j < 2; ++j)
#pragma unroll
      for (int r = 0; r < 16; ++r) acc[i][j][r] = 0.f;
#define G_DMA(gp, lp) __builtin_amdgcn_global_load_lds((const unsigned*)(gp), (__attribute__((address_space(3))) unsigned*)(lp), 16, 0, 0)
#define G_ISSUE(st, k0) do { char* sa_ = lds + (st) * G_STAGE + tid * 16; \
    G_DMA(ap0 + (k0), sa_); G_DMA(ap1 + (k0), sa_ + 8192); G_DMA(ap2 + (k0), sa_ + 16384); G_DMA(ap3 + (k0), sa_ + 24576); \
    G_DMA(bp0 + (k0), sa_ + 32768); G_DMA(bp1 + (k0), sa_ + 40960); } while (0)
  const int fsw = (l31 >> 1) & 7, g = fsw >> 1, c0 = l31 * 128 + ((hi ^ (fsw & 1)) << 4);
  const int o0 = c0 + ((0 ^ g) << 5), o1 = c0 + ((1 ^ g) << 5), o2 = c0 + ((2 ^ g) << 5), o3 = c0 + ((3 ^ g) << 5);
  const int abase = (64 * wm) * 128, bbase = 32768 + (64 * wn) * 128;
#define G_FRAG(O, A0, A1, B0, B1) do { A0 = *(const bf16x8*)(cS + abase + (O)); B0 = *(const bf16x8*)(cS + bbase + (O)); \
    A1 = *(const bf16x8*)(cS + abase + 4096 + (O)); B1 = *(const bf16x8*)(cS + bbase + 4096 + (O)); } while (0)
#define G_MMA(A0, A1, B0, B1) do { \
    acc[0][0] = __builtin_amdgcn_mfma_f32_32x32x16_bf16(A0, B0, acc[0][0], 0, 0, 0); \
    acc[0][1] = __builtin_amdgcn_mfma_f32_32x32x16_bf16(A0, B1, acc[0][1], 0, 0, 0); \
    acc[1][0] = __builtin_amdgcn_mfma_f32_32x32x16_bf16(A1, B0, acc[1][0], 0, 0, 0); \
    acc[1][1] = __builtin_amdgcn_mfma_f32_32x32x16_bf16(A1, B1, acc[1][1], 0, 0, 0); } while (0)
  const int nk = K >> 6;
  G_ISSUE(0, 0);
  if (nk > 1) G_ISSUE(1, 64);
  int st = 0, st2 = 2;
  for (int kt = 0; kt < nk; ++kt) {
    if (kt + 1 < nk) asm volatile("s_waitcnt vmcnt(6)" ::: "memory"); else asm volatile("s_waitcnt vmcnt(0)" ::: "memory");
    __builtin_amdgcn_s_barrier();
    if (kt + 2 < nk) G_ISSUE(st2, (kt + 2) * 64);
    const char* cS = lds + st * G_STAGE;
    bf16x8 pa0, pa1, pb0, pb1, qa0, qa1, qb0, qb1, ra0_, ra1_, rb0_, rb1_;
    G_FRAG(o0, pa0, pa1, pb0, pb1); G_FRAG(o1, qa0, qa1, qb0, qb1); __builtin_amdgcn_sched_barrier(0);
    G_MMA(pa0, pa1, pb0, pb1); G_FRAG(o2, ra0_, ra1_, rb0_, rb1_); __builtin_amdgcn_sched_barrier(0);
    G_MMA(qa0, qa1, qb0, qb1); G_FRAG(o3, pa0, pa1, pb0, pb1); __builtin_amdgcn_sched_barrier(0);
    G_MMA(ra0_, ra1_, rb0_, rb1_); G_MMA(pa0, pa1, pb0, pb1);
    st = st == 2 ? 0 : st + 1; st2 = st2 == 2 ? 0 : st2 + 1;
  }
#undef G_DMA
#undef G_ISSUE
#undef G_FRAG
#undef G_MMA
  __syncthreads();
  epi(acc, 64 * wm, col0 + 64 * wn);
}

template <class RowMap, class Post>
__device__ __forceinline__ void gemm_tile256b(const bf16_t* __restrict__ A, int lda, RowMap rowmap, const bf16_t* __restrict__ Bt, int ldb, int col0, int K,
                                             char* lds, Post post) {
  const int tid = get_tid(), lane = tid & 63, wid = tid >> 6, wm = wid >> 1, wn = wid & 1, l31 = lane & 31, hi = lane >> 5;
  const int lr = tid >> 3, lc = tid & 7, kc = lc ^ ((lr >> 1) & 7);
  const bf16_t* ap0 = A + (size_t)rowmap(lr) * lda + kc * 8;
  const bf16_t* ap1 = A + (size_t)rowmap(lr + 64) * lda + kc * 8;
  const bf16_t* ap2 = A + (size_t)rowmap(lr + 128) * lda + kc * 8;
  const bf16_t* ap3 = A + (size_t)rowmap(lr + 192) * lda + kc * 8;
  const bf16_t* bp0 = Bt + (size_t)(col0 + lr) * ldb + kc * 8;
  const size_t bstep = (size_t)64 * ldb;
  const int l15 = lane & 15, q4 = lane >> 4;
  f32x4 acc[4][8];
#pragma unroll
  for (int i = 0; i < 4; ++i)
#pragma unroll
    for (int j = 0; j < 8; ++j) { acc[i][j][0] = 0.f; acc[i][j][1] = 0.f; acc[i][j][2] = 0.f; acc[i][j][3] = 0.f; }
#define H_DMA(gp, lp) __builtin_amdgcn_global_load_lds((const unsigned*)(gp), (__attribute__((address_space(3))) unsigned*)(lp), 16, 0, 0)
#define H_ISSUE(st, k0) do { char* sa_ = lds + (st) * 65536 + tid * 16; \
    H_DMA(ap0 + (k0), sa_); H_DMA(ap1 + (k0), sa_ + 8192); H_DMA(ap2 + (k0), sa_ + 16384); H_DMA(ap3 + (k0), sa_ + 24576); \
    H_DMA(bp0 + (k0), sa_ + 32768); H_DMA(bp0 + bstep + (k0), sa_ + 40960); H_DMA(bp0 + 2 * bstep + (k0), sa_ + 49152); H_DMA(bp0 + 3 * bstep + (k0), sa_ + 57344); } while (0)
  const int fsw = l15 >> 1, c0 = l15 * 128;
  const int ok0 = c0 + (((0 + q4) ^ fsw) << 4), ok1 = c0 + (((4 + q4) ^ fsw) << 4);
  const int abase = (64 * wm) * 128, bbase = 32768 + (128 * wn) * 128;
#define H_FA(O, F) do { F[0] = *(const bf16x8*)(cS + abase + (O)); F[1] = *(const bf16x8*)(cS + abase + 2048 + (O)); \
    F[2] = *(const bf16x8*)(cS + abase + 4096 + (O)); F[3] = *(const bf16x8*)(cS + abase + 6144 + (O)); } while (0)
#define H_FB(O, NH, F) do { F[0] = *(const bf16x8*)(cS + bbase + (NH) * 8192 + (O)); F[1] = *(const bf16x8*)(cS + bbase + (NH) * 8192 + 2048 + (O)); \
    F[2] = *(const bf16x8*)(cS + bbase + (NH) * 8192 + 4096 + (O)); F[3] = *(const bf16x8*)(cS + bbase + (NH) * 8192 + 6144 + (O)); } while (0)
#define H_MMA(FA, FB, NH) do { _Pragma("unroll") for (int mi_ = 0; mi_ < 4; ++mi_) { _Pragma("unroll") for (int nj_ = 0; nj_ < 4; ++nj_) \
    acc[mi_][(NH) * 4 + nj_] = __builtin_amdgcn_mfma_f32_16x16x32_bf16(FA[mi_], FB[nj_], acc[mi_][(NH) * 4 + nj_], 0, 0, 0); } } while (0)
  const int nk = K >> 6;
  H_ISSUE(0, 0);
  for (int kt = 0; kt < nk; ++kt) {
    asm volatile("s_waitcnt vmcnt(0)" ::: "memory");
    __builtin_amdgcn_s_barrier();
    if (kt + 1 < nk) H_ISSUE((kt + 1) & 1, (kt + 1) * 64);
    const char* cS = lds + (kt & 1) * 65536;
    bf16x8 fa0[4], fb0[4];
    H_FA(ok0, fa0); H_FB(ok0, 0, fb0); __builtin_amdgcn_sched_barrier(0);
    H_MMA(fa0, fb0, 0); __builtin_amdgcn_sched_barrier(0);
    H_FB(ok0, 1, fb0); __builtin_amdgcn_sched_barrier(0);
    H_MMA(fa0, fb0, 1); __builtin_amdgcn_sched_barrier(0);
    H_FA(ok1, fa0); H_FB(ok1, 0, fb0); __builtin_amdgcn_sched_barrier(0);
    H_MMA(fa0, fb0, 0); __builtin_amdgcn_sched_barrier(0);
    H_FB(ok1, 1, fb0); __builtin_amdgcn_sched_barrier(0);
    H_MMA(fa0, fb0, 1);
  }
#undef H_DMA
#undef H_ISSUE
#undef H_FA
#undef H_FB
#undef H_MMA
  float* ut = (float*)lds;
#pragma unroll
  for (int h = 0; h < 2; ++h) {
    __syncthreads();
    if (wn == h) {
#pragma unroll
      for (int mi = 0; mi < 4; ++mi)
#pragma unroll
        for (int ni = 0; ni < 8; ++ni)
#pragma unroll
          for (int r = 0; r < 4; ++r) ut[(64 * wm + 16 * mi + 4 * q4 + r) * 128 + 16 * ni + l15] = acc[mi][ni][r];
    }
    __syncthreads();
    post(h);
  }
  __syncthreads();
}

template <class RowMap, class Post>
__device__ __forceinline__ void gemm_tile256(const bf16_t* __restrict__ A, int lda, RowMap rowmap, const bf16_t* __restrict__ Bt, int ldb, int col0, int K,
                                             char* lds, Post post) {
  const int tid = get_tid(), lane = tid & 63, wid = tid >> 6, wm = wid >> 1, wn = wid & 1, l31 = lane & 31, hi = lane >> 5;
  const int lr = tid >> 3, lc = tid & 7, kc = lc ^ ((lr >> 1) & 7);
  const bf16_t* ap0 = A + (size_t)rowmap(lr) * lda + kc * 8;
  const bf16_t* ap1 = A + (size_t)rowmap(lr + 64) * lda + kc * 8;
  const bf16_t* ap2 = A + (size_t)rowmap(lr + 128) * lda + kc * 8;
  const bf16_t* ap3 = A + (size_t)rowmap(lr + 192) * lda + kc * 8;
  const bf16_t* bp0 = Bt + (size_t)(col0 + lr) * ldb + kc * 8;
  const size_t bstep = (size_t)64 * ldb;
  f32x16 acc[2][4];
#pragma unroll
  for (int i = 0; i < 2; ++i)
#pragma unroll
    for (int j = 0; j < 4; ++j)
#pragma unroll
      for (int r = 0; r < 16; ++r) acc[i][j][r] = 0.f;
#define H_DMA(gp, lp) __builtin_amdgcn_global_load_lds((const unsigned*)(gp), (__attribute__((address_space(3))) unsigned*)(lp), 16, 0, 0)
#define H_ISSUE(st, k0) do { char* sa_ = lds + (st) * 65536 + tid * 16; \
    H_DMA(ap0 + (k0), sa_); H_DMA(ap1 + (k0), sa_ + 8192); H_DMA(ap2 + (k0), sa_ + 16384); H_DMA(ap3 + (k0), sa_ + 24576); \
    H_DMA(bp0 + (k0), sa_ + 32768); H_DMA(bp0 + bstep + (k0), sa_ + 40960); H_DMA(bp0 + 2 * bstep + (k0), sa_ + 49152); H_DMA(bp0 + 3 * bstep + (k0), sa_ + 57344); } while (0)
  const int fsw = (l31 >> 1) & 7, g = fsw >> 1, c0 = l31 * 128 + ((hi ^ (fsw & 1)) << 4);
  const int o0 = c0 + ((0 ^ g) << 5), o1 = c0 + ((1 ^ g) << 5), o2 = c0 + ((2 ^ g) << 5), o3 = c0 + ((3 ^ g) << 5);
  const int abase = (64 * wm) * 128, bbase = 32768 + (128 * wn) * 128;
#define H_FRAG(O, F) do { F[0] = *(const bf16x8*)(cS + abase + (O)); F[1] = *(const bf16x8*)(cS + abase + 4096 + (O)); \
    F[2] = *(const bf16x8*)(cS + bbase + (O)); F[3] = *(const bf16x8*)(cS + bbase + 4096 + (O)); \
    F[4] = *(const bf16x8*)(cS + bbase + 8192 + (O)); F[5] = *(const bf16x8*)(cS + bbase + 12288 + (O)); } while (0)
#define H_MMA(F) do { _Pragma("unroll") for (int nb_ = 0; nb_ < 4; ++nb_) { \
    acc[0][nb_] = __builtin_amdgcn_mfma_f32_32x32x16_bf16(F[0], F[2 + nb_], acc[0][nb_], 0, 0, 0); \
    acc[1][nb_] = __builtin_amdgcn_mfma_f32_32x32x16_bf16(F[1], F[2 + nb_], acc[1][nb_], 0, 0, 0); } } while (0)
  const int nk = K >> 6;
  H_ISSUE(0, 0);
  for (int kt = 0; kt < nk; ++kt) {
    asm volatile("s_waitcnt vmcnt(0)" ::: "memory");
    __builtin_amdgcn_s_barrier();
    if (kt + 1 < nk) H_ISSUE((kt + 1) & 1, (kt + 1) * 64);
    const char* cS = lds + (kt & 1) * 65536;
    bf16x8 f0[6], f1[6];
    H_FRAG(o0, f0); H_FRAG(o1, f1); __builtin_amdgcn_sched_barrier(0);
    H_MMA(f0); H_FRAG(o2, f0); __builtin_amdgcn_sched_barrier(0);
    H_MMA(f1); H_FRAG(o3, f1); __builtin_amdgcn_sched_barrier(0);
    H_MMA(f0); H_MMA(f1);
  }
#undef H_DMA
#undef H_ISSUE
#undef H_FRAG
#undef H_MMA
  float* ut = (float*)lds;
#pragma unroll
  for (int h = 0; h < 2; ++h) {
    __syncthreads();
    if (wn == h) {
#pragma unroll
      for (int mb = 0; mb < 2; ++mb)
#pragma unroll
        for (int nb = 0; nb < 4; ++nb)
#pragma unroll
          for (int r = 0; r < 16; ++r) ut[(64 * wm + 32 * mb + crow(r, hi)) * 128 + 32 * nb + l31] = acc[mb][nb][r];
    }
    __syncthreads();
    post(h);
  }
  __syncthreads();
}

struct RowId { int r0; __device__ __forceinline__ int operator()(int i) const { return r0 + i; } };
struct RowHalo { int r0; __device__ __forceinline__ int operator()(int i) const { int r = r0 + i; r = r < 0 ? 0 : r; return r > T - 1 ? T - 1 : r; } };

__device__ __forceinline__ void transpose_item(const float* __restrict__ src, int ldsrc, int K  , bf16_t* __restrict__ dst, int kt, int ntile, int mode,
                               const float* __restrict__ kscale, float* tile) {
  const int tid = get_tid(), k0 = kt * 64, n0 = ntile * 64;
#pragma unroll
  for (int i = 0; i < 2; ++i) {
    const int kk = (tid >> 4) + 32 * i, n4 = (tid & 15) * 4, nn = n0 + n4;
    const int sc = mode == 1 ? (((nn & 63) < 32) ? (nn >> 6) * 32 + (nn & 31) : DFF + (nn >> 6) * 32 + (nn & 31)) : nn;
    f32x4 v = *(const f32x4*)(src + (size_t)(k0 + kk) * ldsrc + sc);
    if (kscale) { const float g = kscale[k0 + kk]; v *= g; }
    float* tp = tile + kk * 65 + n4; tp[0] = v[0]; tp[1] = v[1]; tp[2] = v[2]; tp[3] = v[3];
  }
  __syncthreads();
  {
    const int n = tid >> 3, kc = tid & 7; const float* tp = tile + (kc * 8) * 65 + n;
    u32x4 w; w[0] = cvtpk(tp[0], tp[65]); w[1] = cvtpk(tp[130], tp[195]); w[2] = cvtpk(tp[260], tp[325]); w[3] = cvtpk(tp[390], tp[455]);
    *(u32x4*)(dst + (size_t)(n0 + n) * K + k0 + kc * 8) = w;
  }
  __syncthreads();
}

__device__ __forceinline__ void phase0(PP pp, char* lds) {
  const int tid = get_tid();
  float* svec = (float*)lds; float* red = (float*)(lds + 12288); float* tile = (float*)(lds + 20480);
  for (int i = tid; i < 3072; i += 512) { const int v = i >> 10, k = i & 1023; const float val = v < 2 ? pp->c[v * 1024 + k] : pp->c_ctx[k]; svec[i] = silu_f(val); }
  __syncthreads();
  constexpr int N_ADA = 192, N_ROPE = 1, N_TR = 3000, N_SG = 16, PER_L = N_TR + N_SG;
  constexpr int N_ITEMS = N_ADA + N_ROPE + NLAYER * PER_L;
  for (int it = get_bid(); it < N_ITEMS; it += gridDim.x) {
    if (it < N_ADA) {
      const int l = it / 96, c0 = (it % 96) * 64, col = tid & 63, kg = tid >> 6;
      const float* wp = pp->ada_w + ((size_t)l * 1024 + kg * 128) * 6144 + c0 + col;
      float a0 = 0.f, a1 = 0.f, a2 = 0.f;
#pragma unroll 8
      for (int k = 0; k < 128; ++k) { const float w = wp[(size_t)k * 6144]; const int kk = kg * 128 + k; a0 += svec[kk] * w; a1 += svec[1024 + kk] * w; a2 += svec[2048 + kk] * w; }
      red[(kg * 3 + 0) * 64 + col] = a0; red[(kg * 3 + 1) * 64 + col] = a1; red[(kg * 3 + 2) * 64 + col] = a2;
      __syncthreads();
      if (tid < 192) { const int v = tid >> 6; float s = 0.f;
#pragma unroll
        for (int g = 0; g < 8; ++g) s += red[(g * 3 + v) * 64 + col];
        ((float*)(pp->ws + OFF_MOD))[(size_t)(l * 3 + v) * 6144 + c0 + col] = s + pp->ada_b[l * 6144 + c0 + col]; }
      __syncthreads();
    } else if (it < N_ADA + N_ROPE) {
      for (int e = tid; e < 128 * 24; e += 512) {
        const int pos = e / 24, i = e % 24; const bool big = i < 16; const int ii = big ? i : i - 16;
        const float inv = exp2f(-(float)ii / (big ? 16.f : 8.f) * 13.287712379549449f);
        const float ang = (float)pos * inv;
        const double a = (double)ang; const double n = rint(a * 0.15915494309189535); const float y = (float)(a - n * 6.283185307179586);
        f32x2 cs; cs[0] = cosf(y); cs[1] = sinf(y);
        if (big) ((f32x2*)(pp->ws + OFF_CS16))[pos * 16 + ii] = cs; else ((f32x2*)(pp->ws + OFF_CS8))[pos * 8 + ii] = cs;
      }
    } else {
      const int q = it - N_ADA - N_ROPE, l = q / PER_L; int t = q % PER_L;
      bf16_t* wl = (bf16_t*)(pp->ws + OFF_W) + (size_t)l * W_LAYER;
      if (t < 496) transpose_item(pp->w_in + (size_t)l * 1024 * INW, INW, KP, wl + W_IN, t % 16, t / 16, 0, nullptr, tile);
      else if (t < 568) { t -= 496; transpose_item(pp->mla_wuq + (size_t)l * 384 * 768, 768, 384, wl + W_UQ, t % 6, t / 6, 0, pp->mla_gq + l * 384, tile); }
      else if (t < 632) { t -= 568; transpose_item(pp->mla_wukv + (size_t)l * 256 * 1024, 1024, 256, wl + W_UKV, t % 4, t / 4, 0, pp->mla_gkv + l * 256, tile); }
      else if (t < 888) { t -= 632; transpose_item(pp->w_o + (size_t)l * 1024 * 1024, 1024, KP, wl + W_O, t % 16, t / 16, 0, nullptr, tile); }
      else if (t < 2296) { t -= 888; transpose_item(pp->ffn_wup + (size_t)l * 1024 * 5632, 5632, KP, wl + W_UP, t % 16, t / 16, 1, nullptr, tile); }
      else if (t < 3000) { t -= 2296; transpose_item(pp->ffn_wdown + (size_t)l * DFF * 1024, 1024, DFF, wl + W_DN, t % 44, t / 44, 0, nullptr, tile); }
      else { t -= 3000; const size_t idx = (size_t)t * 4096 + tid * 8; const float* s = pp->sgu_ws + (size_t)l * 65536 + idx;
        const f32x4 v0 = *(const f32x4*)s, v1 = *(const f32x4*)(s + 4);
        u32x4 w; w[0] = cvtpk(v0[0], v0[1]); w[1] = cvtpk(v0[2], v0[3]); w[2] = cvtpk(v1[0], v1[1]); w[3] = cvtpk(v1[2], v1[3]);
        *(u32x4*)(wl + W_SG + idx) = w; }
    }
  }
}

__device__ __forceinline__ void row_pass(PP pp, int mode, const float* __restrict__ lg, const float* __restrict__ lb, int lm, int shc, int scc, bool want_h, bool skip_ctx, bool alpha_ctx) {
  const int lane = get_tid() & 63, wid = get_tid() >> 6;
  const float* mod = (const float*)(pp->ws + OFF_MOD) + (size_t)lm * 3 * 6144;
  bf16_t* hmod = (bf16_t*)(pp->ws + OFF_HMOD);
  const int tstep = gridDim.x * 8;
  auto src_of = [&](int t) -> const float* { const int b = t / SB, j = t - b * SB;
    return mode == 0 ? (j < CTX ? pp->ctx + (size_t)(b * CTX + j) * DM : pp->x + (size_t)(b * SEQ + j - CTX) * DM) : (const float*)xrow(pp, t); };
  f32x4 vn[4];
  { const int t0 = get_bid() * 8 + wid; if (t0 < T) { const float* s0 = src_of(t0);
#pragma unroll
      for (int i = 0; i < 4; ++i) vn[i] = *(const f32x4*)(s0 + (i * 64 + lane) * 4); } }
  for (int t = get_bid() * 8 + wid; t < T; t += tstep) {
    const int b = t / SB, j = t - b * SB; const bool isctx = j < CTX;
    f32x4 v[4];
#pragma unroll
    for (int i = 0; i < 4; ++i) v[i] = vn[i];
    if (t + tstep < T) { const float* s1 = src_of(t + tstep);
#pragma unroll
      for (int i = 0; i < 4; ++i) vn[i] = *(const f32x4*)(s1 + (i * 64 + lane) * 4); }
    if (isctx && skip_ctx) continue;
    float* xr = xrow(pp, t);
    if (mode == 1) {
      float s = 0.f;
#pragma unroll
      for (int i = 0; i < 4; ++i) s += (v[i][0] + v[i][1]) + (v[i][2] + v[i][3]);
#pragma unroll
      for (int o = 32; o > 0; o >>= 1) s += __shfl_xor(s, o);
      const float mu = s * (1.f / 1024.f);
      float q = 0.f;
#pragma unroll
      for (int i = 0; i < 4; ++i) { v[i] -= mu; q += (v[i][0] * v[i][0] + v[i][1] * v[i][1]) + (v[i][2] * v[i][2] + v[i][3] * v[i][3]); }
#pragma unroll
      for (int o = 32; o > 0; o >>= 1) q += __shfl_xor(q, o);
      const float rstd = rsqrtf(q * (1.f / 1024.f) + EPS);
#pragma unroll
      for (int i = 0; i < 4; ++i) { const int c = (i * 64 + lane) * 4; const f32x4 g = *(const f32x4*)(lg + c), bb = *(const f32x4*)(lb + c); v[i] = v[i] * rstd * g + bb; }
    }
    { const float sca = (isctx && alpha_ctx) ? DN_ALPHA : 1.f;
#pragma unroll
      for (int i = 0; i < 4; ++i) *(f32x4*)(xr + (i * 64 + lane) * 4) = v[i] * sca; }
    if (want_h) {
      if (lane == 0) { float z0 = 0.f; asm volatile("" : "+v"(z0)); f32x2 z; z[0] = z0; z[1] = z0; *(f32x2*)(pp->ws + OFF_SSQ + (size_t)t * 8) = z; }
      const float* mv = mod + (size_t)(isctx ? 2 : b) * 6144;
#pragma unroll
      for (int i = 0; i < 4; ++i) { const int c = (i * 64 + lane) * 4; const f32x4 sh = *(const f32x4*)(mv + shc * 1024 + c), sc = *(const f32x4*)(mv + scc * 1024 + c);
        const f32x4 h = v[i] * (sc + 1.f) + sh; u32x2 w; w[0] = cvtpk(h[0], h[1]); w[1] = cvtpk(h[2], h[3]); *(u32x2*)(hmod + (size_t)t * KP + c) = w; }
    }
  }
}

__device__ __forceinline__ void dump_tile(f32x16 (&acc)[2][2], int rbase, int cl, float* ut, int c31, int hi) {
#pragma unroll
  for (int mb = 0; mb < 2; ++mb)
#pragma unroll
    for (int nb = 0; nb < 2; ++nb)
#pragma unroll
      for (int r = 0; r < 16; ++r) ut[(rbase + 32 * mb + crow(r, hi)) * 128 + cl + 32 * nb + c31] = acc[mb][nb][r];
}
__device__ __forceinline__ u32x4 pack8f(const f32x4 a, const f32x4 b) { u32x4 w; w[0] = cvtpk(a[0], a[1]); w[1] = cvtpk(a[2], a[3]); w[2] = cvtpk(b[0], b[1]); w[3] = cvtpk(b[2], b[3]); return w; }
__device__ __forceinline__ void rope8(f32x4& a, f32x4& b, const f32x4 pa, const f32x4 pb, const f32x2* cs, bool upper) {
  const float sg = upper ? 1.f : -1.f;
#pragma unroll
  for (int e = 0; e < 4; ++e) { const f32x2 c0 = cs[e], c1 = cs[4 + e]; a[e] = a[e] * c0[0] + sg * pa[e] * c0[1]; b[e] = b[e] * c1[0] + sg * pb[e] * c1[1]; }
}
template <int NCOL>
__device__ __forceinline__ void store_transposed(const float* ut, int lc0, bf16_t* dst  , const float* rscale) {
  const int tid = get_tid(), col = tid & (NCOL - 1), rc0 = tid / NCOL;
#pragma unroll 2
  for (int rc = rc0; rc < 32; rc += 512 / NCOL) {
    float v[8];
#pragma unroll
    for (int e = 0; e < 8; ++e) { v[e] = ut[(rc * 8 + e) * 128 + lc0 + col]; if (rscale) v[e] *= rscale[rc * 8 + e]; }
    u32x4 w; w[0] = cvtpk(v[0], v[1]); w[1] = cvtpk(v[2], v[3]); w[2] = cvtpk(v[4], v[5]); w[3] = cvtpk(v[6], v[7]);
    *(u32x4*)(dst + (size_t)col * SB + rc * 8) = w;
  }
}

__device__ __forceinline__ void phase_win(PP pp, int l, char* lds) {
  const bf16_t* A = (const bf16_t*)(pp->ws + OFF_HMOD);
  const bf16_t* Bt = (const bf16_t*)(pp->ws + OFF_W) + (size_t)l * W_LAYER + W_IN;
  bf16_t* zq = (bf16_t*)(pp->ws + OFF_ZQ); bf16_t* Kr = (bf16_t*)(pp->ws + OFF_KR); bf16_t* Qd = (bf16_t*)(pp->ws + OFF_QD); bf16_t* Kd = (bf16_t*)(pp->ws + OFF_KD);
  bf16_t* VdT = (bf16_t*)(pp->ws + OFF_VDT); bf16_t* zc = (bf16_t*)(pp->ws + OFF_ZC);
  const f32x2* cs16 = (const f32x2*)(pp->ws + OFF_CS16); const f32x2* cs8 = (const f32x2*)(pp->ws + OFF_CS8);
  const int tid = get_tid(), lane = tid & 63, c31 = lane & 31, hi = lane >> 5;
  float* ut = (float*)lds;
  const bool xmap = gridDim.x == 256; const int xq = get_bid() & 7, xj = get_bid() >> 3;
  for (int it0 = get_bid(); it0 < 64 * 8 + 32; it0 += gridDim.x) {
    const int it = (xmap && it0 < 512) ? ((xq * 8 + (((it0 >> 8) * 32 + xj) >> 3)) << 3) + (xj & 7) : it0;
    const bool lat = it < 512; const int mi = it >> 3;
    const int mt = lat ? (mi >> 5) * 33 + 1 + (mi & 31) : ((it - 512) >> 4) * 33, nt2 = it & 7, ntc = (it - 512) & 15;
    const int row0 = mt * 256, b = mt / 33, j0 = row0 - b * SB; const bool isctx = !lat;
    auto post_nt = [&](int nt) {
    {
      const int cc = tid & 15, seg = 2 * nt + (cc >> 3), col = nt * 128 + cc * 8;
      if (seg < 31 && !(seg >= 19 && seg < 23)) {
#pragma unroll 2
        for (int i = 0; i < 8; ++i) {
          const int row = (tid >> 4) + 32 * i, t = row0 + row; const float* up = ut + row * 128 + cc * 8;
          f32x4 va = *(const f32x4*)up, vb = *(const f32x4*)(up + 4);
          if (seg < 10) { *(u32x4*)(zq + (size_t)t * 640 + col) = pack8f(va, vb);
            float ss = (va[0] * va[0] + va[1] * va[1]) + (va[2] * va[2] + va[3] * va[3]) + (vb[0] * vb[0] + vb[1] * vb[1]) + (vb[2] * vb[2] + vb[3] * vb[3]);
            ss += __shfl_xor(ss, 1); ss += __shfl_xor(ss, 2); ss += __shfl_xor(ss, 4);
            if ((cc & 7) == 0) atomicAdd((float*)(pp->ws + OFF_SSQ) + (size_t)t * 2 + (seg < 6 ? 0 : 1), ss); }
          else if (seg == 10) {
            if (!isctx) { const float* qp = ut + row * 128 + (cc ^ 2) * 8; const f32x4 pa = *(const f32x4*)qp, pb = *(const f32x4*)(qp + 4);
              const int ppos = j0 + row - CTX, pos = ((cc & 4) == 0) ? (ppos >> 6) : (ppos & 63);
              rope8(va, vb, pa, pb, cs16 + pos * 16 + (cc & 1) * 8, (cc & 2) != 0); }
            *(u32x4*)(Kr + (size_t)t * 64 + (cc & 7) * 8) = pack8f(va, vb);
          } else if (seg < 19) {
            if (!isctx) { const float* qp = ut + row * 128 + (cc ^ 1) * 8; const f32x4 pa = *(const f32x4*)qp, pb = *(const f32x4*)(qp + 4);
              const int ppos = j0 + row - CTX, pos = ((cc & 2) == 0) ? (ppos >> 6) : (ppos & 63);
              rope8(va, vb, pa, pb, cs8 + pos * 8, (cc & 1) != 0); }
            if (seg < 15) { va *= QS_DIFF; vb *= QS_DIFF; *(u32x4*)(Qd + (size_t)t * 256 + col - 704) = pack8f(va, vb); }
            else *(u32x4*)(Kd + (size_t)t * 256 + col - 960) = pack8f(va, vb);
          } else {
#pragma unroll
            for (int e = 0; e < 4; ++e) { va[e] = gelu_tanh(va[e]); vb[e] = gelu_tanh(vb[e]); }
            *(u32x4*)(zc + (size_t)t * 512 + col - 1472) = pack8f(va, vb);
          }
        }
      }
#pragma unroll
      for (int sh = 0; sh < 2; ++sh) { const int sg = 2 * nt + sh;
        if (sg >= 19 && sg < 23) store_transposed<64>(ut, sh * 64, VdT + (size_t)(b * 4 + (sg - 19)) * 64 * SB + j0, nullptr); }
    }
    };
    if (lat) { auto post = [&](int h) { post_nt(2 * nt2 + h); }; gemm_tile256b(A, KP, RowId{row0}, Bt, KP, nt2 * 256, DM, lds, post); }
    else {
      auto epi = [&](f32x16 (&acc)[2][2], int rbase, int cbase) { dump_tile(acc, rbase, cbase - ntc * 128, ut, c31, hi); };
      gemm_tile(A, KP, RowId{row0}, Bt, KP, ntc * 128, DM, lds, epi);
      __syncthreads(); post_nt(ntc); __syncthreads();
    }
  }
}

__device__ __forceinline__ void phase_up2(PP pp, int l, char* lds) {
  const bf16_t* zq = (const bf16_t*)(pp->ws + OFF_ZQ);
  const bf16_t* wl = (const bf16_t*)(pp->ws + OFF_W) + (size_t)l * W_LAYER;
  bf16_t* Qm = (bf16_t*)(pp->ws + OFF_QM); bf16_t* Km = (bf16_t*)(pp->ws + OFF_KM); bf16_t* VmT = (bf16_t*)(pp->ws + OFF_VMT);
  const bf16_t* zc = (const bf16_t*)(pp->ws + OFF_ZC); bf16_t* Y = (bf16_t*)(pp->ws + OFF_Y);
  const f32x2* cs16 = (const f32x2*)(pp->ws + OFF_CS16);
  const int tid = get_tid(), lane = tid & 63, wid = tid >> 6, c31 = lane & 31, hi = lane >> 5;
  float* rstd = (float*)(lds + LDS_RSTD);
  constexpr int N_UQ = 66 * 3, N_UKV = 66 * 4, N_CH = 132;
  const float* ssq = (const float*)(pp->ws + OFF_SSQ);
  for (int it = get_bid(); it < N_UQ + N_UKV; it += gridDim.x) {
    {
      const bool isq = it < N_UQ; const int q = isq ? it : it - N_UQ; const int nN = isq ? 3 : 4;
      const int mt = q / nN, nt2 = q % nN, row0 = mt * 256, b = mt / 33, j0 = row0 - b * SB; const bool isctx = (mt % 33) == 0;
      if (tid < 256) rstd[tid] = rsqrtf(ssq[(size_t)(row0 + tid) * 2 + (isq ? 0 : 1)] * (isq ? 1.f / 384.f : 1.f / 256.f) + EPS);
      float* ut = (float*)lds;
      auto post = [&](int h) {
        const int nt = 2 * nt2 + h;
        if (isq || (nt & 1) == 0) {
          const int cc = tid & 15, seg = 2 * nt + (cc >> 3), col = nt * 128 + cc * 8;
#pragma unroll 2
          for (int i = 0; i < 8; ++i) {
            const int row = (tid >> 4) + 32 * i, t = row0 + row; const float* up = ut + row * 128 + cc * 8; const float rs = rstd[row];
            f32x4 va = *(const f32x4*)up, vb = *(const f32x4*)(up + 4);
            if (isq) {
              if ((seg % 3) == 2 && !isctx) { const float* qp = ut + row * 128 + (cc ^ 2) * 8; const f32x4 pa = *(const f32x4*)qp, pb = *(const f32x4*)(qp + 4);
                const int ppos = j0 + row - CTX, pos = ((cc & 4) == 0) ? (ppos >> 6) : (ppos & 63);
                rope8(va, vb, pa, pb, cs16 + pos * 16 + (cc & 1) * 8, (cc & 2) != 0); }
              va *= rs * QS_MLA; vb *= rs * QS_MLA;
              *(u32x4*)(Qm + (size_t)t * 768 + col) = pack8f(va, vb);
            } else {
              va *= rs; vb *= rs;
              *(u32x4*)(Km + (size_t)t * 512 + (nt >> 1) * 128 + cc * 8) = pack8f(va, vb);
            }
          }
        } else {
          store_transposed<128>(ut, 0, VmT + (size_t)(b * 4 + (nt >> 1)) * 128 * SB + j0, rstd);
        }
      };
      gemm_tile256(isq ? zq : zq + 384, 640, RowId{row0}, isq ? wl + W_UQ : wl + W_UKV, isq ? 384 : 256, nt2 * 256, isq ? 384 : 256, lds, post);
    }
  }
  for (int it = (get_bid() + gridDim.x - ((N_UQ + N_UKV) % gridDim.x)) % gridDim.x; it < N_CH; it += gridDim.x) {
    {
      const int ch = it, t0 = ch * 128;
      float* st = (float*)lds;
      bf16_t* vT = (bf16_t*)(lds + 1024);
      if (tid < 256) {
        const int r = tid >> 1, hf = tid & 1; const bf16_t* rp = zc + (size_t)(t0 + r) * 512 + 256 + hf * 128;
        float s = 0.f, ss = 0.f;
        for (int i = 0; i < 16; ++i) { const u32x4 w = *(const u32x4*)(rp + i * 8);
#pragma unroll
          for (int e = 0; e < 4; ++e) { const float a = bflo(w[e]), c = bfhi(w[e]); s += a + c; ss += a * a + c * c; } }
        s += __shfl_xor(s, 1); ss += __shfl_xor(ss, 1);
        const float mu = s * (1.f / 256.f); const float var = fmaxf(ss * (1.f / 256.f) - mu * mu, 0.f);
        if (hf == 0) { st[2 * r] = mu; st[2 * r + 1] = rsqrtf(var + EPS); }
      }
      __syncthreads();
      const bf16_t* Ws = wl + W_SG;
      for (int g = 0; g < 4; ++g) {
        {
          const int r = tid >> 2, q4 = tid & 3; const bf16_t* rp = zc + (size_t)(t0 + r) * 512 + 256 + g * 64 + q4 * 16;
          const float mu = st[2 * r], rs = st[2 * r + 1];
          const float* lg = pp->sgu_ln_g + l * 256 + g * 64 + q4 * 16; const float* lb = pp->sgu_ln_b + l * 256 + g * 64 + q4 * 16;
#pragma unroll
          for (int i = 0; i < 2; ++i) { const u32x4 w = *(const u32x4*)(rp + i * 8);
#pragma unroll
            for (int e = 0; e < 4; ++e) { const int c = i * 8 + 2 * e;
              vT[(q4 * 16 + c) * 136 + r] = f2bf((bflo(w[e]) - mu) * rs * lg[c] + lb[c]);
              vT[(q4 * 16 + c + 1) * 136 + r] = f2bf((bfhi(w[e]) - mu) * rs * lg[c + 1] + lb[c + 1]); } }
        }
        __syncthreads();
        if (wid < 4) {
          f32x16 a0 = {}, a1 = {};
          const bf16_t* wrow = Ws + ((size_t)g * 128 + 32 * wid + c31) * 128 + hi * 8;
#pragma unroll
          for (int ks = 0; ks < 8; ++ks) {
            const bf16x8 a = *(const bf16x8*)(wrow + ks * 16);
            const bf16x8 b0 = *(const bf16x8*)((const char*)vT + (c31) * 272 + ks * 32 + hi * 16);
            const bf16x8 b1 = *(const bf16x8*)((const char*)vT + (32 + c31) * 272 + ks * 32 + hi * 16);
            a0 = __builtin_amdgcn_mfma_f32_32x32x16_bf16(a, b0, a0, 0, 0, 0);
            a1 = __builtin_amdgcn_mfma_f32_32x32x16_bf16(a, b1, a1, 0, 0, 0);
          }
#pragma unroll
          for (int r = 0; r < 16; ++r) { const int pr = 32 * wid + crow(r, hi); const float bs = pp->sgu_bs[(l * 4 + g) * 128 + pr];
            const size_t t = (size_t)(t0 + pr);
            const float u0 = bf2f(zc[t * 512 + g * 64 + c31]), u1 = bf2f(zc[t * 512 + g * 64 + 32 + c31]);
            Y[t * KP + 768 + g * 64 + c31] = f2bf(u0 * (a0[r] + bs)); Y[t * KP + 768 + g * 64 + 32 + c31] = f2bf(u1 * (a1[r] + bs)); }
        }
        __syncthreads();
      }
    }
  }
}

__device__ __forceinline__ bf16x8 pack8(const f32x16& pv, int base) {
  u32x4 w; w[0] = cvtpk(pv[base], pv[base + 1]); w[1] = cvtpk(pv[base + 2], pv[base + 3]); w[2] = cvtpk(pv[base + 4], pv[base + 5]); w[3] = cvtpk(pv[base + 6], pv[base + 7]);
  return *(bf16x8*)&w;
}
__device__ __forceinline__ bf16x8 ld_vfrag(const char* base) { return *(const bf16x8*)base; }
__device__ __forceinline__ int kperm(int r) { return (r & ~12) | ((r & 4) << 1) | ((r & 8) >> 1); }

constexpr int MLA_KS = 400, MLA_KBYTES = 64 * MLA_KS, VT_S = 144, MLA_VBYTES = 128 * VT_S, MLA_STAGE = MLA_KBYTES + MLA_VBYTES;
constexpr int DF_KS = 144, DF_KBYTES = 64 * DF_KS, DF_VBYTES = 64 * VT_S, DF_STAGE = DF_KBYTES + DF_VBYTES;

template <int NKS>
__device__ __forceinline__ f32x16 qk_tile(const char* krow, const bf16x8* qf, const f32x16& negm) {
  f32x16 p = __builtin_amdgcn_mfma_f32_32x32x16_bf16(*(const bf16x8*)krow, qf[0], negm, 0, 0, 0);
#pragma unroll
  for (int ks = 1; ks < NKS; ++ks) p = __builtin_amdgcn_mfma_f32_32x32x16_bf16(*(const bf16x8*)(krow + ks * 32), qf[ks], p, 0, 0, 0);
  return p;
}
template <int NOB>
__device__ __forceinline__ void sm_pv(f32x16& p, const char* vrow, f32x16& negm, float& m, f32x16& lacc, f32x16* oT, bool first, f32x16* pend) {
  float pm = p[0];
#pragma unroll
  for (int r = 1; r < 16; ++r) pm = fmaxf(pm, p[r]);
  if (first || !__all(pm <= 8.f)) {
    const float pmx = fmaxf(pm, __shfl_xor(pm, 32));
    const float d = first ? pmx : fmaxf(pmx, 0.f);
    if (!first) { const float alpha = fexp2(-d); lacc *= alpha;
#pragma unroll
      for (int nb = 0; nb < NOB; ++nb) oT[nb] *= alpha; }
    m += d;
#pragma unroll
    for (int r = 0; r < 16; ++r) { negm[r] = -m; p[r] -= d; }
    if (pend) {
#pragma unroll
      for (int r = 0; r < 16; ++r) (*pend)[r] -= d; }
  }
#pragma unroll
  for (int r = 0; r < 16; ++r) p[r] = fexp2(p[r]);
  const bf16x8 pb0 = pack8(p, 0), pb1 = pack8(p, 8);
  const bf16x8 ones = {0x3F80, 0x3F80, 0x3F80, 0x3F80, 0x3F80, 0x3F80, 0x3F80, 0x3F80};
  lacc = __builtin_amdgcn_mfma_f32_32x32x16_bf16(ones, pb0, lacc, 0, 0, 0);
  lacc = __builtin_amdgcn_mfma_f32_32x32x16_bf16(ones, pb1, lacc, 0, 0, 0);
#pragma unroll
  for (int nb = 0; nb < NOB; ++nb) {
    oT[nb] = __builtin_amdgcn_mfma_f32_32x32x16_bf16(ld_vfrag(vrow + nb * 32 * VT_S), pb0, oT[nb], 0, 0, 0);
    oT[nb] = __builtin_amdgcn_mfma_f32_32x32x16_bf16(ld_vfrag(vrow + nb * 32 * VT_S + 32), pb1, oT[nb], 0, 0, 0);
  }
}

template <int NOB>
__device__ __forceinline__ void sm_pv_sv(f32x16& p, const char* vrow, f32x16& negm, float& m, float& l, f32x16* oT, bool first) {
  float pm = p[0];
#pragma unroll
  for (int r = 1; r < 16; ++r) pm = fmaxf(pm, p[r]);
  if (first || !__all(pm <= 8.f)) {
    const float pmx = fmaxf(pm, __shfl_xor(pm, 32));
    const float d = first ? pmx : fmaxf(pmx, 0.f);
    if (!first) { const float alpha = fexp2(-d); l *= alpha;
#pragma unroll
      for (int nb = 0; nb < NOB; ++nb) oT[nb] *= alpha; }
    m += d;
#pragma unroll
    for (int r = 0; r < 16; ++r) { negm[r] = -m; p[r] -= d; }
  }
  float ps = 0.f;
#pragma unroll
  for (int r = 0; r < 16; ++r) { p[r] = fexp2(p[r]); ps += p[r]; }
  l += ps;
  const bf16x8 pb0 = pack8(p, 0), pb1 = pack8(p, 8);
#pragma unroll
  for (int nb = 0; nb < NOB; ++nb) {
    oT[nb] = __builtin_amdgcn_mfma_f32_32x32x16_bf16(ld_vfrag(vrow + nb * 32 * VT_S), pb0, oT[nb], 0, 0, 0);
    oT[nb] = __builtin_amdgcn_mfma_f32_32x32x16_bf16(ld_vfrag(vrow + nb * 32 * VT_S + 32), pb1, oT[nb], 0, 0, 0);
  }
}

template <int NOB>
__device__ __forceinline__ void sm_pv_valu(f32x16& p, const char* vrow, float& m, float& l, f32x16* oT, bool first) {
  float pm = p[0];
#pragma unroll
  for (int r = 1; r < 16; ++r) pm = fmaxf(pm, p[r]);
  if (first || !__all(pm <= m + 8.f)) {
    const float pmx = fmaxf(pm, __shfl_xor(pm, 32));
    const float mn = first ? pmx : fmaxf(m, pmx);
    if (!first) { const float alpha = fexp2(m - mn); l *= alpha;
#pragma unroll
      for (int nb = 0; nb < NOB; ++nb) oT[nb] *= alpha; }
    m = mn;
  }
  float ps = 0.f;
#pragma unroll
  for (int r = 0; r < 16; ++r) { p[r] = fexp2(p[r] - m); ps += p[r]; }
  l += ps;
  const bf16x8 pb0 = pack8(p, 0), pb1 = pack8(p, 8);
#pragma unroll
  for (int nb = 0; nb < NOB; ++nb) {
    oT[nb] = __builtin_amdgcn_mfma_f32_32x32x16_bf16(ld_vfrag(vrow + nb * 32 * VT_S), pb0, oT[nb], 0, 0, 0);
    oT[nb] = __builtin_amdgcn_mfma_f32_32x32x16_bf16(ld_vfrag(vrow + nb * 32 * VT_S + 32), pb1, oT[nb], 0, 0, 0);
  }
}

__device__ __forceinline__ void attn_mla_item(PP pp, int b, int h, int tq0, int NT, char* lds) {
  const bf16_t* Qm = (const bf16_t*)(pp->ws + OFF_QM); const bf16_t* Km = (const bf16_t*)(pp->ws + OFF_KM); const bf16_t* Kr = (const bf16_t*)(pp->ws + OFF_KR);
  const bf16_t* VmT = (const bf16_t*)(pp->ws + OFF_VMT) + (size_t)(b * 4 + h) * 128 * SB; bf16_t* Y = (bf16_t*)(pp->ws + OFF_Y);
  const int tid = get_tid(), lane = tid & 63, wid = tid >> 6, c31 = lane & 31, hi = lane >> 5;
  const int tk0 = b * SB;
  bf16x8 qf[12];
  { const bf16_t* qp = Qm + (size_t)(tq0 + 32 * wid + c31) * 768 + h * 192 + hi * 8;
#pragma unroll
    for (int ks = 0; ks < 12; ++ks) qf[ks] = *(const bf16x8*)(qp + ks * 16); }
  f32x16 oT[4];
#pragma unroll
  for (int nb = 0; nb < 4; ++nb)
#pragma unroll
    for (int r = 0; r < 16; ++r) oT[nb][r] = 0.f;
  float m = 0.f, l = 0.f; f32x16 negm;
#pragma unroll
  for (int r = 0; r < 16; ++r) negm[r] = 0.f;
  u32x4 rk0, rk1, rk2, rv0, rv1;
  int kkey[3], kc[3];
#pragma unroll
  for (int i = 0; i < 3; ++i) { const int id = tid + 512 * i; kkey[i] = id / 24; kc[i] = id % 24; }
  const int vdv0 = tid >> 3, vkc = tid & 7;
#define A_KSRC(i, key0) (kc[i] < 16 ? Km + (size_t)(tk0 + (key0) + kkey[i]) * 512 + h * 128 + kc[i] * 8 : Kr + (size_t)(tk0 + (key0) + kkey[i]) * 64 + (kc[i] - 16) * 8)
#define A_LOAD(key0) do { rk0 = *(const u32x4*)A_KSRC(0, key0); rk1 = *(const u32x4*)A_KSRC(1, key0); rk2 = *(const u32x4*)A_KSRC(2, key0); \
    rv0 = *(const u32x4*)(VmT + (size_t)vdv0 * SB + (key0) + vkc * 8); rv1 = *(const u32x4*)(VmT + (size_t)(vdv0 + 64) * SB + (key0) + vkc * 8); } while (0)
#define A_STORE(s) do { char* kb_ = lds + (s) * MLA_STAGE; char* vb_ = kb_ + MLA_KBYTES; \
    *(u32x4*)(kb_ + kkey[0] * MLA_KS + kc[0] * 16) = rk0; *(u32x4*)(kb_ + kkey[1] * MLA_KS + kc[1] * 16) = rk1; *(u32x4*)(kb_ + kkey[2] * MLA_KS + kc[2] * 16) = rk2; \
    { char* d_ = vb_ + vdv0 * VT_S + vkc * 16; *(u32x4*)d_ = rv0; *(u32x4*)(d_ + 64 * VT_S) = rv1; } } while (0)
  A_LOAD(0); A_STORE(0); __syncthreads();
  for (int t = 0; t < NT; ++t) {
    const int s = t & 1;
    if (t + 1 < NT) A_LOAD((t + 1) * 64);
    const char* kb = lds + s * MLA_STAGE; const char* vb = kb + MLA_KBYTES;
    const char* ka = kb + kperm(c31) * MLA_KS + hi * 16; const char* va = vb + c31 * VT_S + hi * 16;
    f32x16 pa = qk_tile<12>(ka, qf, negm);
    sm_pv_sv<4>(pa, va, negm, m, l, oT, t == 0);
    f32x16 pbb = qk_tile<12>(ka + 32 * MLA_KS, qf, negm);
    sm_pv_sv<4>(pbb, va + 64, negm, m, l, oT, false);
    if (t + 1 < NT) A_STORE(s ^ 1);
    __syncthreads();
  }
#undef A_KSRC
#undef A_LOAD
#undef A_STORE
  l += __shfl_xor(l, 32);
  const float il = 1.f / l;
  bf16_t* yp = Y + (size_t)(tq0 + 32 * wid + c31) * KP + h * 128;
#pragma unroll
  for (int nb = 0; nb < 4; ++nb)
#pragma unroll
    for (int i4 = 0; i4 < 4; ++i4) { u32x2 w; w[0] = cvtpk(oT[nb][4 * i4] * il, oT[nb][4 * i4 + 1] * il); w[1] = cvtpk(oT[nb][4 * i4 + 2] * il, oT[nb][4 * i4 + 3] * il);
      *(u32x2*)(yp + 32 * nb + 8 * i4 + 4 * hi) = w; }
}

__device__ __forceinline__ void attn_diff_item(PP pp, int l, int b, int h, int tq0, int NT, float lam, float lam_init, char* lds) {
  const bf16_t* Qd = (const bf16_t*)(pp->ws + OFF_QD); const bf16_t* Kd = (const bf16_t*)(pp->ws + OFF_KD);
  const bf16_t* VdT = (const bf16_t*)(pp->ws + OFF_VDT) + (size_t)(b * 4 + h) * 64 * SB; bf16_t* Y = (bf16_t*)(pp->ws + OFF_Y);
  const int tid = get_tid(), lane = tid & 63, wid = tid >> 6, c31 = lane & 31, hi = lane >> 5;
  const int tk0 = b * SB;
  bf16x8 qf[2][2];
  { const bf16_t* qp = Qd + (size_t)(tq0 + 32 * wid + c31) * 256 + h * 64 + hi * 8;
#pragma unroll
    for (int mp = 0; mp < 2; ++mp)
#pragma unroll
      for (int ks = 0; ks < 2; ++ks) qf[mp][ks] = *(const bf16x8*)(qp + mp * 32 + ks * 16); }
  f32x16 oA[2], oB[2];
#pragma unroll
  for (int nb = 0; nb < 2; ++nb)
#pragma unroll
    for (int r = 0; r < 16; ++r) { oA[nb][r] = 0.f; oB[nb][r] = 0.f; }
  float mA = 0.f, mB = 0.f, lA = 0.f, lB = 0.f; f32x16 negA, negB;
#pragma unroll
  for (int r = 0; r < 16; ++r) { negA[r] = 0.f; negB[r] = 0.f; }
  u32x4 rk, rv;
  const int kkey = tid >> 3, kch = tid & 7;
#define D_LOAD(key0) do { rk = *(const u32x4*)(Kd + (size_t)(tk0 + (key0) + kkey) * 256 + h * 64 + kch * 8); rv = *(const u32x4*)(VdT + (size_t)kkey * SB + (key0) + kch * 8); } while (0)
#define D_STORE(s) do { char* kb_ = lds + (s) * DF_STAGE; char* vb_ = kb_ + DF_KBYTES; *(u32x4*)(kb_ + kkey * DF_KS + kch * 16) = rk; \
    *(u32x4*)(vb_ + kkey * VT_S + kch * 16) = rv; } while (0)
  D_LOAD(0); D_STORE(0); __syncthreads();
  for (int t = 0; t < NT; ++t) {
    const int s = t & 1;
    if (t + 1 < NT) D_LOAD((t + 1) * 64);
    const char* kb = lds + s * DF_STAGE; const char* vb = kb + DF_KBYTES;
    const char* ka = kb + kperm(c31) * DF_KS + hi * 16; const char* va = vb + c31 * VT_S + hi * 16;
    f32x16 pA0 = qk_tile<2>(ka, qf[0], negA);
    f32x16 pB0 = qk_tile<2>(ka + 64, qf[1], negB);
    sm_pv_sv<2>(pA0, va, negA, mA, lA, oA, t == 0);
    f32x16 pA1 = qk_tile<2>(ka + 32 * DF_KS, qf[0], negA);
    sm_pv_sv<2>(pB0, va, negB, mB, lB, oB, t == 0);
    f32x16 pB1 = qk_tile<2>(ka + 32 * DF_KS + 64, qf[1], negB);
    sm_pv_sv<2>(pA1, va + 64, negA, mA, lA, oA, false);
    sm_pv_sv<2>(pB1, va + 64, negB, mB, lB, oB, false);
    if (t + 1 < NT) D_STORE(s ^ 1);
    __syncthreads();
  }
#undef D_LOAD
#undef D_STORE
  lA += __shfl_xor(lA, 32); lB += __shfl_xor(lB, 32);
  const float ia = 1.f / lA, ib = lam / lB;
  float ss = 0.f;
#pragma unroll
  for (int nb = 0; nb < 2; ++nb)
#pragma unroll
    for (int r = 0; r < 16; ++r) { const float d = oA[nb][r] * ia - oB[nb][r] * ib; oA[nb][r] = d; ss += d * d; }
  ss += __shfl_xor(ss, 32);
  const float rs = rsqrtf(ss * (1.f / 64.f) + EPS) * (1.f - lam_init);
  const float* g = pp->subln_g + l * 64;
  bf16_t* yp = Y + (size_t)(tq0 + 32 * wid + c31) * KP + 512 + h * 64;
#pragma unroll
  for (int nb = 0; nb < 2; ++nb)
#pragma unroll
    for (int i4 = 0; i4 < 4; ++i4) { const int dv = 32 * nb + 8 * i4 + 4 * hi; const f32x4 gg = *(const f32x4*)(g + dv);
      u32x2 w; w[0] = cvtpk(oA[nb][4 * i4] * rs * gg[0], oA[nb][4 * i4 + 1] * rs * gg[1]); w[1] = cvtpk(oA[nb][4 * i4 + 2] * rs * gg[2], oA[nb][4 * i4 + 3] * rs * gg[3]);
      *(u32x2*)(yp + dv) = w; }
}

__device__ __forceinline__ void phase_attn(PP pp, int l, bool need_ctx, char* lds) {
  const int n_items = 256 + (need_ctx ? 8 : 0);
  for (int it = get_bid(); it < n_items; it += gridDim.x) {
    const int bh = it & 7, b = bh >> 2, h = bh & 3; const bool lat = it < 256;
    attn_mla_item(pp, b, h, lat ? b * SB + CTX + (it >> 3) * 256 : b * SB, lat ? SB / 64 : CTX / 64, lds);
  }
  float d1 = 0.f, d2 = 0.f;
#pragma unroll 1
  for (int i = 0; i < 32; ++i) { d1 += pp->lq1[l * 32 + i] * pp->lk1[l * 32 + i]; d2 += pp->lq2[l * 32 + i] * pp->lk2[l * 32 + i]; }
  const float lam_init = 0.8f - 0.6f * __expf(-0.3f * (float)l);
  const float lam = __expf(d1) - __expf(d2) + lam_init;
  for (int it = get_bid(); it < n_items; it += gridDim.x) {
    const int bh = it & 7, b = bh >> 2, h = bh & 3; const bool lat = it < 256;
    attn_diff_item(pp, l, b, h, lat ? b * SB + CTX + (it >> 3) * 256 : b * SB, lat ? SB / 64 : CTX / 64, lam, lam_init, lds);
  }
}

__device__ __forceinline__ void phase_res_gemm(PP pp, int l, const bf16_t* A, int K, int ld, const bf16_t* Bt, int gchunk, bool skip_ctx, char* lds) {
  const float* mod = (const float*)(pp->ws + OFF_MOD) + (size_t)l * 3 * 6144;
  const int tid = get_tid(), lane = tid & 63, c31 = lane & 31, hi = lane >> 5;
  float* ut = (float*)lds;
  for (int it0 = get_bid(); it0 < 64 * 4; it0 += gridDim.x) {
    const int it = gridDim.x == 256 ? (((it0 & 7) * 8 + (it0 >> 5)) << 2) + ((it0 >> 3) & 3) : it0;
    const int mi = it >> 2, nt2 = it & 3, mt = (mi >> 5) * 33 + 1 + (mi & 31), row0 = mt * 256, b = mt / 33;
    const float* gv = mod + (size_t)b * 6144 + gchunk * 1024;
    auto post = [&](int h) {
      const int cc = tid & 15, col = nt2 * 256 + h * 128 + cc * 8;
      const f32x4 g0 = *(const f32x4*)(gv + col), g1 = *(const f32x4*)(gv + col + 4);
#pragma unroll 2
      for (int i = 0; i < 8; ++i) {
        const int row = (tid >> 4) + 32 * i; const float* up = ut + row * 128 + cc * 8;
        float* xp = xrow(pp, row0 + row) + col;
        const f32x4 ua = *(const f32x4*)up, ub = *(const f32x4*)(up + 4);
        f32x4 xa = *(const f32x4*)xp, xb = *(const f32x4*)(xp + 4);
        xa = xa * DN_ALPHA + g0 * ua; xb = xb * DN_ALPHA + g1 * ub;
        *(f32x4*)xp = xa; *(f32x4*)(xp + 4) = xb;
      }
    };
    gemm_tile256b(A, ld, RowId{row0}, Bt, ld, nt2 * 256, K, lds, post);
  }
  if (!skip_ctx) {
    const float* gv = mod + (size_t)2 * 6144 + gchunk * 1024;
    const int Kc = K >> 2;
    for (int it = get_bid(); it < 64; it += gridDim.x) {
      const int sp = it & 3, nt = (it >> 2) & 7, row0 = (it >> 5) * 33 * 256;
      auto epi = [&](f32x16 (&acc)[2][2], int rbase, int cbase) {
#pragma unroll
        for (int mb = 0; mb < 2; ++mb)
#pragma unroll
          for (int nb = 0; nb < 2; ++nb) { const int col = cbase + 32 * nb + c31; const float g = gv[col];
#pragma unroll
            for (int r = 0; r < 16; ++r) atomicAdd(xrow(pp, row0 + rbase + 32 * mb + crow(r, hi)) + col, g * acc[mb][nb][r]); }
      };
      gemm_tile(A + sp * Kc, ld, RowId{row0}, Bt + sp * Kc, ld, nt * 128, Kc, lds, epi);
    }
  }
}

__device__ __forceinline__ void phase_ffn_up(PP pp, int l, char* lds) {
  const bf16_t* A = (const bf16_t*)(pp->ws + OFF_HMOD);
  const bf16_t* Bt = (const bf16_t*)(pp->ws + OFF_W) + (size_t)l * W_LAYER + W_UP;
  bf16_t* A2 = (bf16_t*)(pp->ws + OFF_A2);
  const float* cw = pp->ffn_convw + (size_t)l * 3 * 5632; const float* cb = pp->ffn_convb + (size_t)l * 5632;
  const int tid = get_tid(), lane = tid & 63, c31 = lane & 31, hi = lane >> 5;
  float* ut = (float*)lds;
  const bool xmap = gridDim.x == 256; const int xq = get_bid() & 7, xj = get_bid() >> 3;
  const int n_it = xmap ? 6 * 32 : 67 * 22;
  for (int it = xmap ? xj : get_bid(); it < n_it; it += xmap ? 32 : gridDim.x) {
    int mt, nt2;
    if (xmap) { mt = 4 * (it / 11) + (xq >> 1); nt2 = 11 * (xq & 1) + it % 11; if (mt >= 67) continue; }
    else { mt = it / 22; nt2 = it % 22; }
    const int o0 = mt * 254;
    auto post = [&](int h) {
      const int nt = 2 * nt2 + h;
    {
      const int fp = tid & 31, rg = tid >> 5, f = nt * 64 + 2 * fp;
      const int cg = (fp >> 4) * 64 + ((2 * fp) & 31), cv = cg + 32;
      const f32x2 wg0 = *(const f32x2*)(cw + f), wg1 = *(const f32x2*)(cw + 5632 + f), wg2 = *(const f32x2*)(cw + 2 * 5632 + f), bg = *(const f32x2*)(cb + f);
      const f32x2 wv0 = *(const f32x2*)(cw + DFF + f), wv1 = *(const f32x2*)(cw + 5632 + DFF + f), wv2 = *(const f32x2*)(cw + 2 * 5632 + DFF + f), bv = *(const f32x2*)(cb + DFF + f);
      int i0 = rg * 16; int i1 = i0 + 16; if (i0 < 1) i0 = 1; if (i1 > 255) i1 = 255;
      if (i1 > T - (o0 - 1)) i1 = T - (o0 - 1);
      f32x2 gp = *(const f32x2*)(ut + (i0 - 1) * 128 + cg), gc = *(const f32x2*)(ut + i0 * 128 + cg);
      f32x2 vp = *(const f32x2*)(ut + (i0 - 1) * 128 + cv), vc = *(const f32x2*)(ut + i0 * 128 + cv);
      int t = o0 - 1 + i0; int j = t % SB;
      bf16_t* dst = A2 + (size_t)t * DFF + f;
      for (int i = i0; i < i1; ++i) {
        const f32x2 gn = *(const f32x2*)(ut + (i + 1) * 128 + cg), vn = *(const f32x2*)(ut + (i + 1) * 128 + cv);
        f32x2 gate = wg1 * gc + bg, val = wv1 * vc + bv;
        if (j != 0 && j != CTX) { gate += wg0 * gp; val += wv0 * vp; }
        if (j != CTX - 1 && j != SB - 1) { gate += wg2 * gn; val += wv2 * vn; }
        *(unsigned*)dst = cvtpk(silu_f(gate[0]) * val[0], silu_f(gate[1]) * val[1]);
        dst += DFF; j = (j == SB - 1) ? 0 : j + 1;
        gp = gc; gc = gn; vp = vc; vc = vn;
      }
    }
    };
    gemm_tile256b(A, KP, RowHalo{o0 - 1}, Bt, KP, nt2 * 256, DM, lds, post);
  }
}


#define XB_TMO      128
#define XB_XCNT(j)  (256  + 64 * (j))
#define XB_XSUB(j)  (1280 + 64 * (j))
#define XB_XGEN(j)  (2304 + 64 * (j))
#define XB_TOP      3328
#define XB_TOPGEN   3392
#define XCD_BAR_WORDS 3456
#define XB_SPIN_CAP (1u << 18)
#define LAS __attribute__((address_space(3)))

__device__ __forceinline__ unsigned xb_ld(unsigned* p)              { return __hip_atomic_load(p, __ATOMIC_RELAXED, __HIP_MEMORY_SCOPE_AGENT); }
__device__ __forceinline__ unsigned xb_add(unsigned* p, unsigned v) { return __hip_atomic_fetch_add(p, v, __ATOMIC_RELAXED, __HIP_MEMORY_SCOPE_AGENT); }
__device__ __forceinline__ unsigned xb_xcc_id() { return (unsigned)__builtin_amdgcn_s_getreg((3 << 11) | 20) & 0xFu; }
#define XB_SPIN(cond, bar) do { unsigned _sp = 0; while (cond) { __builtin_amdgcn_s_sleep(1); \
    if ((++_sp & 255u) == 0u) { if (xb_ld(&(bar)[XB_TMO])) break; if (_sp > XB_SPIN_CAP) { atomicAdd(&(bar)[XB_TMO], 1u); break; } } } } while (0)

struct XcdBarrier {
    unsigned* bar; unsigned x;
    volatile LAS unsigned* st;
};

__device__ __forceinline__ XcdBarrier xcd_barrier_post(unsigned* bar, volatile LAS unsigned* st) {
    XcdBarrier b; b.bar = bar; b.x = xb_xcc_id(); b.st = st;
    if (get_tid() == 0) (void)xb_add(&bar[XB_XCNT(b.x)], 1u);
    return b;
}
__device__ __forceinline__ void xcd_barrier_complete(unsigned* bar, unsigned x, unsigned& nloc, unsigned& nx) {
    const unsigned G = gridDim.x * gridDim.y * gridDim.z;
    unsigned sum, cnt, mine, sp = 0u;
    for (;;) {
        sum = 0u; cnt = 0u; mine = 0u;
#pragma unroll
        for (unsigned j = 0; j < 16; ++j) { const unsigned c = xb_ld(&bar[XB_XCNT(j)]); sum += c; cnt += (c > 0u) ? 1u : 0u; mine = (j == x) ? c : mine; }
        if (sum == G) break;
        __builtin_amdgcn_s_sleep(1);
        if ((++sp & 255u) == 0u) { if (xb_ld(&bar[XB_TMO])) break; if (sp > XB_SPIN_CAP) { atomicAdd(&bar[XB_TMO], 1u); break; } }
    }
    nloc = mine > 0u ? mine : 1u; nx = cnt > 0u ? cnt : 1u;
}

__device__ __forceinline__ void xcd_barrier(const XcdBarrier& b) {
    asm volatile("s_waitcnt vmcnt(0)" ::: "memory");
    __syncthreads();
    if (get_tid() == 0) {
        unsigned* bar = b.bar;
        __builtin_amdgcn_s_waitcnt(0);
        unsigned nloc = b.st[0], nx = b.st[1];
        if (nloc == 0u) { xcd_barrier_complete(bar, b.x, nloc, nx); b.st[0] = nloc; b.st[1] = nx; }
        const unsigned old = xb_add(&bar[XB_XSUB(b.x)], 1u);
        const unsigned gen = old / nloc;
        if (old + 1u == (gen + 1u) * nloc) {
            __builtin_amdgcn_fence(__ATOMIC_RELEASE, "agent");
            asm volatile("s_waitcnt vmcnt(0)" ::: "memory");
            const unsigned og = xb_add(&bar[XB_TOP], 1u);
            const unsigned tg = og / nx;
            if (og + 1u == (tg + 1u) * nx) xb_add(&bar[XB_TOPGEN], 1u);
            else XB_SPIN(xb_ld(&bar[XB_TOPGEN]) == tg, bar);
            __builtin_amdgcn_fence(__ATOMIC_ACQUIRE, "agent");
            xb_add(&bar[XB_XGEN(b.x)], 1u);
            asm volatile("s_waitcnt vmcnt(0)" ::: "memory");
        } else {
            XB_SPIN(xb_ld(&bar[XB_XGEN(b.x)]) == gen, bar);
            __builtin_amdgcn_fence(__ATOMIC_ACQUIRE, "agent");
            asm volatile("s_waitcnt vmcnt(0)" ::: "memory");
        }
    }
    __syncthreads();
}

constexpr size_t OFF_BAR = OFF_END;
constexpr int LDS_XB = 3 * 49152 + 1024;
__device__ __forceinline__ void grid_bar(PP pp, char* lds) {
  XcdBarrier b; b.bar = (unsigned*)(pp->ws + OFF_BAR); b.x = xb_xcc_id(); b.st = (volatile LAS unsigned*)(lds + LDS_XB);
  xcd_barrier(b);
}
__global__ void __launch_bounds__(512) fwd_megakernel(Params p_arg) {
  extern __shared__ __attribute__((aligned(16))) char lds[];
  cg::grid_group grid = cg::this_grid();
  PP pp = (PP)__builtin_amdgcn_kernarg_segment_ptr();
  { const int t0_ = get_tid(); if (t0_ < 4) ((volatile LAS unsigned*)(lds + LDS_XB))[t0_] = 0u; }
  __syncthreads();
  (void)xcd_barrier_post((unsigned*)(pp->ws + OFF_BAR), (volatile LAS unsigned*)(lds + LDS_XB));
  grid.sync();
  phase0(launder(pp), lds);
  grid_bar(launder(pp), lds);
  row_pass(launder(pp), 0, nullptr, nullptr, 0, 0, 1, true, false, NLAYER > 1);
  grid_bar(launder(pp), lds);
#pragma unroll 1
  for (int l = 0; l < NLAYER; ++l) {
    const bool last = (l == NLAYER - 1);
    const bf16_t* wl = (const bf16_t*)(pp->ws + OFF_W) + (size_t)l * W_LAYER;
    phase_win(launder(pp), l, lds);
    grid_bar(launder(pp), lds);
    phase_up2(launder(pp), l, lds);
    grid_bar(launder(pp), lds);
    phase_attn(launder(pp), l, !last, lds);
    grid_bar(launder(pp), lds);
    phase_res_gemm(launder(pp), l, (const bf16_t*)(pp->ws + OFF_Y), 1024, KP, wl + W_O, 2, last, lds);
    grid_bar(launder(pp), lds);
    row_pass(launder(pp), 1, pp->ln1_g + l * DM, pp->ln1_b + l * DM, l, 3, 4, true, last, !last);
    grid_bar(launder(pp), lds);
    phase_ffn_up(launder(pp), l, lds);
    grid_bar(launder(pp), lds);
    phase_res_gemm(launder(pp), l, (const bf16_t*)(pp->ws + OFF_A2), DFF, DFF, wl + W_DN, 5, last, lds);
    grid_bar(launder(pp), lds);
    row_pass(launder(pp), 1, pp->ln2_g + l * DM, pp->ln2_b + l * DM, l + 1, 0, 1, !last, last, l + 2 < NLAYER);
    if (!last) grid_bar(launder(pp), lds);
  }
}

extern "C" void kernel_launch(void* const* d_in, const int* in_sizes, int n_in, void* d_out, int out_size, void* d_ws, size_t ws_size, hipStream_t stream) {
  static int grid_blocks = 0;
  if (!grid_blocks) {
    int dev = 0, cus = 0, per_cu = 0;
    hipGetDevice(&dev);
    hipDeviceGetAttribute(&cus, hipDeviceAttributeMultiprocessorCount, dev);
    hipFuncSetAttribute((const void*)fwd_megakernel, hipFuncAttributeMaxDynamicSharedMemorySize, LDS_BYTES);
    hipOccupancyMaxActiveBlocksPerMultiprocessor(&per_cu, fwd_megakernel, 512, LDS_BYTES);
    if (per_cu < 1) { fprintf(stderr, "occupancy query returned %d\n", per_cu); per_cu = 1; }
    if (per_cu > 1) per_cu = 1;
    grid_blocks = cus * per_cu;
  }
  Params p{};
  const float** f = (const float**)&p;
  for (int i = 0; i < 29; ++i) f[i] = (const float*)d_in[i];
  p.out = (float*)d_out; p.ws = (char*)d_ws;
  (void)hipMemsetAsync((char*)d_ws + OFF_BAR, 0, XCD_BAR_WORDS * sizeof(unsigned), stream);
  void* args[] = {&p};
  hipError_t e = hipLaunchCooperativeKernel((void*)fwd_megakernel, dim3(grid_blocks), dim3(512), args, LDS_BYTES, stream);
  if (e != hipSuccess) fprintf(stderr, "cooperative launch failed: %s (grid %d)\n", hipGetErrorString(e), grid_blocks);
}
```

```cpp
#include <hip/hip_runtime.h>
#include <hip/hip_cooperative_groups.h>
#include <stdint.h>
#include <cstdio>
namespace cg = cooperative_groups;

typedef unsigned short bf16_t;
typedef short bf16x8 __attribute__((ext_vector_type(8)));
typedef float f32x16 __attribute__((ext_vector_type(16)));
typedef float f32x4 __attribute__((ext_vector_type(4)));
typedef float f32x2 __attribute__((ext_vector_type(2)));
typedef unsigned u32x4 __attribute__((ext_vector_type(4)));
typedef unsigned u32x2 __attribute__((ext_vector_type(2)));

constexpr int DM = 1024, NBATCH = 2, SEQ = 8192, CTX = 256, SB = SEQ + CTX  , T = NBATCH * SB  ;
constexpr int INW = 1984, DFF = 2816, NLAYER = 2;
constexpr int KP = 1088;
constexpr float EPS = 1e-6f;
constexpr float DN_ALPHA = 1.4142135623730951f;
constexpr float LOG2E = 1.4426950408889634f;
constexpr float QS_MLA = 0.07216878364870322f * LOG2E;
constexpr float QS_DIFF = 0.17677669529663687f * LOG2E;

constexpr size_t al256(size_t x) { return (x + 255) / 256 * 256; }
constexpr size_t W_IN = 0;
constexpr size_t W_UQ = W_IN + 2048ull * KP;
constexpr size_t W_UKV = W_UQ + 768ull * 384;
constexpr size_t W_O = W_UKV + 1024ull * 256;
constexpr size_t W_UP = W_O + 1024ull * KP;
constexpr size_t W_DN = W_UP + 5632ull * KP;
constexpr size_t W_SG = W_DN + 1024ull * 2816;
constexpr size_t W_LAYER = W_SG + 4ull * 128 * 128;
constexpr size_t OFF_W = 0;
constexpr size_t OFF_MOD = al256(OFF_W + W_LAYER * 2 * NLAYER);
constexpr size_t OFF_CS16 = al256(OFF_MOD + 2ull * 3 * 6144 * 4);
constexpr size_t OFF_CS8 = al256(OFF_CS16 + 128ull * 16 * 8);
constexpr size_t OFF_CTXRES = al256(OFF_CS8 + 128ull * 8 * 8);
constexpr size_t OFF_HMOD = al256(OFF_CTXRES + 512ull * 1024 * 4);
constexpr size_t OFF_R = al256(OFF_HMOD + (size_t)T * KP * 2);
constexpr size_t OFF_ZQ = OFF_R;
constexpr size_t OFF_KR = al256(OFF_ZQ + (size_t)T * 640 * 2);
constexpr size_t OFF_QD = al256(OFF_KR + (size_t)T * 64 * 2);
constexpr size_t OFF_KD = al256(OFF_QD + (size_t)T * 256 * 2);
constexpr size_t OFF_VDT = al256(OFF_KD + (size_t)T * 256 * 2);
constexpr size_t OFF_ZC = al256(OFF_VDT + (size_t)T * 256 * 2);
constexpr size_t OFF_QM = al256(OFF_ZC + (size_t)T * 512 * 2);
constexpr size_t OFF_KM = al256(OFF_QM + (size_t)T * 768 * 2);
constexpr size_t OFF_VMT = al256(OFF_KM + (size_t)T * 512 * 2);
constexpr size_t OFF_Y = al256(OFF_VMT + (size_t)T * 512 * 2);
constexpr size_t OFF_END = al256(OFF_Y + (size_t)T * KP * 2);
constexpr size_t OFF_A2 = OFF_R;
static_assert(OFF_A2 + (size_t)T * 2816 * 2 <= OFF_END, "A2 alias fits");
constexpr size_t OFF_SSQ = OFF_END + 16384;
static_assert(OFF_SSQ + (size_t)T * 8 <= 268435456ull, "workspace fits 256 MiB");

constexpr int LDS_A_STAGE = 256 * 144, LDS_B_STAGE = 128 * 144;
constexpr int LDS_GEMM = 2 * (LDS_A_STAGE + LDS_B_STAGE);
constexpr int LDS_RSTD = 3 * 49152;
constexpr int LDS_BYTES = 3 * 49152 + 1024 + 16;

struct Params {
  const float *x, *c, *ctx, *c_ctx, *ada_w, *ada_b, *w_in, *mla_gq, *mla_wuq, *mla_gkv, *mla_wukv;
  const float *lq1, *lk1, *lq2, *lk2, *subln_g, *sgu_ln_g, *sgu_ln_b, *sgu_ws, *sgu_bs, *w_o, *ln1_g, *ln1_b;
  const float *ffn_wup, *ffn_convw, *ffn_convb, *ffn_wdown, *ln2_g, *ln2_b;
  float* out; char* ws;
};
typedef const __attribute__((address_space(4))) Params* PP;
__device__ __forceinline__ PP launder(PP q) { asm volatile("" : "+s"(q)); return q; }

__device__ __forceinline__ int get_tid() { int t = threadIdx.x; asm volatile("" : "+v"(t)); return t; }
__device__ __forceinline__ int get_bid() { int t = blockIdx.x; asm volatile("" : "+s"(t)); return t; }
typedef __bf16 bf16x2_t __attribute__((ext_vector_type(2)));
__device__ __forceinline__ unsigned cvtpk(float lo, float hi) { f32x2 v = {lo, hi}; bf16x2_t b = __builtin_convertvector(v, bf16x2_t); return __builtin_bit_cast(unsigned, b); }
__device__ __forceinline__ bf16_t f2bf(float x) { return (bf16_t)(cvtpk(x, 0.f) & 0xffffu); }
__device__ __forceinline__ float bf2f(bf16_t v) { return __uint_as_float(((unsigned)v) << 16); }
__device__ __forceinline__ float bflo(unsigned w) { return __uint_as_float(w << 16); }
__device__ __forceinline__ float bfhi(unsigned w) { return __uint_as_float(w & 0xffff0000u); }
__device__ __forceinline__ int crow(int r, int hi) { return (r & 3) + 8 * (r >> 2) + 4 * hi; }
__device__ __forceinline__ float fexp2(float x) { return __builtin_amdgcn_exp2f(x); }
__device__ __forceinline__ float silu_f(float x) { return x * __builtin_amdgcn_rcpf(1.f + __expf(-x)); }
__device__ __forceinline__ float gelu_tanh(float x) {
  const float u = 0.7978845608028654f * (x + 0.044715f * x * x * x);
  return x * __builtin_amdgcn_rcpf(1.f + __expf(-2.f * u));
}
__device__ __forceinline__ float* xrow(PP pp, int t) {
  const int b = t / SB, j = t - b * SB;
  return j < CTX ? (float*)(pp->ws + OFF_CTXRES) + (size_t)(b * CTX + j) * DM : pp->out + (size_t)(b * SEQ + j - CTX) * DM;
}

constexpr int G_STAGE = 256 * 128 + 128 * 128;
template <class RowMap, class Epi>
__device__ __forceinline__ void gemm_tile(const bf16_t* __restrict__ A, int lda, RowMap rowmap, const bf16_t* __restrict__ Bt, int ldb, int col0, int K,
                                          char* lds, Epi epi) {
  const int tid = get_tid(), lane = tid & 63, wid = tid >> 6, wm = wid >> 1, wn = wid & 1, l31 = lane & 31, hi = lane >> 5;
  const int lr = tid >> 3, lc = tid & 7, kc = lc ^ ((lr >> 1) & 7);
  const bf16_t* ap0 = A + (size_t)rowmap(lr) * lda + kc * 8;
  const bf16_t* ap1 = A + (size_t)rowmap(lr + 64) * lda + kc * 8;
  const bf16_t* ap2 = A + (size_t)rowmap(lr + 128) * lda + kc * 8;
  const bf16_t* ap3 = A + (size_t)rowmap(lr + 192) * lda + kc * 8;
  const bf16_t* bp0 = Bt + (size_t)(col0 + lr) * ldb + kc * 8;
  const bf16_t* bp1 = Bt + (size_t)(col0 + lr + 64) * ldb + kc * 8;
  f32x16 acc[2][2];
#pragma unroll
  for (int i = 0; i < 2; ++i)
#pragma unroll
    for (int j = 0; j < 2; ++j)
#pragma unroll
      for (int r = 0; r < 16; ++r) acc[i][j][r] = 0.f;
#define G_DMA(gp, lp) __builtin_amdgcn_global_load_lds((const unsigned*)(gp), (__attribute__((address_space(3))) unsigned*)(lp), 16, 0, 0)
#define G_ISSUE(st, k0) do { char* sa_ = lds + (st) * G_STAGE + tid * 16; \
    G_DMA(ap0 + (k0), sa_); G_DMA(ap1 + (k0), sa_ + 8192); G_DMA(ap2 + (k0), sa_ + 16384); G_DMA(ap3 + (k0), sa_ + 24576); \
    G_DMA(bp0 + (k0), sa_ + 32768); G_DMA(bp1 + (k0), sa_ + 40960); } while (0)
  const int fsw = (l31 >> 1) & 7, g = fsw >> 1, c0 = l31 * 128 + ((hi ^ (fsw & 1)) << 4);
  const int o0 = c0 + ((0 ^ g) << 5), o1 = c0 + ((1 ^ g) << 5), o2 = c0 + ((2 ^ g) << 5), o3 = c0 + ((3 ^ g) << 5);
  const int abase = (64 * wm) * 128, bbase = 32768 + (64 * wn) * 128;
#define G_FRAG(O, A0, A1, B0, B1) do { A0 = *(const bf16x8*)(cS + abase + (O)); B0 = *(const bf16x8*)(cS + bbase + (O)); \
    A1 = *(const bf16x8*)(cS + abase + 4096 + (O)); B1 = *(const bf16x8*)(cS + bbase + 4096 + (O)); } while (0)
#define G_MMA(A0, A1, B0, B1) do { \
    acc[0][0] = __builtin_amdgcn_mfma_f32_32x32x16_bf16(A0, B0, acc[0][0], 0, 0, 0); \
    acc[0][1] = __builtin_amdgcn_mfma_f32_32x32x16_bf16(A0, B1, acc[0][1], 0, 0, 0); \
    acc[1][0] = __builtin_amdgcn_mfma_f32_32x32x16_bf16(A1, B0, acc[1][0], 0, 0, 0); \
    acc[1][1] = __builtin_amdgcn_mfma_f32_32x32x16_bf16(A1, B1, acc[1][1], 0, 0, 0); } while (0)
  const int nk = K >> 6;
  G_ISSUE(0, 0);
  if (nk > 1) G_ISSUE(1, 64);
  int st = 0, st2 = 2;
  for (int kt = 0; kt < nk; ++kt) {
    if (kt + 1 < nk) asm volatile("s_waitcnt vmcnt(6)" ::: "memory"); else asm volatile("s_waitcnt vmcnt(0)" ::: "memory");
    __builtin_amdgcn_s_barrier();
    if (kt + 2 < nk) G_ISSUE(st2, (kt + 2) * 64);
    const char* cS = lds + st * G_STAGE;
    bf16x8 pa0, pa1, pb0, pb1, qa0, qa1, qb0, qb1, ra0_, ra1_, rb0_, rb1_;
    G_FRAG(o0, pa0, pa1, pb0, pb1); G_FRAG(o1, qa0, qa1, qb0, qb1); __builtin_amdgcn_sched_barrier(0);
    G_MMA(pa0, pa1, pb0, pb1); G_FRAG(o2, ra0_, ra1_, rb0_, rb1_); __builtin_amdgcn_sched_barrier(0);
    G_MMA(qa0, qa1, qb0, qb1); G_FRAG(o3, pa0, pa1, pb0, pb1); __builtin_amdgcn_sched_barrier(0);
    G_MMA(ra0_, ra1_, rb0_, rb1_); G_MMA(pa0, pa1, pb0, pb1);
    st = st == 2 ? 0 : st + 1; st2 = st2 == 2 ? 0 : st2 + 1;
  }
#undef G_DMA
#undef G_ISSUE
#undef G_FRAG
#undef G_MMA
  __syncthreads();
  epi(acc, 64 * wm, col0 + 64 * wn);
}

template <class RowMap, class Post>
__device__ __forceinline__ void gemm_tile256b(const bf16_t* __restrict__ A, int lda, RowMap rowmap, const bf16_t* __restrict__ Bt, int ldb, int col0, int K,
                                             char* lds, Post post) {
  const int tid = get_tid(), lane = tid & 63, wid = tid >> 6, wm = wid >> 1, wn = wid & 1, l31 = lane & 31, hi = lane >> 5;
  const int lr = tid >> 3, lc = tid & 7, kc = lc ^ ((lr >> 1) & 7);
  const bf16_t* ap0 = A + (size_t)rowmap(lr) * lda + kc * 8;
  const bf16_t* ap1 = A + (size_t)rowmap(lr + 64) * lda + kc * 8;
  const bf16_t* ap2 = A + (size_t)rowmap(lr + 128) * lda + kc * 8;
  const bf16_t* ap3 = A + (size_t)rowmap(lr + 192) * lda + kc * 8;
  const bf16_t* bp0 = Bt + (size_t)(col0 + lr) * ldb + kc * 8;
  const size_t bstep = (size_t)64 * ldb;
  const int l15 = lane & 15, q4 = lane >> 4;
  f32x4 acc[4][8];
#pragma unroll
  for (int i = 0; i < 4; ++i)
#pragma unroll
    for (int j = 0; j < 8; ++j) { acc[i][j][0] = 0.f; acc[i][j][1] = 0.f; acc[i][j][2] = 0.f; acc[i][j][3] = 0.f; }
#define H_DMA(gp, lp) __builtin_amdgcn_global_load_lds((const unsigned*)(gp), (__attribute__((address_space(3))) unsigned*)(lp), 16, 0, 0)
#define H_ISSUE(st, k0) do { char* sa_ = lds + (st) * 65536 + tid * 16; \
    H_DMA(ap0 + (k0), sa_); H_DMA(ap1 + (k0), sa_ + 8192); H_DMA(ap2 + (k0), sa_ + 16384); H_DMA(ap3 + (k0), sa_ + 24576); \
    H_DMA(bp0 + (k0), sa_ + 32768); H_DMA(bp0 + bstep + (k0), sa_ + 40960); H_DMA(bp0 + 2 * bstep + (k0), sa_ + 49152); H_DMA(bp0 + 3 * bstep + (k0), sa_ + 57344); } while (0)
  const int fsw = l15 >> 1, c0 = l15 * 128;
  const int ok0 = c0 + (((0 + q4) ^ fsw) << 4), ok1 = c0 + (((4 + q4) ^ fsw) << 4);
  const int abase = (64 * wm) * 128, bbase = 32768 + (128 * wn) * 128;
#define H_FA(O, F) do { F[0] = *(const bf16x8*)(cS + abase + (O)); F[1] = *(const bf16x8*)(cS + abase + 2048 + (O)); \
    F[2] = *(const bf16x8*)(cS + abase + 4096 + (O)); F[3] = *(const bf16x8*)(cS + abase + 6144 + (O)); } while (0)
#define H_FB(O, NH, F) do { F[0] = *(const bf16x8*)(cS + bbase + (NH) * 8192 + (O)); F[1] = *(const bf16x8*)(cS + bbase + (NH) * 8192 + 2048 + (O)); \
    F[2] = *(const bf16x8*)(cS + bbase + (NH) * 8192 + 4096 + (O)); F[3] = *(const bf16x8*)(cS + bbase + (NH) * 8192 + 6144 + (O)); } while (0)
#define H_MMA(FA, FB, NH) do { _Pragma("unroll") for (int mi_ = 0; mi_ < 4; ++mi_) { _Pragma("unroll") for (int nj_ = 0; nj_ < 4; ++nj_) \
    acc[mi_][(NH) * 4 + nj_] = __builtin_amdgcn_mfma_f32_16x16x32_bf16(FA[mi_], FB[nj_], acc[mi_][(NH) * 4 + nj_], 0, 0, 0); } } while (0)
  const int nk = K >> 6;
  H_ISSUE(0, 0);
  for (int kt = 0; kt < nk; ++kt) {
    asm volatile("s_waitcnt vmcnt(0)" ::: "memory");
    __builtin_amdgcn_s_barrier();
    if (kt + 1 < nk) H_ISSUE((kt + 1) & 1, (kt + 1) * 64);
    const char* cS = lds + (kt & 1) * 65536;
    bf16x8 fa0[4], fb0[4];
    H_FA(ok0, fa0); H_FB(ok0, 0, fb0); __builtin_amdgcn_sched_barrier(0);
    H_MMA(fa0, fb0, 0); __builtin_amdgcn_sched_barrier(0);
    H_FB(ok0, 1, fb0); __builtin_amdgcn_sched_barrier(0);
    H_MMA(fa0, fb0, 1); __builtin_amdgcn_sched_barrier(0);
    H_FA(ok1, fa0); H_FB(ok1, 0, fb0); __builtin_amdgcn_sched_barrier(0);
    H_MMA(fa0, fb0, 0); __builtin_amdgcn_sched_barrier(0);
    H_FB(ok1, 1, fb0); __builtin_amdgcn_sched_barrier(0);
    H_MMA(fa0, fb0, 1);
  }
#undef H_DMA
#undef H_ISSUE
#undef H_FA
#undef H_FB
#undef H_MMA
  float* ut = (float*)lds;
#pragma unroll
  for (int h = 0; h < 2; ++h) {
    __syncthreads();
    if (wn == h) {
#pragma unroll
      for (int mi = 0; mi < 4; ++mi)
#pragma unroll
        for (int ni = 0; ni < 8; ++ni)
#pragma unroll
          for (int r = 0; r < 4; ++r) ut[(64 * wm + 16 * mi + 4 * q4 + r) * 128 + 16 * ni + l15] = acc[mi][ni][r];
    }
    __syncthreads();
    post(h);
  }
  __syncthreads();
}

template <class RowMap, class Post>
__device__ __forceinline__ void gemm_tile256(const bf16_t* __restrict__ A, int lda, RowMap rowmap, const bf16_t* __restrict__ Bt, int ldb, int col0, int K,
                                             char* lds, Post post) {
  const int tid = get_tid(), lane = tid & 63, wid = tid >> 6, wm = wid >> 1, wn = wid & 1, l31 = lane & 31, hi = lane >> 5;
  const int lr = tid >> 3, lc = tid & 7, kc = lc ^ ((lr >> 1) & 7);
  const bf16_t* ap0 = A + (size_t)rowmap(lr) * lda + kc * 8;
  const bf16_t* ap1 = A + (size_t)rowmap(lr + 64) * lda + kc * 8;
  const bf16_t* ap2 = A + (size_t)rowmap(lr + 128) * lda + kc * 8;
  const bf16_t* ap3 = A + (size_t)rowmap(lr + 192) * lda + kc * 8;
  const bf16_t* bp0 = Bt + (size_t)(col0 + lr) * ldb + kc * 8;
  const size_t bstep = (size_t)64 * ldb;
  f32x16 acc[2][4];
#pragma unroll
  for (int i = 0; i < 2; ++i)
#pragma unroll
    for (int j = 0; j < 4; ++j)
#pragma unroll
      for (int r = 0; r < 16; ++r) acc[i][j][r] = 0.f;
#define H_DMA(gp, lp) __builtin_amdgcn_global_load_lds((const unsigned*)(gp), (__attribute__((address_space(3))) unsigned*)(lp), 16, 0, 0)
#define H_ISSUE(st, k0) do { char* sa_ = lds + (st) * 65536 + tid * 16; \
    H_DMA(ap0 + (k0), sa_); H_DMA(ap1 + (k0), sa_ + 8192); H_DMA(ap2 + (k0), sa_ + 16384); H_DMA(ap3 + (k0), sa_ + 24576); \
    H_DMA(bp0 + (k0), sa_ + 32768); H_DMA(bp0 + bstep + (k0), sa_ + 40960); H_DMA(bp0 + 2 * bstep + (k0), sa_ + 49152); H_DMA(bp0 + 3 * bstep + (k0), sa_ + 57344); } while (0)
  const int fsw = (l31 >> 1) & 7, g = fsw >> 1, c0 = l31 * 128 + ((hi ^ (fsw & 1)) << 4);
  const int o0 = c0 + ((0 ^ g) << 5), o1 = c0 + ((1 ^ g) << 5), o2 = c0 + ((2 ^ g) << 5), o3 = c0 + ((3 ^ g) << 5);
  const int abase = (64 * wm) * 128, bbase = 32768 + (128 * wn) * 128;
#define H_FRAG(O, F) do { F[0] = *(const bf16x8*)(cS + abase + (O)); F[1] = *(const bf16x8*)(cS + abase + 4096 + (O)); \
    F[2] = *(const bf16x8*)(cS + bbase + (O)); F[3] = *(const bf16x8*)(cS + bbase + 4096 + (O)); \
    F[4] = *(const bf16x8*)(cS + bbase + 8192 + (O)); F[5] = *(const bf16x8*)(cS + bbase + 12288 + (O)); } while (0)
#define H_MMA(F) do { _Pragma("unroll") for (int nb_ = 0; nb_ < 4; ++nb_) { \
    acc[0][nb_] = __builtin_amdgcn_mfma_f32_32x32x16_bf16(F[0], F[2 + nb_], acc[0][nb_], 0, 0, 0); \
    acc[1][nb_] = __builtin_amdgcn_mfma_f32_32x32x16_bf16(F[1], F[2 + nb_], acc[1][nb_], 0, 0, 0); } } while (0)
  const int nk = K >> 6;
  H_ISSUE(0, 0);
  for (int kt = 0; kt < nk; ++kt) {
    asm volatile("s_waitcnt vmcnt(0)" ::: "memory");
    __builtin_amdgcn_s_barrier();
    if (kt + 1 < nk) H_ISSUE((kt + 1) & 1, (kt + 1) * 64);
    const char* cS = lds + (kt & 1) * 65536;
    bf16x8 f0[6], f1[6];
    H_FRAG(o0, f0); H_FRAG(o1, f1); __builtin_amdgcn_sched_barrier(0);
    H_MMA(f0); H_FRAG(o2, f0); __builtin_amdgcn_sched_barrier(0);
    H_MMA(f1); H_FRAG(o3, f1); __builtin_amdgcn_sched_barrier(0);
    H_MMA(f0); H_MMA(f1);
  }
#undef H_DMA
#undef H_ISSUE
#undef H_FRAG
#undef H_MMA
  float* ut = (float*)lds;
#pragma unroll
  for (int h = 0; h < 2; ++h) {
    __syncthreads();
    if (wn == h) {
#pragma unroll
      for (int mb = 0; mb < 2; ++mb)
#pragma unroll
        for (int nb = 0; nb < 4; ++nb)
#pragma unroll
          for (int r = 0; r < 16; ++r) ut[(64 * wm + 32 * mb + crow(r, hi)) * 128 + 32 * nb + l31] = acc[mb][nb][r];
    }
    __syncthreads();
    post(h);
  }
  __syncthreads();
}

struct RowId { int r0; __device__ __forceinline__ int operator()(int i) const { return r0 + i; } };
struct RowHalo { int r0; __device__ __forceinline__ int operator()(int i) const { int r = r0 + i; r = r < 0 ? 0 : r; return r > T - 1 ? T - 1 : r; } };

__device__ __forceinline__ void transpose_item(const float* __restrict__ src, int ldsrc, int K  , bf16_t* __restrict__ dst, int kt, int ntile, int mode,
                               const float* __restrict__ kscale, float* tile) {
  const int tid = get_tid(), k0 = kt * 64, n0 = ntile * 64;
#pragma unroll
  for (int i = 0; i < 2; ++i) {
    const int kk = (tid >> 4) + 32 * i, n4 = (tid & 15) * 4, nn = n0 + n4;
    const int sc = mode == 1 ? (((nn & 63) < 32) ? (nn >> 6) * 32 + (nn & 31) : DFF + (nn >> 6) * 32 + (nn & 31)) : nn;
    f32x4 v = *(const f32x4*)(src + (size_t)(k0 + kk) * ldsrc + sc);
    if (kscale) { const float g = kscale[k0 + kk]; v *= g; }
    float* tp = tile + kk * 65 + n4; tp[0] = v[0]; tp[1] = v[1]; tp[2] = v[2]; tp[3] = v[3];
  }
  __syncthreads();
  {
    const int n = tid >> 3, kc = tid & 7; const float* tp = tile + (kc * 8) * 65 + n;
    u32x4 w; w[0] = cvtpk(tp[0], tp[65]); w[1] = cvtpk(tp[130], tp[195]); w[2] = cvtpk(tp[260], tp[325]); w[3] = cvtpk(tp[390], tp[455]);
    *(u32x4*)(dst + (size_t)(n0 + n) * K + k0 + kc * 8) = w;
  }
  __syncthreads();
}

__device__ __forceinline__ void phase0(PP pp, char* lds) {
  const int tid = get_tid();
  float* svec = (float*)lds; float* red = (float*)(lds + 12288); float* tile = (float*)(lds + 20480);
  for (int i = tid; i < 3072; i += 512) { const int v = i >> 10, k = i & 1023; const float val = v < 2 ? pp->c[v * 1024 + k] : pp->c_ctx[k]; svec[i] = silu_f(val); }
  __syncthreads();
  constexpr int N_ADA = 192, N_ROPE = 1, N_TR = 3000, N_SG = 16, PER_L = N_TR + N_SG;
  constexpr int N_ITEMS = N_ADA + N_ROPE + NLAYER * PER_L;
  for (int it = get_bid(); it < N_ITEMS; it += gridDim.x) {
    if (it < N_ADA) {
      const int l = it / 96, c0 = (it % 96) * 64, col = tid & 63, kg = tid >> 6;
      const float* wp = pp->ada_w + ((size_t)l * 1024 + kg * 128) * 6144 + c0 + col;
      float a0 = 0.f, a1 = 0.f, a2 = 0.f;
#pragma unroll 8
      for (int k = 0; k < 128; ++k) { const float w = wp[(size_t)k * 6144]; const int kk = kg * 128 + k; a0 += svec[kk] * w; a1 += svec[1024 + kk] * w; a2 += svec[2048 + kk] * w; }
      red[(kg * 3 + 0) * 64 + col] = a0; red[(kg * 3 + 1) * 64 + col] = a1; red[(kg * 3 + 2) * 64 + col] = a2;
      __syncthreads();
      if (tid < 192) { const int v = tid >> 6; float s = 0.f;
#pragma unroll
        for (int g = 0; g < 8; ++g) s += red[(g * 3 + v) * 64 + col];
        ((float*)(pp->ws + OFF_MOD))[(size_t)(l * 3 + v) * 6144 + c0 + col] = s + pp->ada_b[l * 6144 + c0 + col]; }
      __syncthreads();
    } else if (it < N_ADA + N_ROPE) {
      for (int e = tid; e < 128 * 24; e += 512) {
        const int pos = e / 24, i = e % 24; const bool big = i < 16; const int ii = big ? i : i - 16;
        const float inv = exp2f(-(float)ii / (big ? 16.f : 8.f) * 13.287712379549449f);
        const float ang = (float)pos * inv;
        const double a = (double)ang; const double n = rint(a * 0.15915494309189535); const float y = (float)(a - n * 6.283185307179586);
        f32x2 cs; cs[0] = cosf(y); cs[1] = sinf(y);
        if (big) ((f32x2*)(pp->ws + OFF_CS16))[pos * 16 + ii] = cs; else ((f32x2*)(pp->ws + OFF_CS8))[pos * 8 + ii] = cs;
      }
    } else {
      const int q = it - N_ADA - N_ROPE, l = q / PER_L; int t = q % PER_L;
      bf16_t* wl = (bf16_t*)(pp->ws + OFF_W) + (size_t)l * W_LAYER;
      if (t < 496) transpose_item(pp->w_in + (size_t)l * 1024 * INW, INW, KP, wl + W_IN, t % 16, t / 16, 0, nullptr, tile);
      else if (t < 568) { t -= 496; transpose_item(pp->mla_wuq + (size_t)l * 384 * 768, 768, 384, wl + W_UQ, t % 6, t / 6, 0, pp->mla_gq + l * 384, tile); }
      else if (t < 632) { t -= 568; transpose_item(pp->mla_wukv + (size_t)l * 256 * 1024, 1024, 256, wl + W_UKV, t % 4, t / 4, 0, pp->mla_gkv + l * 256, tile); }
      else if (t < 888) { t -= 632; transpose_item(pp->w_o + (size_t)l * 1024 * 1024, 1024, KP, wl + W_O, t % 16, t / 16, 0, nullptr, tile); }
      else if (t < 2296) { t -= 888; transpose_item(pp->ffn_wup + (size_t)l * 1024 * 5632, 5632, KP, wl + W_UP, t % 16, t / 16, 1, nullptr, tile); }
      else if (t < 3000) { t -= 2296; transpose_item(pp->ffn_wdown + (size_t)l * DFF * 1024, 1024, DFF, wl + W_DN, t % 44, t / 44, 0, nullptr, tile); }
      else { t -= 3000; const size_t idx = (size_t)t * 4096 + tid * 8; const float* s = pp->sgu_ws + (size_t)l * 65536 + idx;
        const f32x4 v0 = *(const f32x4*)s, v1 = *(const f32x4*)(s + 4);
        u32x4 w; w[0] = cvtpk(v0[0], v0[1]); w[1] = cvtpk(v0[2], v0[3]); w[2] = cvtpk(v1[0], v1[1]); w[3] = cvtpk(v1[2], v1[3]);
        *(u32x4*)(wl + W_SG + idx) = w; }
    }
  }
}

__device__ __forceinline__ void row_pass(PP pp, int mode, const float* __restrict__ lg, const float* __restrict__ lb, int lm, int shc, int scc, bool want_h, bool skip_ctx, bool alpha_ctx) {
  const int lane = get_tid() & 63, wid = get_tid() >> 6;
  const float* mod = (const float*)(pp->ws + OFF_MOD) + (size_t)lm * 3 * 6144;
  bf16_t* hmod = (bf16_t*)(pp->ws + OFF_HMOD);
  for (int t = get_bid() * 8 + wid; t < T; t += gridDim.x * 8) {
    const int b = t / SB, j = t - b * SB; const bool isctx = j < CTX;
    if (isctx && skip_ctx) continue;
    float* xr = xrow(pp, t);
    const float* src = mode == 0 ? (isctx ? pp->ctx + (size_t)(b * CTX + j) * DM : pp->x + (size_t)(b * SEQ + j - CTX) * DM) : xr;
    f32x4 v[4];
#pragma unroll
    for (int i = 0; i < 4; ++i) v[i] = *(const f32x4*)(src + (i * 64 + lane) * 4);
    if (mode == 1) {
      float s = 0.f;
#pragma unroll
      for (int i = 0; i < 4; ++i) s += (v[i][0] + v[i][1]) + (v[i][2] + v[i][3]);
#pragma unroll
      for (int o = 32; o > 0; o >>= 1) s += __shfl_xor(s, o);
      const float mu = s * (1.f / 1024.f);
      float q = 0.f;
#pragma unroll
      for (int i = 0; i < 4; ++i) { v[i] -= mu; q += (v[i][0] * v[i][0] + v[i][1] * v[i][1]) + (v[i][2] * v[i][2] + v[i][3] * v[i][3]); }
#pragma unroll
      for (int o = 32; o > 0; o >>= 1) q += __shfl_xor(q, o);
      const float rstd = rsqrtf(q * (1.f / 1024.f) + EPS);
#pragma unroll
      for (int i = 0; i < 4; ++i) { const int c = (i * 64 + lane) * 4; const f32x4 g = *(const f32x4*)(lg + c), bb = *(const f32x4*)(lb + c); v[i] = v[i] * rstd * g + bb; }
    }
    { const float sca = (isctx && alpha_ctx) ? DN_ALPHA : 1.f;
#pragma unroll
      for (int i = 0; i < 4; ++i) *(f32x4*)(xr + (i * 64 + lane) * 4) = v[i] * sca; }
    if (want_h) {
      if (lane == 0) { float z0 = 0.f; asm volatile("" : "+v"(z0)); f32x2 z; z[0] = z0; z[1] = z0; *(f32x2*)(pp->ws + OFF_SSQ + (size_t)t * 8) = z; }
      const float* mv = mod + (size_t)(isctx ? 2 : b) * 6144;
#pragma unroll
      for (int i = 0; i < 4; ++i) { const int c = (i * 64 + lane) * 4; const f32x4 sh = *(const f32x4*)(mv + shc * 1024 + c), sc = *(const f32x4*)(mv + scc * 1024 + c);
        const f32x4 h = v[i] * (sc + 1.f) + sh; u32x2 w; w[0] = cvtpk(h[0], h[1]); w[1] = cvtpk(h[2], h[3]); *(u32x2*)(hmod + (size_t)t * KP + c) = w; }
    }
  }
}

__device__ __forceinline__ void dump_tile(f32x16 (&acc)[2][2], int rbase, int cl, float* ut, int c31, int hi) {
#pragma unroll
  for (int mb = 0; mb < 2; ++mb)
#pragma unroll
    for (int nb = 0; nb < 2; ++nb)
#pragma unroll
      for (int r = 0; r < 16; ++r) ut[(rbase + 32 * mb + crow(r, hi)) * 128 + cl + 32 * nb + c31] = acc[mb][nb][r];
}
__device__ __forceinline__ u32x4 pack8f(const f32x4 a, const f32x4 b) { u32x4 w; w[0] = cvtpk(a[0], a[1]); w[1] = cvtpk(a[2], a[3]); w[2] = cvtpk(b[0], b[1]); w[3] = cvtpk(b[2], b[3]); return w; }
__device__ __forceinline__ void rope8(f32x4& a, f32x4& b, const f32x4 pa, const f32x4 pb, const f32x2* cs, bool upper) {
  const float sg = upper ? 1.f : -1.f;
#pragma unroll
  for (int e = 0; e < 4; ++e) { const f32x2 c0 = cs[e], c1 = cs[4 + e]; a[e] = a[e] * c0[0] + sg * pa[e] * c0[1]; b[e] = b[e] * c1[0] + sg * pb[e] * c1[1]; }
}
template <int NCOL>
__device__ __forceinline__ void store_transposed(const float* ut, int lc0, bf16_t* dst  , const float* rscale) {
  const int tid = get_tid(), col = tid & (NCOL - 1), rc0 = tid / NCOL;
#pragma unroll 2
  for (int rc = rc0; rc < 32; rc += 512 / NCOL) {
    float v[8];
#pragma unroll
    for (int e = 0; e < 8; ++e) { v[e] = ut[(rc * 8 + e) * 128 + lc0 + col]; if (rscale) v[e] *= rscale[rc * 8 + e]; }
    u32x4 w; w[0] = cvtpk(v[0], v[1]); w[1] = cvtpk(v[2], v[3]); w[2] = cvtpk(v[4], v[5]); w[3] = cvtpk(v[6], v[7]);
    *(u32x4*)(dst + (size_t)col * SB + rc * 8) = w;
  }
}

__device__ __forceinline__ void phase_win(PP pp, int l, char* lds) {
  const bf16_t* A = (const bf16_t*)(pp->ws + OFF_HMOD);
  const bf16_t* Bt = (const bf16_t*)(pp->ws + OFF_W) + (size_t)l * W_LAYER + W_IN;
  bf16_t* zq = (bf16_t*)(pp->ws + OFF_ZQ); bf16_t* Kr = (bf16_t*)(pp->ws + OFF_KR); bf16_t* Qd = (bf16_t*)(pp->ws + OFF_QD); bf16_t* Kd = (bf16_t*)(pp->ws + OFF_KD);
  bf16_t* VdT = (bf16_t*)(pp->ws + OFF_VDT); bf16_t* zc = (bf16_t*)(pp->ws + OFF_ZC);
  const f32x2* cs16 = (const f32x2*)(pp->ws + OFF_CS16); const f32x2* cs8 = (const f32x2*)(pp->ws + OFF_CS8);
  const int tid = get_tid(), lane = tid & 63, c31 = lane & 31, hi = lane >> 5;
  float* ut = (float*)lds;
  const bool xmap = gridDim.x == 256; const int xq = get_bid() & 7, xj = get_bid() >> 3;
  for (int it0 = get_bid(); it0 < 64 * 8 + 32; it0 += gridDim.x) {
    const int it = (xmap && it0 < 512) ? ((xq * 8 + (((it0 >> 8) * 32 + xj) >> 3)) << 3) + (xj & 7) : it0;
    const bool lat = it < 512; const int mi = it >> 3;
    const int mt = lat ? (mi >> 5) * 33 + 1 + (mi & 31) : ((it - 512) >> 4) * 33, nt2 = it & 7, ntc = (it - 512) & 15;
    const int row0 = mt * 256, b = mt / 33, j0 = row0 - b * SB; const bool isctx = !lat;
    auto post_nt = [&](int nt) {
    {
      const int cc = tid & 15, seg = 2 * nt + (cc >> 3), col = nt * 128 + cc * 8;
      if (seg < 31 && !(seg >= 19 && seg < 23)) {
#pragma unroll 2
        for (int i = 0; i < 8; ++i) {
          const int row = (tid >> 4) + 32 * i, t = row0 + row; const float* up = ut + row * 128 + cc * 8;
          f32x4 va = *(const f32x4*)up, vb = *(const f32x4*)(up + 4);
          if (seg < 10) { *(u32x4*)(zq + (size_t)t * 640 + col) = pack8f(va, vb);
            float ss = (va[0] * va[0] + va[1] * va[1]) + (va[2] * va[2] + va[3] * va[3]) + (vb[0] * vb[0] + vb[1] * vb[1]) + (vb[2] * vb[2] + vb[3] * vb[3]);
            ss += __shfl_xor(ss, 1); ss += __shfl_xor(ss, 2); ss += __shfl_xor(ss, 4);
            if ((cc & 7) == 0) atomicAdd((float*)(pp->ws + OFF_SSQ) + (size_t)t * 2 + (seg < 6 ? 0 : 1), ss); }
          else if (seg == 10) {
            if (!isctx) { const float* qp = ut + row * 128 + (cc ^ 2) * 8; const f32x4 pa = *(const f32x4*)qp, pb = *(const f32x4*)(qp + 4);
              const int ppos = j0 + row - CTX, pos = ((cc & 4) == 0) ? (ppos >> 6) : (ppos & 63);
              rope8(va, vb, pa, pb, cs16 + pos * 16 + (cc & 1) * 8, (cc & 2) != 0); }
            *(u32x4*)(Kr + (size_t)t * 64 + (cc & 7) * 8) = pack8f(va, vb);
          } else if (seg < 19) {
            if (!isctx) { const float* qp = ut + row * 128 + (cc ^ 1) * 8; const f32x4 pa = *(const f32x4*)qp, pb = *(const f32x4*)(qp + 4);
              const int ppos = j0 + row - CTX, pos = ((cc & 2) == 0) ? (ppos >> 6) : (ppos & 63);
              rope8(va, vb, pa, pb, cs8 + pos * 8, (cc & 1) != 0); }
            if (seg < 15) { va *= QS_DIFF; vb *= QS_DIFF; *(u32x4*)(Qd + (size_t)t * 256 + col - 704) = pack8f(va, vb); }
            else *(u32x4*)(Kd + (size_t)t * 256 + col - 960) = pack8f(va, vb);
          } else {
#pragma unroll
            for (int e = 0; e < 4; ++e) { va[e] = gelu_tanh(va[e]); vb[e] = gelu_tanh(vb[e]); }
            *(u32x4*)(zc + (size_t)t * 512 + col - 1472) = pack8f(va, vb);
          }
        }
      }
#pragma unroll
      for (int sh = 0; sh < 2; ++sh) { const int sg = 2 * nt + sh;
        if (sg >= 19 && sg < 23) store_transposed<64>(ut, sh * 64, VdT + (size_t)(b * 4 + (sg - 19)) * 64 * SB + j0, nullptr); }
    }
    };
    if (lat) { auto post = [&](int h) { post_nt(2 * nt2 + h); }; gemm_tile256b(A, KP, RowId{row0}, Bt, KP, nt2 * 256, DM, lds, post); }
    else {
      auto epi = [&](f32x16 (&acc)[2][2], int rbase, int cbase) { dump_tile(acc, rbase, cbase - ntc * 128, ut, c31, hi); };
      gemm_tile(A, KP, RowId{row0}, Bt, KP, ntc * 128, DM, lds, epi);
      __syncthreads(); post_nt(ntc); __syncthreads();
    }
  }
}

__device__ __forceinline__ void phase_up2(PP pp, int l, char* lds) {
  const bf16_t* zq = (const bf16_t*)(pp->ws + OFF_ZQ);
  const bf16_t* wl = (const bf16_t*)(pp->ws + OFF_W) + (size_t)l * W_LAYER;
  bf16_t* Qm = (bf16_t*)(pp->ws + OFF_QM); bf16_t* Km = (bf16_t*)(pp->ws + OFF_KM); bf16_t* VmT = (bf16_t*)(pp->ws + OFF_VMT);
  const bf16_t* zc = (const bf16_t*)(pp->ws + OFF_ZC); bf16_t* Y = (bf16_t*)(pp->ws + OFF_Y);
  const f32x2* cs16 = (const f32x2*)(pp->ws + OFF_CS16);
  const int tid = get_tid(), lane = tid & 63, wid = tid >> 6, c31 = lane & 31, hi = lane >> 5;
  float* rstd = (float*)(lds + LDS_RSTD);
  constexpr int N_UQ = 66 * 3, N_UKV = 66 * 4, N_CH = 132;
  const float* ssq = (const float*)(pp->ws + OFF_SSQ);
  for (int it = get_bid(); it < N_UQ + N_UKV; it += gridDim.x) {
    {
      const bool isq = it < N_UQ; const int q = isq ? it : it - N_UQ; const int nN = isq ? 3 : 4;
      const int mt = q / nN, nt2 = q % nN, row0 = mt * 256, b = mt / 33, j0 = row0 - b * SB; const bool isctx = (mt % 33) == 0;
      if (tid < 256) rstd[tid] = rsqrtf(ssq[(size_t)(row0 + tid) * 2 + (isq ? 0 : 1)] * (isq ? 1.f / 384.f : 1.f / 256.f) + EPS);
      float* ut = (float*)lds;
      auto post = [&](int h) {
        const int nt = 2 * nt2 + h;
        if (isq || (nt & 1) == 0) {
          const int cc = tid & 15, seg = 2 * nt + (cc >> 3), col = nt * 128 + cc * 8;
#pragma unroll 2
          for (int i = 0; i < 8; ++i) {
            const int row = (tid >> 4) + 32 * i, t = row0 + row; const float* up = ut + row * 128 + cc * 8; const float rs = rstd[row];
            f32x4 va = *(const f32x4*)up, vb = *(const f32x4*)(up + 4);
            if (isq) {
              if ((seg % 3) == 2 && !isctx) { const float* qp = ut + row * 128 + (cc ^ 2) * 8; const f32x4 pa = *(const f32x4*)qp, pb = *(const f32x4*)(qp + 4);
                const int ppos = j0 + row - CTX, pos = ((cc & 4) == 0) ? (ppos >> 6) : (ppos & 63);
                rope8(va, vb, pa, pb, cs16 + pos * 16 + (cc & 1) * 8, (cc & 2) != 0); }
              va *= rs * QS_MLA; vb *= rs * QS_MLA;
              *(u32x4*)(Qm + (size_t)t * 768 + col) = pack8f(va, vb);
            } else {
              va *= rs; vb *= rs;
              *(u32x4*)(Km + (size_t)t * 512 + (nt >> 1) * 128 + cc * 8) = pack8f(va, vb);
            }
          }
        } else {
          store_transposed<128>(ut, 0, VmT + (size_t)(b * 4 + (nt >> 1)) * 128 * SB + j0, rstd);
        }
      };
      gemm_tile256(isq ? zq : zq + 384, 640, RowId{row0}, isq ? wl + W_UQ : wl + W_UKV, isq ? 384 : 256, nt2 * 256, isq ? 384 : 256, lds, post);
    }
  }
  for (int it = (get_bid() + gridDim.x - ((N_UQ + N_UKV) % gridDim.x)) % gridDim.x; it < N_CH; it += gridDim.x) {
    {
      const int ch = it, t0 = ch * 128;
      float* st = (float*)lds;
      bf16_t* vT = (bf16_t*)(lds + 1024);
      if (tid < 256) {
        const int r = tid >> 1, hf = tid & 1; const bf16_t* rp = zc + (size_t)(t0 + r) * 512 + 256 + hf * 128;
        float s = 0.f, ss = 0.f;
        for (int i = 0; i < 16; ++i) { const u32x4 w = *(const u32x4*)(rp + i * 8);
#pragma unroll
          for (int e = 0; e < 4; ++e) { const float a = bflo(w[e]), c = bfhi(w[e]); s += a + c; ss += a * a + c * c; } }
        s += __shfl_xor(s, 1); ss += __shfl_xor(ss, 1);
        const float mu = s * (1.f / 256.f); const float var = fmaxf(ss * (1.f / 256.f) - mu * mu, 0.f);
        if (hf == 0) { st[2 * r] = mu; st[2 * r + 1] = rsqrtf(var + EPS); }
      }
      __syncthreads();
      const bf16_t* Ws = wl + W_SG;
      for (int g = 0; g < 4; ++g) {
        {
          const int r = tid >> 2, q4 = tid & 3; const bf16_t* rp = zc + (size_t)(t0 + r) * 512 + 256 + g * 64 + q4 * 16;
          const float mu = st[2 * r], rs = st[2 * r + 1];
          const float* lg = pp->sgu_ln_g + l * 256 + g * 64 + q4 * 16; const float* lb = pp->sgu_ln_b + l * 256 + g * 64 + q4 * 16;
#pragma unroll
          for (int i = 0; i < 2; ++i) { const u32x4 w = *(const u32x4*)(rp + i * 8);
#pragma unroll
            for (int e = 0; e < 4; ++e) { const int c = i * 8 + 2 * e;
              vT[(q4 * 16 + c) * 136 + r] = f2bf((bflo(w[e]) - mu) * rs * lg[c] + lb[c]);
              vT[(q4 * 16 + c + 1) * 136 + r] = f2bf((bfhi(w[e]) - mu) * rs * lg[c + 1] + lb[c + 1]); } }
        }
        __syncthreads();
        if (wid < 4) {
          f32x16 a0 = {}, a1 = {};
          const bf16_t* wrow = Ws + ((size_t)g * 128 + 32 * wid + c31) * 128 + hi * 8;
#pragma unroll
          for (int ks = 0; ks < 8; ++ks) {
            const bf16x8 a = *(const bf16x8*)(wrow + ks * 16);
            const bf16x8 b0 = *(const bf16x8*)((const char*)vT + (c31) * 272 + ks * 32 + hi * 16);
            const bf16x8 b1 = *(const bf16x8*)((const char*)vT + (32 + c31) * 272 + ks * 32 + hi * 16);
            a0 = __builtin_amdgcn_mfma_f32_32x32x16_bf16(a, b0, a0, 0, 0, 0);
            a1 = __builtin_amdgcn_mfma_f32_32x32x16_bf16(a, b1, a1, 0, 0, 0);
          }
#pragma unroll
          for (int r = 0; r < 16; ++r) { const int pr = 32 * wid + crow(r, hi); const float bs = pp->sgu_bs[(l * 4 + g) * 128 + pr];
            const size_t t = (size_t)(t0 + pr);
            const float u0 = bf2f(zc[t * 512 + g * 64 + c31]), u1 = bf2f(zc[t * 512 + g * 64 + 32 + c31]);
            Y[t * KP + 768 + g * 64 + c31] = f2bf(u0 * (a0[r] + bs)); Y[t * KP + 768 + g * 64 + 32 + c31] = f2bf(u1 * (a1[r] + bs)); }
        }
        __syncthreads();
      }
    }
  }
}

__device__ __forceinline__ bf16x8 pack8(const f32x16& pv, int base) {
  u32x4 w; w[0] = cvtpk(pv[base], pv[base + 1]); w[1] = cvtpk(pv[base + 2], pv[base + 3]); w[2] = cvtpk(pv[base + 4], pv[base + 5]); w[3] = cvtpk(pv[base + 6], pv[base + 7]);
  return *(bf16x8*)&w;
}
__device__ __forceinline__ bf16x8 ld_vfrag(const char* base) { return *(const bf16x8*)base; }
__device__ __forceinline__ int kperm(int r) { return (r & ~12) | ((r & 4) << 1) | ((r & 8) >> 1); }

constexpr int MLA_KS = 400, MLA_KBYTES = 64 * MLA_KS, VT_S = 144, MLA_VBYTES = 128 * VT_S, MLA_STAGE = MLA_KBYTES + MLA_VBYTES;
constexpr int DF_KS = 144, DF_KBYTES = 64 * DF_KS, DF_VBYTES = 64 * VT_S, DF_STAGE = DF_KBYTES + DF_VBYTES;

template <int NKS>
__device__ __forceinline__ f32x16 qk_tile(const char* krow, const bf16x8* qf, const f32x16& negm) {
  f32x16 p = __builtin_amdgcn_mfma_f32_32x32x16_bf16(*(const bf16x8*)krow, qf[0], negm, 0, 0, 0);
#pragma unroll
  for (int ks = 1; ks < NKS; ++ks) p = __builtin_amdgcn_mfma_f32_32x32x16_bf16(*(const bf16x8*)(krow + ks * 32), qf[ks], p, 0, 0, 0);
  return p;
}
template <int NOB>
__device__ __forceinline__ void sm_pv(f32x16& p, const char* vrow, f32x16& negm, float& m, f32x16& lacc, f32x16* oT, bool first, f32x16* pend) {
  float pm = p[0];
#pragma unroll
  for (int r = 1; r < 16; ++r) pm = fmaxf(pm, p[r]);
  if (first || !__all(pm <= 8.f)) {
    const float pmx = fmaxf(pm, __shfl_xor(pm, 32));
    const float d = first ? pmx : fmaxf(pmx, 0.f);
    if (!first) { const float alpha = fexp2(-d); lacc *= alpha;
#pragma unroll
      for (int nb = 0; nb < NOB; ++nb) oT[nb] *= alpha; }
    m += d;
#pragma unroll
    for (int r = 0; r < 16; ++r) { negm[r] = -m; p[r] -= d; }
    if (pend) {
#pragma unroll
      for (int r = 0; r < 16; ++r) (*pend)[r] -= d; }
  }
#pragma unroll
  for (int r = 0; r < 16; ++r) p[r] = fexp2(p[r]);
  const bf16x8 pb0 = pack8(p, 0), pb1 = pack8(p, 8);
  const bf16x8 ones = {0x3F80, 0x3F80, 0x3F80, 0x3F80, 0x3F80, 0x3F80, 0x3F80, 0x3F80};
  lacc = __builtin_amdgcn_mfma_f32_32x32x16_bf16(ones, pb0, lacc, 0, 0, 0);
  lacc = __builtin_amdgcn_mfma_f32_32x32x16_bf16(ones, pb1, lacc, 0, 0, 0);
#pragma unroll
  for (int nb = 0; nb < NOB; ++nb) {
    oT[nb] = __builtin_amdgcn_mfma_f32_32x32x16_bf16(ld_vfrag(vrow + nb * 32 * VT_S), pb0, oT[nb], 0, 0, 0);
    oT[nb] = __builtin_amdgcn_mfma_f32_32x32x16_bf16(ld_vfrag(vrow + nb * 32 * VT_S + 32), pb1, oT[nb], 0, 0, 0);
  }
}

template <int NOB, int VS = VT_S>
__device__ __forceinline__ void sm_pv_sv(f32x16& p, const char* vrow, f32x16& negm, float& m, float& l, f32x16* oT, bool first) {
  float pm = p[0];
#pragma unroll
  for (int r = 1; r < 16; ++r) pm = fmaxf(pm, p[r]);
  if (first || !__all(pm <= 8.f)) {
    const float pmx = fmaxf(pm, __shfl_xor(pm, 32));
    const float d = first ? pmx : fmaxf(pmx, 0.f);
    if (!first) { const float alpha = fexp2(-d); l *= alpha;
#pragma unroll
      for (int nb = 0; nb < NOB; ++nb) oT[nb] *= alpha; }
    m += d;
#pragma unroll
    for (int r = 0; r < 16; ++r) { negm[r] = -m; p[r] -= d; }
  }
  float ps = 0.f;
#pragma unroll
  for (int r = 0; r < 16; ++r) { p[r] = fexp2(p[r]); ps += p[r]; }
  l += ps;
  const bf16x8 pb0 = pack8(p, 0), pb1 = pack8(p, 8);
#pragma unroll
  for (int nb = 0; nb < NOB; ++nb) {
    oT[nb] = __builtin_amdgcn_mfma_f32_32x32x16_bf16(ld_vfrag(vrow + nb * 32 * VS), pb0, oT[nb], 0, 0, 0);
    oT[nb] = __builtin_amdgcn_mfma_f32_32x32x16_bf16(ld_vfrag(vrow + nb * 32 * VS + 32), pb1, oT[nb], 0, 0, 0);
  }
}

template <int NOB>
__device__ __forceinline__ void sm_pv_valu(f32x16& p, const char* vrow, float& m, float& l, f32x16* oT, bool first) {
  float pm = p[0];
#pragma unroll
  for (int r = 1; r < 16; ++r) pm = fmaxf(pm, p[r]);
  if (first || !__all(pm <= m + 8.f)) {
    const float pmx = fmaxf(pm, __shfl_xor(pm, 32));
    const float mn = first ? pmx : fmaxf(m, pmx);
    if (!first) { const float alpha = fexp2(m - mn); l *= alpha;
#pragma unroll
      for (int nb = 0; nb < NOB; ++nb) oT[nb] *= alpha; }
    m = mn;
  }
  float ps = 0.f;
#pragma unroll
  for (int r = 0; r < 16; ++r) { p[r] = fexp2(p[r] - m); ps += p[r]; }
  l += ps;
  const bf16x8 pb0 = pack8(p, 0), pb1 = pack8(p, 8);
#pragma unroll
  for (int nb = 0; nb < NOB; ++nb) {
    oT[nb] = __builtin_amdgcn_mfma_f32_32x32x16_bf16(ld_vfrag(vrow + nb * 32 * VT_S), pb0, oT[nb], 0, 0, 0);
    oT[nb] = __builtin_amdgcn_mfma_f32_32x32x16_bf16(ld_vfrag(vrow + nb * 32 * VT_S + 32), pb1, oT[nb], 0, 0, 0);
  }
}

__device__ __forceinline__ void attn_mla_item(PP pp, int b, int h, int tq0, int NT, char* lds) {
  const bf16_t* Qm = (const bf16_t*)(pp->ws + OFF_QM); const bf16_t* Km = (const bf16_t*)(pp->ws + OFF_KM); const bf16_t* Kr = (const bf16_t*)(pp->ws + OFF_KR);
  const bf16_t* VmT = (const bf16_t*)(pp->ws + OFF_VMT) + (size_t)(b * 4 + h) * 128 * SB; bf16_t* Y = (bf16_t*)(pp->ws + OFF_Y);
  const int tid = get_tid(), lane = tid & 63, wid = tid >> 6, c31 = lane & 31, hi = lane >> 5;
  const int tk0 = b * SB;
  bf16x8 qf[12];
  { const bf16_t* qp = Qm + (size_t)(tq0 + 32 * wid + c31) * 768 + h * 192 + hi * 8;
#pragma unroll
    for (int ks = 0; ks < 12; ++ks) qf[ks] = *(const bf16x8*)(qp + ks * 16); }
  f32x16 oT[4];
#pragma unroll
  for (int nb = 0; nb < 4; ++nb)
#pragma unroll
    for (int r = 0; r < 16; ++r) oT[nb][r] = 0.f;
  float m = 0.f, l = 0.f; f32x16 negm;
#pragma unroll
  for (int r = 0; r < 16; ++r) negm[r] = 0.f;
  u32x4 rk0, rk1, rk2, rv0, rv1;
  int kkey[3], kc[3];
#pragma unroll
  for (int i = 0; i < 3; ++i) { const int id = tid + 512 * i; kkey[i] = id / 24; kc[i] = id % 24; }
  const int vdv0 = tid >> 3, vkc = tid & 7;
#define A_KSRC(i, key0) (kc[i] < 16 ? Km + (size_t)(tk0 + (key0) + kkey[i]) * 512 + h * 128 + kc[i] * 8 : Kr + (size_t)(tk0 + (key0) + kkey[i]) * 64 + (kc[i] - 16) * 8)
#define A_LOAD(key0) do { rk0 = *(const u32x4*)A_KSRC(0, key0); rk1 = *(const u32x4*)A_KSRC(1, key0); rk2 = *(const u32x4*)A_KSRC(2, key0); \
    rv0 = *(const u32x4*)(VmT + (size_t)vdv0 * SB + (key0) + vkc * 8); rv1 = *(const u32x4*)(VmT + (size_t)(vdv0 + 64) * SB + (key0) + vkc * 8); } while (0)
#define A_STORE(s) do { char* kb_ = lds + (s) * MLA_STAGE; char* vb_ = kb_ + MLA_KBYTES; \
    *(u32x4*)(kb_ + kkey[0] * MLA_KS + kc[0] * 16) = rk0; *(u32x4*)(kb_ + kkey[1] * MLA_KS + kc[1] * 16) = rk1; *(u32x4*)(kb_ + kkey[2] * MLA_KS + kc[2] * 16) = rk2; \
    { char* d_ = vb_ + vdv0 * VT_S + vkc * 16; *(u32x4*)d_ = rv0; *(u32x4*)(d_ + 64 * VT_S) = rv1; } } while (0)
  A_LOAD(0); A_STORE(0); __syncthreads();
  for (int t = 0; t < NT; ++t) {
    const int s = t & 1;
    if (t + 1 < NT) A_LOAD((t + 1) * 64);
    const char* kb = lds + s * MLA_STAGE; const char* vb = kb + MLA_KBYTES;
    const char* ka = kb + kperm(c31) * MLA_KS + hi * 16; const char* va = vb + c31 * VT_S + hi * 16;
    f32x16 pa = qk_tile<12>(ka, qf, negm);
    sm_pv_sv<4>(pa, va, negm, m, l, oT, t == 0);
    f32x16 pbb = qk_tile<12>(ka + 32 * MLA_KS, qf, negm);
    sm_pv_sv<4>(pbb, va + 64, negm, m, l, oT, false);
    if (t + 1 < NT) A_STORE(s ^ 1);
    __syncthreads();
  }
#undef A_KSRC
#undef A_LOAD
#undef A_STORE
  l += __shfl_xor(l, 32);
  const float il = 1.f / l;
  bf16_t* yp = Y + (size_t)(tq0 + 32 * wid + c31) * KP + h * 128;
#pragma unroll
  for (int nb = 0; nb < 4; ++nb)
#pragma unroll
    for (int i4 = 0; i4 < 4; ++i4) { u32x2 w; w[0] = cvtpk(oT[nb][4 * i4] * il, oT[nb][4 * i4 + 1] * il); w[1] = cvtpk(oT[nb][4 * i4 + 2] * il, oT[nb][4 * i4 + 3] * il);
      *(u32x2*)(yp + 32 * nb + 8 * i4 + 4 * hi) = w; }
}

__device__ __forceinline__ void attn_diff_item(PP pp, int l, int b, int h, int tq0, int NT, float lam, float lam_init, char* lds) {
  const bf16_t* Qd = (const bf16_t*)(pp->ws + OFF_QD); const bf16_t* Kd = (const bf16_t*)(pp->ws + OFF_KD);
  const bf16_t* VdT = (const bf16_t*)(pp->ws + OFF_VDT) + (size_t)(b * 4 + h) * 64 * SB; bf16_t* Y = (bf16_t*)(pp->ws + OFF_Y);
  const int tid = get_tid(), lane = tid & 63, wid = tid >> 6, c31 = lane & 31, hi = lane >> 5;
  const int tk0 = b * SB;
  bf16x8 qf[2][2];
  { const bf16_t* qp = Qd + (size_t)(tq0 + 32 * wid + c31) * 256 + h * 64 + hi * 8;
#pragma unroll
    for (int mp = 0; mp < 2; ++mp)
#pragma unroll
      for (int ks = 0; ks < 2; ++ks) qf[mp][ks] = *(const bf16x8*)(qp + mp * 32 + ks * 16); }
  f32x16 oA[2], oB[2];
#pragma unroll
  for (int nb = 0; nb < 2; ++nb)
#pragma unroll
    for (int r = 0; r < 16; ++r) { oA[nb][r] = 0.f; oB[nb][r] = 0.f; }
  float mA = 0.f, mB = 0.f, lA = 0.f, lB = 0.f; f32x16 negA, negB;
#pragma unroll
  for (int r = 0; r < 16; ++r) { negA[r] = 0.f; negB[r] = 0.f; }
  constexpr int DV2S = 272, D2K = 128 * DF_KS, D2STAGE = D2K + 64 * DV2S;
  u32x4 rk, rk2, rv, rv2;
  const int kkey = tid >> 3, kch = tid & 7;
#define D_LOAD(key0) do { const bf16_t* kp_ = Kd + (size_t)(tk0 + (key0) + kkey) * 256 + h * 64 + kch * 8; rk = *(const u32x4*)kp_; rk2 = *(const u32x4*)(kp_ + 64 * 256); \
    const bf16_t* vp_ = VdT + (size_t)kkey * SB + (key0) + kch * 8; rv = *(const u32x4*)vp_; rv2 = *(const u32x4*)(vp_ + 64); } while (0)
#define D_STORE(s) do { char* kb_ = lds + (s) * D2STAGE; char* vb_ = kb_ + D2K; *(u32x4*)(kb_ + kkey * DF_KS + kch * 16) = rk; *(u32x4*)(kb_ + (kkey + 64) * DF_KS + kch * 16) = rk2; \
    *(u32x4*)(vb_ + kkey * DV2S + kch * 16) = rv; *(u32x4*)(vb_ + kkey * DV2S + 128 + kch * 16) = rv2; } while (0)
  const int NT2 = NT >> 1;
  D_LOAD(0); D_STORE(0); __syncthreads();
  for (int t = 0; t < NT2; ++t) {
    const int s = t & 1;
    if (t + 1 < NT2) D_LOAD((t + 1) * 128);
    const char* kb = lds + s * D2STAGE; const char* vb = kb + D2K;
#pragma unroll
    for (int sub = 0; sub < 2; ++sub) {
      const char* ka = kb + (kperm(c31) + 64 * sub) * DF_KS + hi * 16; const char* va = vb + c31 * DV2S + hi * 16 + 128 * sub;
      const bool f0 = (t == 0) && (sub == 0);
      f32x16 pA0 = qk_tile<2>(ka, qf[0], negA);
      f32x16 pB0 = qk_tile<2>(ka + 64, qf[1], negB);
      sm_pv_sv<2, DV2S>(pA0, va, negA, mA, lA, oA, f0);
      f32x16 pA1 = qk_tile<2>(ka + 32 * DF_KS, qf[0], negA);
      sm_pv_sv<2, DV2S>(pB0, va, negB, mB, lB, oB, f0);
      f32x16 pB1 = qk_tile<2>(ka + 32 * DF_KS + 64, qf[1], negB);
      sm_pv_sv<2, DV2S>(pA1, va + 64, negA, mA, lA, oA, false);
      sm_pv_sv<2, DV2S>(pB1, va + 64, negB, mB, lB, oB, false);
    }
    if (t + 1 < NT2) D_STORE(s ^ 1);
    __syncthreads();
  }
#undef D_LOAD
#undef D_STORE
  lA += __shfl_xor(lA, 32); lB += __shfl_xor(lB, 32);
  const float ia = 1.f / lA, ib = lam / lB;
  float ss = 0.f;
#pragma unroll
  for (int nb = 0; nb < 2; ++nb)
#pragma unroll
    for (int r = 0; r < 16; ++r) { const float d = oA[nb][r] * ia - oB[nb][r] * ib; oA[nb][r] = d; ss += d * d; }
  ss += __shfl_xor(ss, 32);
  const float rs = rsqrtf(ss * (1.f / 64.f) + EPS) * (1.f - lam_init);
  const float* g = pp->subln_g + l * 64;
  bf16_t* yp = Y + (size_t)(tq0 + 32 * wid + c31) * KP + 512 + h * 64;
#pragma unroll
  for (int nb = 0; nb < 2; ++nb)
#pragma unroll
    for (int i4 = 0; i4 < 4; ++i4) { const int dv = 32 * nb + 8 * i4 + 4 * hi; const f32x4 gg = *(const f32x4*)(g + dv);
      u32x2 w; w[0] = cvtpk(oA[nb][4 * i4] * rs * gg[0], oA[nb][4 * i4 + 1] * rs * gg[1]); w[1] = cvtpk(oA[nb][4 * i4 + 2] * rs * gg[2], oA[nb][4 * i4 + 3] * rs * gg[3]);
      *(u32x2*)(yp + dv) = w; }
}

__device__ __forceinline__ void phase_attn(PP pp, int l, bool need_ctx, char* lds) {
  const int n_items = 256 + (need_ctx ? 8 : 0);
  for (int it = get_bid(); it < n_items; it += gridDim.x) {
    const int bh = it & 7, b = bh >> 2, h = bh & 3; const bool lat = it < 256;
    attn_mla_item(pp, b, h, lat ? b * SB + CTX + (it >> 3) * 256 : b * SB, lat ? SB / 64 : CTX / 64, lds);
  }
  float d1 = 0.f, d2 = 0.f;
#pragma unroll 1
  for (int i = 0; i < 32; ++i) { d1 += pp->lq1[l * 32 + i] * pp->lk1[l * 32 + i]; d2 += pp->lq2[l * 32 + i] * pp->lk2[l * 32 + i]; }
  const float lam_init = 0.8f - 0.6f * __expf(-0.3f * (float)l);
  const float lam = __expf(d1) - __expf(d2) + lam_init;
  for (int it = get_bid(); it < n_items; it += gridDim.x) {
    const int bh = it & 7, b = bh >> 2, h = bh & 3; const bool lat = it < 256;
    attn_diff_item(pp, l, b, h, lat ? b * SB + CTX + (it >> 3) * 256 : b * SB, lat ? SB / 64 : CTX / 64, lam, lam_init, lds);
  }
}

__device__ __forceinline__ void phase_res_gemm(PP pp, int l, const bf16_t* A, int K, int ld, const bf16_t* Bt, int gchunk, bool skip_ctx, char* lds) {
  const float* mod = (const float*)(pp->ws + OFF_MOD) + (size_t)l * 3 * 6144;
  const int tid = get_tid(), lane = tid & 63, c31 = lane & 31, hi = lane >> 5;
  float* ut = (float*)lds;
  for (int it0 = get_bid(); it0 < 64 * 4; it0 += gridDim.x) {
    const int it = gridDim.x == 256 ? (((it0 & 7) * 8 + (it0 >> 5)) << 2) + ((it0 >> 3) & 3) : it0;
    const int mi = it >> 2, nt2 = it & 3, mt = (mi >> 5) * 33 + 1 + (mi & 31), row0 = mt * 256, b = mt / 33;
    const float* gv = mod + (size_t)b * 6144 + gchunk * 1024;
    auto post = [&](int h) {
      const int cc = tid & 15, col = nt2 * 256 + h * 128 + cc * 8;
      const f32x4 g0 = *(const f32x4*)(gv + col), g1 = *(const f32x4*)(gv + col + 4);
#pragma unroll 2
      for (int i = 0; i < 8; ++i) {
        const int row = (tid >> 4) + 32 * i; const float* up = ut + row * 128 + cc * 8;
        float* xp = xrow(pp, row0 + row) + col;
        const f32x4 ua = *(const f32x4*)up, ub = *(const f32x4*)(up + 4);
        f32x4 xa = *(const f32x4*)xp, xb = *(const f32x4*)(xp + 4);
        xa = xa * DN_ALPHA + g0 * ua; xb = xb * DN_ALPHA + g1 * ub;
        *(f32x4*)xp = xa; *(f32x4*)(xp + 4) = xb;
      }
    };
    gemm_tile256b(A, ld, RowId{row0}, Bt, ld, nt2 * 256, K, lds, post);
  }
  if (!skip_ctx) {
    const float* gv = mod + (size_t)2 * 6144 + gchunk * 1024;
    const int Kc = K >> 2;
    for (int it = get_bid(); it < 64; it += gridDim.x) {
      const int sp = it & 3, nt = (it >> 2) & 7, row0 = (it >> 5) * 33 * 256;
      auto epi = [&](f32x16 (&acc)[2][2], int rbase, int cbase) {
#pragma unroll
        for (int mb = 0; mb < 2; ++mb)
#pragma unroll
          for (int nb = 0; nb < 2; ++nb) { const int col = cbase + 32 * nb + c31; const float g = gv[col];
#pragma unroll
            for (int r = 0; r < 16; ++r) atomicAdd(xrow(pp, row0 + rbase + 32 * mb + crow(r, hi)) + col, g * acc[mb][nb][r]); }
      };
      gemm_tile(A + sp * Kc, ld, RowId{row0}, Bt + sp * Kc, ld, nt * 128, Kc, lds, epi);
    }
  }
}

__device__ __forceinline__ void phase_ffn_up(PP pp, int l, char* lds) {
  const bf16_t* A = (const bf16_t*)(pp->ws + OFF_HMOD);
  const bf16_t* Bt = (const bf16_t*)(pp->ws + OFF_W) + (size_t)l * W_LAYER + W_UP;
  bf16_t* A2 = (bf16_t*)(pp->ws + OFF_A2);
  const float* cw = pp->ffn_convw + (size_t)l * 3 * 5632; const float* cb = pp->ffn_convb + (size_t)l * 5632;
  const int tid = get_tid(), lane = tid & 63, c31 = lane & 31, hi = lane >> 5;
  float* ut = (float*)lds;
  const bool xmap = gridDim.x == 256; const int xq = get_bid() & 7, xj = get_bid() >> 3;
  const int n_it = xmap ? 6 * 32 : 67 * 22;
  for (int it = xmap ? xj : get_bid(); it < n_it; it += xmap ? 32 : gridDim.x) {
    int mt, nt2;
    if (xmap) { mt = 4 * (it / 11) + (xq >> 1); nt2 = 11 * (xq & 1) + it % 11; if (mt >= 67) continue; }
    else { mt = it / 22; nt2 = it % 22; }
    const int o0 = mt * 254;
    auto post = [&](int h) {
      const int nt = 2 * nt2 + h;
    {
      const int fp = tid & 31, rg = tid >> 5, f = nt * 64 + 2 * fp;
      const int cg = (fp >> 4) * 64 + ((2 * fp) & 31), cv = cg + 32;
      const f32x2 wg0 = *(const f32x2*)(cw + f), wg1 = *(const f32x2*)(cw + 5632 + f), wg2 = *(const f32x2*)(cw + 2 * 5632 + f), bg = *(const f32x2*)(cb + f);
      const f32x2 wv0 = *(const f32x2*)(cw + DFF + f), wv1 = *(const f32x2*)(cw + 5632 + DFF + f), wv2 = *(const f32x2*)(cw + 2 * 5632 + DFF + f), bv = *(const f32x2*)(cb + DFF + f);
      int i0 = rg * 16; int i1 = i0 + 16; if (i0 < 1) i0 = 1; if (i1 > 255) i1 = 255;
      if (i1 > T - (o0 - 1)) i1 = T - (o0 - 1);
      f32x2 gp = *(const f32x2*)(ut + (i0 - 1) * 128 + cg), gc = *(const f32x2*)(ut + i0 * 128 + cg);
      f32x2 vp = *(const f32x2*)(ut + (i0 - 1) * 128 + cv), vc = *(const f32x2*)(ut + i0 * 128 + cv);
      int t = o0 - 1 + i0; int j = t % SB;
      bf16_t* dst = A2 + (size_t)t * DFF + f;
      for (int i = i0; i < i1; ++i) {
        const f32x2 gn = *(const f32x2*)(ut + (i + 1) * 128 + cg), vn = *(const f32x2*)(ut + (i + 1) * 128 + cv);
        f32x2 gate = wg1 * gc + bg, val = wv1 * vc + bv;
        if (j != 0 && j != CTX) { gate += wg0 * gp; val += wv0 * vp; }
        if (j != CTX - 1 && j != SB - 1) { gate += wg2 * gn; val += wv2 * vn; }
        *(unsigned*)dst = cvtpk(silu_f(gate[0]) * val[0], silu_f(gate[1]) * val[1]);
        dst += DFF; j = (j == SB - 1) ? 0 : j + 1;
        gp = gc; gc = gn; vp = vc; vc = vn;
      }
    }
    };
    gemm_tile256b(A, KP, RowHalo{o0 - 1}, Bt, KP, nt2 * 256, DM, lds, post);
  }
}


#define XB_TMO      128
#define XB_XCNT(j)  (256  + 64 * (j))
#define XB_XSUB(j)  (1280 + 64 * (j))
#define XB_XGEN(j)  (2304 + 64 * (j))
#define XB_TOP      3328
#define XB_TOPGEN   3392
#define XCD_BAR_WORDS 3456
#define XB_SPIN_CAP (1u << 18)
#define LAS __attribute__((address_space(3)))

__device__ __forceinline__ unsigned xb_ld(unsigned* p)              { return __hip_atomic_load(p, __ATOMIC_RELAXED, __HIP_MEMORY_SCOPE_AGENT); }
__device__ __forceinline__ unsigned xb_add(unsigned* p, unsigned v) { return __hip_atomic_fetch_add(p, v, __ATOMIC_RELAXED, __HIP_MEMORY_SCOPE_AGENT); }
__device__ __forceinline__ unsigned xb_xcc_id() { return (unsigned)__builtin_amdgcn_s_getreg((3 << 11) | 20) & 0xFu; }
#define XB_SPIN(cond, bar) do { unsigned _sp = 0; while (cond) { __builtin_amdgcn_s_sleep(1); \
    if ((++_sp & 255u) == 0u) { if (xb_ld(&(bar)[XB_TMO])) break; if (_sp > XB_SPIN_CAP) { atomicAdd(&(bar)[XB_TMO], 1u); break; } } } } while (0)

struct XcdBarrier {
    unsigned* bar; unsigned x;
    volatile LAS unsigned* st;
};

__device__ __forceinline__ XcdBarrier xcd_barrier_post(unsigned* bar, volatile LAS unsigned* st) {
    XcdBarrier b; b.bar = bar; b.x = xb_xcc_id(); b.st = st;
    if (get_tid() == 0) (void)xb_add(&bar[XB_XCNT(b.x)], 1u);
    return b;
}
__device__ __forceinline__ void xcd_barrier_complete(unsigned* bar, unsigned x, unsigned& nloc, unsigned& nx) {
    const unsigned G = gridDim.x * gridDim.y * gridDim.z;
    unsigned sum, cnt, mine, sp = 0u;
    for (;;) {
        sum = 0u; cnt = 0u; mine = 0u;
#pragma unroll
        for (unsigned j = 0; j < 16; ++j) { const unsigned c = xb_ld(&bar[XB_XCNT(j)]); sum += c; cnt += (c > 0u) ? 1u : 0u; mine = (j == x) ? c : mine; }
        if (sum == G) break;
        __builtin_amdgcn_s_sleep(1);
        if ((++sp & 255u) == 0u) { if (xb_ld(&bar[XB_TMO])) break; if (sp > XB_SPIN_CAP) { atomicAdd(&bar[XB_TMO], 1u); break; } }
    }
    nloc = mine > 0u ? mine : 1u; nx = cnt > 0u ? cnt : 1u;
}

__device__ __forceinline__ void xcd_barrier(const XcdBarrier& b) {
    asm volatile("s_waitcnt vmcnt(0)" ::: "memory");
    __syncthreads();
    if (get_tid() == 0) {
        unsigned* bar = b.bar;
        __builtin_amdgcn_s_waitcnt(0);
        unsigned nloc = b.st[0], nx = b.st[1];
        if (nloc == 0u) { xcd_barrier_complete(bar, b.x, nloc, nx); b.st[0] = nloc; b.st[1] = nx; }
        const unsigned old = xb_add(&bar[XB_XSUB(b.x)], 1u);
        const unsigned gen = old / nloc;
        if (old + 1u == (gen + 1u) * nloc) {
            __builtin_amdgcn_fence(__ATOMIC_RELEASE, "agent");
            asm volatile("s_waitcnt vmcnt(0)" ::: "memory");
            const unsigned og = xb_add(&bar[XB_TOP], 1u);
            const unsigned tg = og / nx;
            if (og + 1u == (tg + 1u) * nx) xb_add(&bar[XB_TOPGEN], 1u);
            else XB_SPIN(xb_ld(&bar[XB_TOPGEN]) == tg, bar);
            __builtin_amdgcn_fence(__ATOMIC_ACQUIRE, "agent");
            xb_add(&bar[XB_XGEN(b.x)], 1u);
            asm volatile("s_waitcnt vmcnt(0)" ::: "memory");
        } else {
            XB_SPIN(xb_ld(&bar[XB_XGEN(b.x)]) == gen, bar);
            __builtin_amdgcn_fence(__ATOMIC_ACQUIRE, "agent");
            asm volatile("s_waitcnt vmcnt(0)" ::: "memory");
        }
    }
    __syncthreads();
}

constexpr size_t OFF_BAR = OFF_END;
constexpr int LDS_XB = 3 * 49152 + 1024;
__device__ __forceinline__ void grid_bar(PP pp, char* lds) {
  XcdBarrier b; b.bar = (unsigned*)(pp->ws + OFF_BAR); b.x = xb_xcc_id(); b.st = (volatile LAS unsigned*)(lds + LDS_XB);
  xcd_barrier(b);
}
__global__ void __launch_bounds__(512) fwd_megakernel(Params p_arg) {
  extern __shared__ __attribute__((aligned(16))) char lds[];
  cg::grid_group grid = cg::this_grid();
  PP pp = (PP)__builtin_amdgcn_kernarg_segment_ptr();
  { const int t0_ = get_tid(); if (t0_ < 4) ((volatile LAS unsigned*)(lds + LDS_XB))[t0_] = 0u; }
  __syncthreads();
  (void)xcd_barrier_post((unsigned*)(pp->ws + OFF_BAR), (volatile LAS unsigned*)(lds + LDS_XB));
  grid.sync();
  phase0(launder(pp), lds);
  grid_bar(launder(pp), lds);
  row_pass(launder(pp), 0, nullptr, nullptr, 0, 0, 1, true, false, NLAYER > 1);
  grid_bar(launder(pp), lds);
#pragma unroll 1
  for (int l = 0; l < NLAYER; ++l) {
    const bool last = (l == NLAYER - 1);
    const bf16_t* wl = (const bf16_t*)(pp->ws + OFF_W) + (size_t)l * W_LAYER;
    phase_win(launder(pp), l, lds);
    grid_bar(launder(pp), lds);
    phase_up2(launder(pp), l, lds);
    grid_bar(launder(pp), lds);
    phase_attn(launder(pp), l, !last, lds);
    grid_bar(launder(pp), lds);
    phase_res_gemm(launder(pp), l, (const bf16_t*)(pp->ws + OFF_Y), 1024, KP, wl + W_O, 2, last, lds);
    grid_bar(launder(pp), lds);
    row_pass(launder(pp), 1, pp->ln1_g + l * DM, pp->ln1_b + l * DM, l, 3, 4, true, last, !last);
    grid_bar(launder(pp), lds);
    phase_ffn_up(launder(pp), l, lds);
    grid_bar(launder(pp), lds);
    phase_res_gemm(launder(pp), l, (const bf16_t*)(pp->ws + OFF_A2), DFF, DFF, wl + W_DN, 5, last, lds);
    grid_bar(launder(pp), lds);
    row_pass(launder(pp), 1, pp->ln2_g + l * DM, pp->ln2_b + l * DM, l + 1, 0, 1, !last, last, l + 2 < NLAYER);
    if (!last) grid_bar(launder(pp), lds);
  }
}

extern "C" void kernel_launch(void* const* d_in, const int* in_sizes, int n_in, void* d_out, int out_size, void* d_ws, size_t ws_size, hipStream_t stream) {
  static int grid_blocks = 0;
  if (!grid_blocks) {
    int dev = 0, cus = 0, per_cu = 0;
    hipGetDevice(&dev);
    hipDeviceGetAttribute(&cus, hipDeviceAttributeMultiprocessorCount, dev);
    hipFuncSetAttribute((const void*)fwd_megakernel, hipFuncAttributeMaxDynamicSharedMemorySize, LDS_BYTES);
    hipOccupancyMaxActiveBlocksPerMultiprocessor(&per_cu, fwd_megakernel, 512, LDS_BYTES);
    if (per_cu < 1) { fprintf(stderr, "occupancy query returned %d\n", per_cu); per_cu = 1; }
    if (per_cu > 1) per_cu = 1;
    grid_blocks = cus * per_cu;
  }
  Params p{};
  const float** f = (const float**)&p;
  for (int i = 0; i < 29; ++i) f[i] = (const float*)d_in[i];
  p.out = (float*)d_out; p.ws = (char*)d_ws;
  (void)hipMemsetAsync((char*)d_ws + OFF_BAR, 0, XCD_BAR_WORDS * sizeof(unsigned), stream);
  void* args[] = {&p};
  hipError_t e = hipLaunchCooperativeKernel((void*)fwd_megakernel, dim3(grid_blocks), dim3(512), args, LDS_BYTES, stream);
  if (e != hipSuccess) fprintf(stderr, "cooperative launch failed: %s (grid %d)\n", hipGetErrorString(e), grid_blocks);
}
```

```cpp
#include <hip/hip_runtime.h>
#include <hip/hip_cooperative_groups.h>
#include <stdint.h>
#include <cstdio>
namespace cg = cooperative_groups;

typedef unsigned short bf16_t;
typedef short bf16x8 __attribute__((ext_vector_type(8)));
typedef float f32x16 __attribute__((ext_vector_type(16)));
typedef float f32x4 __attribute__((ext_vector_type(4)));
typedef float f32x2 __attribute__((ext_vector_type(2)));
typedef unsigned u32x4 __attribute__((ext_vector_type(4)));
typedef unsigned u32x2 __attribute__((ext_vector_type(2)));

constexpr int DM = 1024, NBATCH = 2, SEQ = 8192, CTX = 256, SB = SEQ + CTX  , T = NBATCH * SB  ;
constexpr int INW = 1984, DFF = 2816, NLAYER = 2;
constexpr int KP = 1088;
constexpr float EPS = 1e-6f;
constexpr float DN_ALPHA = 1.4142135623730951f;
constexpr float LOG2E = 1.4426950408889634f;
constexpr float QS_MLA = 0.07216878364870322f * LOG2E;
constexpr float QS_DIFF = 0.17677669529663687f * LOG2E;

constexpr size_t al256(size_t x) { return (x + 255) / 256 * 256; }
constexpr size_t W_IN = 0;
constexpr size_t W_UQ = W_IN + 2048ull * KP;
constexpr size_t W_UKV = W_UQ + 768ull * 384;
constexpr size_t W_O = W_UKV + 1024ull * 256;
constexpr size_t W_UP = W_O + 1024ull * KP;
constexpr size_t W_DN = W_UP + 5632ull * KP;
constexpr size_t W_SG = W_DN + 1024ull * 2816;
constexpr size_t W_LAYER = W_SG + 4ull * 128 * 128;
constexpr size_t OFF_W = 0;
constexpr size_t OFF_MOD = al256(OFF_W + W_LAYER * 2 * NLAYER);
constexpr size_t OFF_CS16 = al256(OFF_MOD + 2ull * 3 * 6144 * 4);
constexpr size_t OFF_CS8 = al256(OFF_CS16 + 128ull * 16 * 8);
constexpr size_t OFF_CTXRES = al256(OFF_CS8 + 128ull * 8 * 8);
constexpr size_t OFF_HMOD = al256(OFF_CTXRES + 512ull * 1024 * 4);
constexpr size_t OFF_R = al256(OFF_HMOD + (size_t)T * KP * 2);
constexpr size_t OFF_ZQ = OFF_R;
constexpr size_t OFF_KR = al256(OFF_ZQ + (size_t)T * 640 * 2);
constexpr size_t OFF_QD = al256(OFF_KR + (size_t)T * 64 * 2);
constexpr size_t OFF_KD = al256(OFF_QD + (size_t)T * 256 * 2);
constexpr size_t OFF_VDT = al256(OFF_KD + (size_t)T * 256 * 2);
constexpr size_t OFF_ZC = al256(OFF_VDT + (size_t)T * 256 * 2);
constexpr size_t OFF_QM = al256(OFF_ZC + (size_t)T * 512 * 2);
constexpr size_t OFF_KM = al256(OFF_QM + (size_t)T * 768 * 2);
constexpr size_t OFF_VMT = al256(OFF_KM + (size_t)T * 512 * 2);
constexpr size_t OFF_Y = al256(OFF_VMT + (size_t)T * 512 * 2);
constexpr size_t OFF_END = al256(OFF_Y + (size_t)T * KP * 2);
constexpr size_t OFF_A2 = OFF_R;
static_assert(OFF_A2 + (size_t)T * 2816 * 2 <= OFF_END, "A2 alias fits");
constexpr size_t OFF_SSQ = OFF_END + 16384;
static_assert(OFF_SSQ + (size_t)T * 8 <= 268435456ull, "workspace fits 256 MiB");

constexpr int LDS_A_STAGE = 256 * 144, LDS_B_STAGE = 128 * 144;
constexpr int LDS_GEMM = 2 * (LDS_A_STAGE + LDS_B_STAGE);
constexpr int LDS_RSTD = 3 * 49152;
constexpr int LDS_BYTES = 3 * 49152 + 1024 + 16;

struct Params {
  const float *x, *c, *ctx, *c_ctx, *ada_w, *ada_b, *w_in, *mla_gq, *mla_wuq, *mla_gkv, *mla_wukv;
  const float *lq1, *lk1, *lq2, *lk2, *subln_g, *sgu_ln_g, *sgu_ln_b, *sgu_ws, *sgu_bs, *w_o, *ln1_g, *ln1_b;
  const float *ffn_wup, *ffn_convw, *ffn_convb, *ffn_wdown, *ln2_g, *ln2_b;
  float* out; char* ws;
};
typedef const __attribute__((address_space(4))) Params* PP;
__device__ __forceinline__ PP launder(PP q) { asm volatile("" : "+s"(q)); return q; }

__device__ __forceinline__ int get_tid() { int t = threadIdx.x; asm volatile("" : "+v"(t)); return t; }
__device__ __forceinline__ int get_bid() { int t = blockIdx.x; asm volatile("" : "+s"(t)); return t; }
typedef __bf16 bf16x2_t __attribute__((ext_vector_type(2)));
__device__ __forceinline__ unsigned cvtpk(float lo, float hi) { f32x2 v = {lo, hi}; bf16x2_t b = __builtin_convertvector(v, bf16x2_t); return __builtin_bit_cast(unsigned, b); }
__device__ __forceinline__ bf16_t f2bf(float x) { return (bf16_t)(cvtpk(x, 0.f) & 0xffffu); }
__device__ __forceinline__ float bf2f(bf16_t v) { return __uint_as_float(((unsigned)v) << 16); }
__device__ __forceinline__ float bflo(unsigned w) { return __uint_as_float(w << 16); }
__device__ __forceinline__ float bfhi(unsigned w) { return __uint_as_float(w & 0xffff0000u); }
__device__ __forceinline__ int crow(int r, int hi) { return (r & 3) + 8 * (r >> 2) + 4 * hi; }
__device__ __forceinline__ float fexp2(float x) { return __builtin_amdgcn_exp2f(x); }
__device__ __forceinline__ float silu_f(float x) { return x * __builtin_amdgcn_rcpf(1.f + __expf(-x)); }
__device__ __forceinline__ float gelu_tanh(float x) {
  const float u = 0.7978845608028654f * (x + 0.044715f * x * x * x);
  return x * __builtin_amdgcn_rcpf(1.f + __expf(-2.f * u));
}
__device__ __forceinline__ float* xrow(PP pp, int t) {
  const int b = t / SB, j = t - b * SB;
  return j < CTX ? (float*)(pp->ws + OFF_CTXRES) + (size_t)(b * CTX + j) * DM : pp->out + (size_t)(b * SEQ + j - CTX) * DM;
}

constexpr int G_STAGE = 256 * 128 + 128 * 128;
template <class RowMap, class Epi>
__device__ __forceinline__ void gemm_tile(const bf16_t* __restrict__ A, int lda, RowMap rowmap, const bf16_t* __restrict__ Bt, int ldb, int col0, int K,
                                          char* lds, Epi epi) {
  const int tid = get_tid(), lane = tid & 63, wid = tid >> 6, wm = wid >> 1, wn = wid & 1, l31 = lane & 31, hi = lane >> 5;
  const int lr = tid >> 3, lc = tid & 7, kc = lc ^ ((lr >> 1) & 7);
  const bf16_t* ap0 = A + (size_t)rowmap(lr) * lda + kc * 8;
  const bf16_t* ap1 = A + (size_t)rowmap(lr + 64) * lda + kc * 8;
  const bf16_t* ap2 = A + (size_t)rowmap(lr + 128) * lda + kc * 8;
  const bf16_t* ap3 = A + (size_t)rowmap(lr + 192) * lda + kc * 8;
  const bf16_t* bp0 = Bt + (size_t)(col0 + lr) * ldb + kc * 8;
  const bf16_t* bp1 = Bt + (size_t)(col0 + lr + 64) * ldb + kc * 8;
  f32x16 acc[2][2];
#pragma unroll
  for (int i = 0; i < 2; ++i)
#pragma unroll
    for (int j = 0; j < 2; ++j)
#pragma unroll
      for (int r = 0; r < 16; ++r) acc[i][j][r] = 0.f;
#define G_DMA(gp, lp) __builtin_amdgcn_global_load_lds((const unsigned*)(gp), (__attribute__((address_space(3))) unsigned*)(lp), 16, 0, 0)
#define G_ISSUE(st, k0) do { char* sa_ = lds + (st) * G_STAGE + tid * 16; \
    G_DMA(ap0 + (k0), sa_); G_DMA(ap1 + (k0), sa_ + 8192); G_DMA(ap2 + (k0), sa_ + 16384); G_DMA(ap3 + (k0), sa_ + 24576); \
    G_DMA(bp0 + (k0), sa_ + 32768); G_DMA(bp1 + (k0), sa_ + 40960); } while (0)
  const int fsw = (l31 >> 1) & 7, g = fsw >> 1, c0 = l31 * 128 + ((hi ^ (fsw & 1)) << 4);
  const int o0 = c0 + ((0 ^ g) << 5), o1 = c0 + ((1 ^ g) << 5), o2 = c0 + ((2 ^ g) << 5), o3 = c0 + ((3 ^ g) << 5);
  const int abase = (64 * wm) * 128, bbase = 32768 + (64 * wn) * 128;
#define G_FRAG(O, A0, A1, B0, B1) do { A0 = *(const bf16x8*)(cS + abase + (O)); B0 = *(const bf16x8*)(cS + bbase + (O)); \
    A1 = *(const bf16x8*)(cS + abase + 4096 + (O)); B1 = *(const bf16x8*)(cS + bbase + 4096 + (O)); } while (0)
#define G_MMA(A0, A1, B0, B1) do { \
    acc[0][0] = __builtin_amdgcn_mfma_f32_32x32x16_bf16(A0, B0, acc[0][0], 0, 0, 0); \
    acc[0][1] = __builtin_amdgcn_mfma_f32_32x32x16_bf16(A0, B1, acc[0][1], 0, 0, 0); \
    acc[1][0] = __builtin_amdgcn_mfma_f32_32x32x16_bf16(A1, B0, acc[1][0], 0, 0, 0); \
    acc[1][1] = __builtin_amdgcn_mfma_f32_32x32x16_bf16(A1, B1, acc[1][1], 0, 0, 0); } while (0)
  const int nk = K >> 6;
  G_ISSUE(0, 0);
  if (nk > 1) G_ISSUE(1, 64);
  int st = 0, st2 = 2;
  for (int kt = 0; kt < nk; ++kt) {
    if (kt + 1 < nk) asm volatile("s_waitcnt vmcnt(6)" ::: "memory"); else asm volatile("s_waitcnt vmcnt(0)" ::: "memory");
    __builtin_amdgcn_s_barrier();
    if (kt + 2 < nk) G_ISSUE(st2, (kt + 2) * 64);
    const char* cS = lds + st * G_STAGE;
    bf16x8 pa0, pa1, pb0, pb1, qa0, qa1, qb0, qb1, ra0_, ra1_, rb0_, rb1_;
    G_FRAG(o0, pa0, pa1, pb0, pb1); G_FRAG(o1, qa0, qa1, qb0, qb1); __builtin_amdgcn_sched_barrier(0);
    G_MMA(pa0, pa1, pb0, pb1); G_FRAG(o2, ra0_, ra1_, rb0_, rb1_); __builtin_amdgcn_sched_barrier(0);
    G_MMA(qa0, qa1, qb0, qb1); G_FRAG(o3, pa0, pa1, pb0, pb1); __builtin_amdgcn_sched_barrier(0);
    G_MMA(ra0_, ra1_, rb0_, rb1_); G_MMA(pa0, pa1, pb0, pb1);
    st = st == 2 ? 0 : st + 1; st2 = st2 == 2 ? 0 : st2 + 1;
  }
#undef G_DMA
#undef G_ISSUE
#undef G_FRAG
#undef G_MMA
  __syncthreads();
  epi(acc, 64 * wm, col0 + 64 * wn);
}

template <class RowMap, class Post>
__device__ __forceinline__ void gemm_tile256b(const bf16_t* __restrict__ A, int lda, RowMap rowmap, const bf16_t* __restrict__ Bt, int ldb, int col0, int K,
                                             char* lds, Post post) {
  const int tid = get_tid(), lane = tid & 63, wid = tid >> 6, wm = wid >> 1, wn = wid & 1, l31 = lane & 31, hi = lane >> 5;
  const int lr = tid >> 3, lc = tid & 7, kc = lc ^ ((lr >> 1) & 7);
  const bf16_t* ap0 = A + (size_t)rowmap(lr) * lda + kc * 8;
  const bf16_t* ap1 = A + (size_t)rowmap(lr + 64) * lda + kc * 8;
  const bf16_t* ap2 = A + (size_t)rowmap(lr + 128) * lda + kc * 8;
  const bf16_t* ap3 = A + (size_t)rowmap(lr + 192) * lda + kc * 8;
  const bf16_t* bp0 = Bt + (size_t)(col0 + lr) * ldb + kc * 8;
  const size_t bstep = (size_t)64 * ldb;
  const int l15 = lane & 15, q4 = lane >> 4;
  f32x4 acc[4][8];
#pragma unroll
  for (int i = 0; i < 4; ++i)
#pragma unroll
    for (int j = 0; j < 8; ++j) { acc[i][j][0] = 0.f; acc[i][j][1] = 0.f; acc[i][j][2] = 0.f; acc[i][j][3] = 0.f; }
#define H_DMA(gp, lp) __builtin_amdgcn_global_load_lds((const unsigned*)(gp), (__attribute__((address_space(3))) unsigned*)(lp), 16, 0, 0)
#define H_ISSUE(st, k0) do { char* sa_ = lds + (st) * 65536 + tid * 16; \
    H_DMA(ap0 + (k0), sa_); H_DMA(ap1 + (k0), sa_ + 8192); H_DMA(ap2 + (k0), sa_ + 16384); H_DMA(ap3 + (k0), sa_ + 24576); \
    H_DMA(bp0 + (k0), sa_ + 32768); H_DMA(bp0 + bstep + (k0), sa_ + 40960); H_DMA(bp0 + 2 * bstep + (k0), sa_ + 49152); H_DMA(bp0 + 3 * bstep + (k0), sa_ + 57344); } while (0)
  const int fsw = l15 >> 1, c0 = l15 * 128;
  const int ok0 = c0 + (((0 + q4) ^ fsw) << 4), ok1 = c0 + (((4 + q4) ^ fsw) << 4);
  const int abase = (64 * wm) * 128, bbase = 32768 + (128 * wn) * 128;
#define H_FA(O, F) do { F[0] = *(const bf16x8*)(cS + abase + (O)); F[1] = *(const bf16x8*)(cS + abase + 2048 + (O)); \
    F[2] = *(const bf16x8*)(cS + abase + 4096 + (O)); F[3] = *(const bf16x8*)(cS + abase + 6144 + (O)); } while (0)
#define H_FB(O, NH, F) do { F[0] = *(const bf16x8*)(cS + bbase + (NH) * 8192 + (O)); F[1] = *(const bf16x8*)(cS + bbase + (NH) * 8192 + 2048 + (O)); \
    F[2] = *(const bf16x8*)(cS + bbase + (NH) * 8192 + 4096 + (O)); F[3] = *(const bf16x8*)(cS + bbase + (NH) * 8192 + 6144 + (O)); } while (0)
#define H_MMA(FA, FB, NH) do { _Pragma("unroll") for (int mi_ = 0; mi_ < 4; ++mi_) { _Pragma("unroll") for (int nj_ = 0; nj_ < 4; ++nj_) \
    acc[mi_][(NH) * 4 + nj_] = __builtin_amdgcn_mfma_f32_16x16x32_bf16(FA[mi_], FB[nj_], acc[mi_][(NH) * 4 + nj_], 0, 0, 0); } } while (0)
  const int nk = K >> 6;
  H_ISSUE(0, 0);
  for (int kt = 0; kt < nk; ++kt) {
    asm volatile("s_waitcnt vmcnt(0)" ::: "memory");
    __builtin_amdgcn_s_barrier();
    if (kt + 1 < nk) H_ISSUE((kt + 1) & 1, (kt + 1) * 64);
    const char* cS = lds + (kt & 1) * 65536;
    bf16x8 fa0[4], fb0[4];
    H_FA(ok0, fa0); H_FB(ok0, 0, fb0); __builtin_amdgcn_sched_barrier(0);
    H_MMA(fa0, fb0, 0); __builtin_amdgcn_sched_barrier(0);
    H_FB(ok0, 1, fb0); __builtin_amdgcn_sched_barrier(0);
    H_MMA(fa0, fb0, 1); __builtin_amdgcn_sched_barrier(0);
    H_FA(ok1, fa0); H_FB(ok1, 0, fb0); __builtin_amdgcn_sched_barrier(0);
    H_MMA(fa0, fb0, 0); __builtin_amdgcn_sched_barrier(0);
    H_FB(ok1, 1, fb0); __builtin_amdgcn_sched_barrier(0);
    H_MMA(fa0, fb0, 1);
  }
#undef H_DMA
#undef H_ISSUE
#undef H_FA
#undef H_FB
#undef H_MMA
  float* ut = (float*)lds;
#pragma unroll
  for (int h = 0; h < 2; ++h) {
    __syncthreads();
    if (wn == h) {
#pragma unroll
      for (int mi = 0; mi < 4; ++mi)
#pragma unroll
        for (int ni = 0; ni < 8; ++ni)
#pragma unroll
          for (int r = 0; r < 4; ++r) ut[(64 * wm + 16 * mi + 4 * q4 + r) * 128 + 16 * ni + l15] = acc[mi][ni][r];
    }
    __syncthreads();
    post(h);
  }
  __syncthreads();
}

template <class RowMap, class Post>
__device__ __forceinline__ void gemm_tile256(const bf16_t* __restrict__ A, int lda, RowMap rowmap, const bf16_t* __restrict__ Bt, int ldb, int col0, int K,
                                             char* lds, Post post) {
  const int tid = get_tid(), lane = tid & 63, wid = tid >> 6, wm = wid >> 1, wn = wid & 1, l31 = lane & 31, hi = lane >> 5;
  const int lr = tid >> 3, lc = tid & 7, kc = lc ^ ((lr >> 1) & 7);
  const bf16_t* ap0 = A + (size_t)rowmap(lr) * lda + kc * 8;
  const bf16_t* ap1 = A + (size_t)rowmap(lr + 64) * lda + kc * 8;
  const bf16_t* ap2 = A + (size_t)rowmap(lr + 128) * lda + kc * 8;
  const bf16_t* ap3 = A + (size_t)rowmap(lr + 192) * lda + kc * 8;
  const bf16_t* bp0 = Bt + (size_t)(col0 + lr) * ldb + kc * 8;
  const size_t bstep = (size_t)64 * ldb;
  f32x16 acc[2][4];
#pragma unroll
  for (int i = 0; i < 2; ++i)
#pragma unroll
    for (int j = 0; j < 4; ++j)
#pragma unroll
      for (int r = 0; r < 16; ++r) acc[i][j][r] = 0.f;
#define H_DMA(gp, lp) __builtin_amdgcn_global_load_lds((const unsigned*)(gp), (__attribute__((address_space(3))) unsigned*)(lp), 16, 0, 0)
#define H_ISSUE(st, k0) do { char* sa_ = lds + (st) * 65536 + tid * 16; \
    H_DMA(ap0 + (k0), sa_); H_DMA(ap1 + (k0), sa_ + 8192); H_DMA(ap2 + (k0), sa_ + 16384); H_DMA(ap3 + (k0), sa_ + 24576); \
    H_DMA(bp0 + (k0), sa_ + 32768); H_DMA(bp0 + bstep + (k0), sa_ + 40960); H_DMA(bp0 + 2 * bstep + (k0), sa_ + 49152); H_DMA(bp0 + 3 * bstep + (k0), sa_ + 57344); } while (0)
  const int fsw = (l31 >> 1) & 7, g = fsw >> 1, c0 = l31 * 128 + ((hi ^ (fsw & 1)) << 4);
  const int o0 = c0 + ((0 ^ g) << 5), o1 = c0 + ((1 ^ g) << 5), o2 = c0 + ((2 ^ g) << 5), o3 = c0 + ((3 ^ g) << 5);
  const int abase = (64 * wm) * 128, bbase = 32768 + (128 * wn) * 128;
#define H_FRAG(O, F) do { F[0] = *(const bf16x8*)(cS + abase + (O)); F[1] = *(const bf16x8*)(cS + abase + 4096 + (O)); \
    F[2] = *(const bf16x8*)(cS + bbase + (O)); F[3] = *(const bf16x8*)(cS + bbase + 4096 + (O)); \
    F[4] = *(const bf16x8*)(cS + bbase + 8192 + (O)); F[5] = *(const bf16x8*)(cS + bbase + 12288 + (O)); } while (0)
#define H_MMA(F) do { _Pragma("unroll") for (int nb_ = 0; nb_ < 4; ++nb_) { \
    acc[0][nb_] = __builtin_amdgcn_mfma_f32_32x32x16_bf16(F[0], F[2 + nb_], acc[0][nb_], 0, 0, 0); \
    acc[1][nb_] = __builtin_amdgcn_mfma_f32_32x32x16_bf16(F[1], F[2 + nb_], acc[1][nb_], 0, 0, 0); } } while (0)
  const int nk = K >> 6;
  H_ISSUE(0, 0);
  for (int kt = 0; kt < nk; ++kt) {
    asm volatile("s_waitcnt vmcnt(0)" ::: "memory");
    __builtin_amdgcn_s_barrier();
    if (kt + 1 < nk) H_ISSUE((kt + 1) & 1, (kt + 1) * 64);
    const char* cS = lds + (kt & 1) * 65536;
    bf16x8 f0[6], f1[6];
    H_FRAG(o0, f0); H_FRAG(o1, f1); __builtin_amdgcn_sched_barrier(0);
    H_MMA(f0); H_FRAG(o2, f0); __builtin_amdgcn_sched_barrier(0);
    H_MMA(f1); H_FRAG(o3, f1); __builtin_amdgcn_sched_barrier(0);
    H_MMA(f0); H_MMA(f1);
  }
#undef H_DMA
#undef H_ISSUE
#undef H_FRAG
#undef H_MMA
  float* ut = (float*)lds;
#pragma unroll
  for (int h = 0; h < 2; ++h) {
    __syncthreads();
    if (wn == h) {
#pragma unroll
      for (int mb = 0; mb < 2; ++mb)
#pragma unroll
        for (int nb = 0; nb < 4; ++nb)
#pragma unroll
          for (int r = 0; r < 16; ++r) ut[(64 * wm + 32 * mb + crow(r, hi)) * 128 + 32 * nb + l31] = acc[mb][nb][r];
    }
    __syncthreads();
    post(h);
  }
  __syncthreads();
}

struct RowId { int r0; __device__ __forceinline__ int operator()(int i) const { return r0 + i; } };
struct RowHalo { int r0; __device__ __forceinline__ int operator()(int i) const { int r = r0 + i; r = r < 0 ? 0 : r; return r > T - 1 ? T - 1 : r; } };

__device__ __forceinline__ void transpose_item(const float* __restrict__ src, int ldsrc, int K  , bf16_t* __restrict__ dst, int kt, int ntile, int mode,
                               const float* __restrict__ kscale, float* tile) {
  const int tid = get_tid(), k0 = kt * 64, n0 = ntile * 64;
#pragma unroll
  for (int i = 0; i < 2; ++i) {
    const int kk = (tid >> 4) + 32 * i, n4 = (tid & 15) * 4, nn = n0 + n4;
    const int sc = mode == 1 ? (((nn & 63) < 32) ? (nn >> 6) * 32 + (nn & 31) : DFF + (nn >> 6) * 32 + (nn & 31)) : nn;
    f32x4 v = *(const f32x4*)(src + (size_t)(k0 + kk) * ldsrc + sc);
    if (kscale) { const float g = kscale[k0 + kk]; v *= g; }
    float* tp = tile + kk * 65 + n4; tp[0] = v[0]; tp[1] = v[1]; tp[2] = v[2]; tp[3] = v[3];
  }
  __syncthreads();
  {
    const int n = tid >> 3, kc = tid & 7; const float* tp = tile + (kc * 8) * 65 + n;
    u32x4 w; w[0] = cvtpk(tp[0], tp[65]); w[1] = cvtpk(tp[130], tp[195]); w[2] = cvtpk(tp[260], tp[325]); w[3] = cvtpk(tp[390], tp[455]);
    *(u32x4*)(dst + (size_t)(n0 + n) * K + k0 + kc * 8) = w;
  }
  __syncthreads();
}

__device__ __forceinline__ void phase0(PP pp, char* lds) {
  const int tid = get_tid();
  float* svec = (float*)lds; float* red = (float*)(lds + 12288); float* tile = (float*)(lds + 20480);
  for (int i = tid; i < 3072; i += 512) { const int v = i >> 10, k = i & 1023; const float val = v < 2 ? pp->c[v * 1024 + k] : pp->c_ctx[k]; svec[i] = silu_f(val); }
  __syncthreads();
  constexpr int N_ADA = 192, N_ROPE = 1, N_TR = 3000, N_SG = 16, PER_L = N_TR + N_SG;
  constexpr int N_ITEMS = N_ADA + N_ROPE + NLAYER * PER_L;
  for (int it = get_bid(); it < N_ITEMS; it += gridDim.x) {
    if (it < N_ADA) {
      const int l = it / 96, c0 = (it % 96) * 64, col = tid & 63, kg = tid >> 6;
      const float* wp = pp->ada_w + ((size_t)l * 1024 + kg * 128) * 6144 + c0 + col;
      float a0 = 0.f, a1 = 0.f, a2 = 0.f;
#pragma unroll 8
      for (int k = 0; k < 128; ++k) { const float w = wp[(size_t)k * 6144]; const int kk = kg * 128 + k; a0 += svec[kk] * w; a1 += svec[1024 + kk] * w; a2 += svec[2048 + kk] * w; }
      red[(kg * 3 + 0) * 64 + col] = a0; red[(kg * 3 + 1) * 64 + col] = a1; red[(kg * 3 + 2) * 64 + col] = a2;
      __syncthreads();
      if (tid < 192) { const int v = tid >> 6; float s = 0.f;
#pragma unroll
        for (int g = 0; g < 8; ++g) s += red[(g * 3 + v) * 64 + col];
        ((float*)(pp->ws + OFF_MOD))[(size_t)(l * 3 + v) * 6144 + c0 + col] = s + pp->ada_b[l * 6144 + c0 + col]; }
      __syncthreads();
    } else if (it < N_ADA + N_ROPE) {
      for (int e = tid; e < 128 * 24; e += 512) {
        const int pos = e / 24, i = e % 24; const bool big = i < 16; const int ii = big ? i : i - 16;
        const float inv = exp2f(-(float)ii / (big ? 16.f : 8.f) * 13.287712379549449f);
        const float ang = (float)pos * inv;
        const double a = (double)ang; const double n = rint(a * 0.15915494309189535); const float y = (float)(a - n * 6.283185307179586);
        f32x2 cs; cs[0] = cosf(y); cs[1] = sinf(y);
        if (big) ((f32x2*)(pp->ws + OFF_CS16))[pos * 16 + ii] = cs; else ((f32x2*)(pp->ws + OFF_CS8))[pos * 8 + ii] = cs;
      }
    } else {
      const int q = it - N_ADA - N_ROPE, l = q / PER_L; int t = q % PER_L;
      bf16_t* wl = (bf16_t*)(pp->ws + OFF_W) + (size_t)l * W_LAYER;
      if (t < 496) transpose_item(pp->w_in + (size_t)l * 1024 * INW, INW, KP, wl + W_IN, t % 16, t / 16, 0, nullptr, tile);
      else if (t < 568) { t -= 496; transpose_item(pp->mla_wuq + (size_t)l * 384 * 768, 768, 384, wl + W_UQ, t % 6, t / 6, 0, pp->mla_gq + l * 384, tile); }
      else if (t < 632) { t -= 568; transpose_item(pp->mla_wukv + (size_t)l * 256 * 1024, 1024, 256, wl + W_UKV, t % 4, t / 4, 0, pp->mla_gkv + l * 256, tile); }
      else if (t < 888) { t -= 632; transpose_item(pp->w_o + (size_t)l * 1024 * 1024, 1024, KP, wl + W_O, t % 16, t / 16, 0, nullptr, tile); }
      else if (t < 2296) { t -= 888; transpose_item(pp->ffn_wup + (size_t)l * 1024 * 5632, 5632, KP, wl + W_UP, t % 16, t / 16, 1, nullptr, tile); }
      else if (t < 3000) { t -= 2296; transpose_item(pp->ffn_wdown + (size_t)l * DFF * 1024, 1024, DFF, wl + W_DN, t % 44, t / 44, 0, nullptr, tile); }
      else { t -= 3000; const size_t idx = (size_t)t * 4096 + tid * 8; const float* s = pp->sgu_ws + (size_t)l * 65536 + idx;
        const f32x4 v0 = *(const f32x4*)s, v1 = *(const f32x4*)(s + 4);
        u32x4 w; w[0] = cvtpk(v0[0], v0[1]); w[1] = cvtpk(v0[2], v0[3]); w[2] = cvtpk(v1[0], v1[1]); w[3] = cvtpk(v1[2], v1[3]);
        *(u32x4*)(wl + W_SG + idx) = w; }
    }
  }
}

__device__ __forceinline__ void row_pass(PP pp, int mode, const float* __restrict__ lg, const float* __restrict__ lb, int lm, int shc, int scc, bool want_h, bool skip_ctx, bool alpha_ctx) {
  const int lane = get_tid() & 63, wid = get_tid() >> 6;
  const float* mod = (const float*)(pp->ws + OFF_MOD) + (size_t)lm * 3 * 6144;
  bf16_t* hmod = (bf16_t*)(pp->ws + OFF_HMOD);
  for (int t = get_bid() * 8 + wid; t < T; t += gridDim.x * 8) {
    const int b = t / SB, j = t - b * SB; const bool isctx = j < CTX;
    if (isctx && skip_ctx) continue;
    float* xr = xrow(pp, t);
    const float* src = mode == 0 ? (isctx ? pp->ctx + (size_t)(b * CTX + j) * DM : pp->x + (size_t)(b * SEQ + j - CTX) * DM) : xr;
    f32x4 v[4];
#pragma unroll
    for (int i = 0; i < 4; ++i) v[i] = *(const f32x4*)(src + (i * 64 + lane) * 4);
    if (mode == 1) {
      float s = 0.f;
#pragma unroll
      for (int i = 0; i < 4; ++i) s += (v[i][0] + v[i][1]) + (v[i][2] + v[i][3]);
#pragma unroll
      for (int o = 32; o > 0; o >>= 1) s += __shfl_xor(s, o);
      const float mu = s * (1.f / 1024.f);
      float q = 0.f;
#pragma unroll
      for (int i = 0; i < 4; ++i) { v[i] -= mu; q += (v[i][0] * v[i][0] + v[i][1] * v[i][1]) + (v[i][2] * v[i][2] + v[i][3] * v[i][3]); }
#pragma unroll
      for (int o = 32; o > 0; o >>= 1) q += __shfl_xor(q, o);
      const float rstd = rsqrtf(q * (1.f / 1024.f) + EPS);
#pragma unroll
      for (int i = 0; i < 4; ++i) { const int c = (i * 64 + lane) * 4; const f32x4 g = *(const f32x4*)(lg + c), bb = *(const f32x4*)(lb + c); v[i] = v[i] * rstd * g + bb; }
    }
    { const float sca = (isctx && alpha_ctx) ? DN_ALPHA : 1.f;
#pragma unroll
      for (int i = 0; i < 4; ++i) *(f32x4*)(xr + (i * 64 + lane) * 4) = v[i] * sca; }
    if (want_h) {
      if (lane == 0) { float z0 = 0.f; asm volatile("" : "+v"(z0)); f32x2 z; z[0] = z0; z[1] = z0; *(f32x2*)(pp->ws + OFF_SSQ + (size_t)t * 8) = z; }
      const float* mv = mod + (size_t)(isctx ? 2 : b) * 6144;
#pragma unroll
      for (int i = 0; i < 4; ++i) { const int c = (i * 64 + lane) * 4; const f32x4 sh = *(const f32x4*)(mv + shc * 1024 + c), sc = *(const f32x4*)(mv + scc * 1024 + c);
        const f32x4 h = v[i] * (sc + 1.f) + sh; u32x2 w; w[0] = cvtpk(h[0], h[1]); w[1] = cvtpk(h[2], h[3]); *(u32x2*)(hmod + (size_t)t * KP + c) = w; }
    }
  }
}

__device__ __forceinline__ void dump_tile(f32x16 (&acc)[2][2], int rbase, int cl, float* ut, int c31, int hi) {
#pragma unroll
  for (int mb = 0; mb < 2; ++mb)
#pragma unroll
    for (int nb = 0; nb < 2; ++nb)
#pragma unroll
      for (int r = 0; r < 16; ++r) ut[(rbase + 32 * mb + crow(r, hi)) * 128 + cl + 32 * nb + c31] = acc[mb][nb][r];
}
__device__ __forceinline__ u32x4 pack8f(const f32x4 a, const f32x4 b) { u32x4 w; w[0] = cvtpk(a[0], a[1]); w[1] = cvtpk(a[2], a[3]); w[2] = cvtpk(b[0], b[1]); w[3] = cvtpk(b[2], b[3]); return w; }
__device__ __forceinline__ void rope8(f32x4& a, f32x4& b, const f32x4 pa, const f32x4 pb, const f32x2* cs, bool upper) {
  const float sg = upper ? 1.f : -1.f;
#pragma unroll
  for (int e = 0; e < 4; ++e) { const f32x2 c0 = cs[e], c1 = cs[4 + e]; a[e] = a[e] * c0[0] + sg * pa[e] * c0[1]; b[e] = b[e] * c1[0] + sg * pb[e] * c1[1]; }
}
template <int NCOL>
__device__ __forceinline__ void store_transposed(const float* ut, int lc0, bf16_t* dst  , const float* rscale) {
  const int tid = get_tid(), col = tid & (NCOL - 1), rc0 = tid / NCOL;
#pragma unroll 2
  for (int rc = rc0; rc < 32; rc += 512 / NCOL) {
    float v[8];
#pragma unroll
    for (int e = 0; e < 8; ++e) { v[e] = ut[(rc * 8 + e) * 128 + lc0 + col]; if (rscale) v[e] *= rscale[rc * 8 + e]; }
    u32x4 w; w[0] = cvtpk(v[0], v[1]); w[1] = cvtpk(v[2], v[3]); w[2] = cvtpk(v[4], v[5]); w[3] = cvtpk(v[6], v[7]);
    *(u32x4*)(dst + (size_t)col * SB + rc * 8) = w;
  }
}

__device__ __forceinline__ void phase_win(PP pp, int l, char* lds) {
  const bf16_t* A = (const bf16_t*)(pp->ws + OFF_HMOD);
  const bf16_t* Bt = (const bf16_t*)(pp->ws + OFF_W) + (size_t)l * W_LAYER + W_IN;
  bf16_t* zq = (bf16_t*)(pp->ws + OFF_ZQ); bf16_t* Kr = (bf16_t*)(pp->ws + OFF_KR); bf16_t* Qd = (bf16_t*)(pp->ws + OFF_QD); bf16_t* Kd = (bf16_t*)(pp->ws + OFF_KD);
  bf16_t* VdT = (bf16_t*)(pp->ws + OFF_VDT); bf16_t* zc = (bf16_t*)(pp->ws + OFF_ZC);
  const f32x2* cs16 = (const f32x2*)(pp->ws + OFF_CS16); const f32x2* cs8 = (const f32x2*)(pp->ws + OFF_CS8);
  const int tid = get_tid(), lane = tid & 63, c31 = lane & 31, hi = lane >> 5;
  float* ut = (float*)lds;
  const bool xmap = gridDim.x == 256; const int xq = get_bid() & 7, xj = get_bid() >> 3;
  for (int it0 = get_bid(); it0 < 64 * 8 + 32; it0 += gridDim.x) {
    const int it = (xmap && it0 < 512) ? ((xq * 8 + (((it0 >> 8) * 32 + xj) >> 3)) << 3) + (xj & 7) : it0;
    const bool lat = it < 512; const int mi = it >> 3;
    const int mt = lat ? (mi >> 5) * 33 + 1 + (mi & 31) : ((it - 512) >> 4) * 33, nt2 = it & 7, ntc = (it - 512) & 15;
    const int row0 = mt * 256, b = mt / 33, j0 = row0 - b * SB; const bool isctx = !lat;
    auto post_nt = [&](int nt) {
    {
      const int cc = tid & 15, seg = 2 * nt + (cc >> 3), col = nt * 128 + cc * 8;
      if (seg < 31 && !(seg >= 19 && seg < 23)) {
#pragma unroll 2
        for (int i = 0; i < 8; ++i) {
          const int row = (tid >> 4) + 32 * i, t = row0 + row; const float* up = ut + row * 128 + cc * 8;
          f32x4 va = *(const f32x4*)up, vb = *(const f32x4*)(up + 4);
          if (seg < 10) { *(u32x4*)(zq + (size_t)t * 640 + col) = pack8f(va, vb);
            float ss = (va[0] * va[0] + va[1] * va[1]) + (va[2] * va[2] + va[3] * va[3]) + (vb[0] * vb[0] + vb[1] * vb[1]) + (vb[2] * vb[2] + vb[3] * vb[3]);
            ss += __shfl_xor(ss, 1); ss += __shfl_xor(ss, 2); ss += __shfl_xor(ss, 4);
            if ((cc & 7) == 0) atomicAdd((float*)(pp->ws + OFF_SSQ) + (size_t)t * 2 + (seg < 6 ? 0 : 1), ss); }
          else if (seg == 10) {
            if (!isctx) { const float* qp = ut + row * 128 + (cc ^ 2) * 8; const f32x4 pa = *(const f32x4*)qp, pb = *(const f32x4*)(qp + 4);
              const int ppos = j0 + row - CTX, pos = ((cc & 4) == 0) ? (ppos >> 6) : (ppos & 63);
              rope8(va, vb, pa, pb, cs16 + pos * 16 + (cc & 1) * 8, (cc & 2) != 0); }
            *(u32x4*)(Kr + (size_t)t * 64 + (cc & 7) * 8) = pack8f(va, vb);
          } else if (seg < 19) {
            if (!isctx) { const float* qp = ut + row * 128 + (cc ^ 1) * 8; const f32x4 pa = *(const f32x4*)qp, pb = *(const f32x4*)(qp + 4);
              const int ppos = j0 + row - CTX, pos = ((cc & 2) == 0) ? (ppos >> 6) : (ppos & 63);
              rope8(va, vb, pa, pb, cs8 + pos * 8, (cc & 1) != 0); }
            if (seg < 15) { va *= QS_DIFF; vb *= QS_DIFF; *(u32x4*)(Qd + (size_t)t * 256 + col - 704) = pack8f(va, vb); }
            else *(u32x4*)(Kd + (size_t)t * 256 + col - 960) = pack8f(va, vb);
          } else {
#pragma unroll
            for (int e = 0; e < 4; ++e) { va[e] = gelu_tanh(va[e]); vb[e] = gelu_tanh(vb[e]); }
            *(u32x4*)(zc + (size_t)t * 512 + col - 1472) = pack8f(va, vb);
          }
        }
      }
#pragma unroll
      for (int sh = 0; sh < 2; ++sh) { const int sg = 2 * nt + sh;
        if (sg >= 19 && sg < 23) store_transposed<64>(ut, sh * 64, VdT + (size_t)(b * 4 + (sg - 19)) * 64 * SB + j0, nullptr); }
    }
    };
    if (lat) { auto post = [&](int h) { post_nt(2 * nt2 + h); }; gemm_tile256b(A, KP, RowId{row0}, Bt, KP, nt2 * 256, DM, lds, post); }
    else {
      auto epi = [&](f32x16 (&acc)[2][2], int rbase, int cbase) { dump_tile(acc, rbase, cbase - ntc * 128, ut, c31, hi); };
      gemm_tile(A, KP, RowId{row0}, Bt, KP, ntc * 128, DM, lds, epi);
      __syncthreads(); post_nt(ntc); __syncthreads();
    }
  }
}

__device__ __forceinline__ void phase_up2(PP pp, int l, char* lds) {
  const bf16_t* zq = (const bf16_t*)(pp->ws + OFF_ZQ);
  const bf16_t* wl = (const bf16_t*)(pp->ws + OFF_W) + (size_t)l * W_LAYER;
  bf16_t* Qm = (bf16_t*)(pp->ws + OFF_QM); bf16_t* Km = (bf16_t*)(pp->ws + OFF_KM); bf16_t* VmT = (bf16_t*)(pp->ws + OFF_VMT);
  const bf16_t* zc = (const bf16_t*)(pp->ws + OFF_ZC); bf16_t* Y = (bf16_t*)(pp->ws + OFF_Y);
  const f32x2* cs16 = (const f32x2*)(pp->ws + OFF_CS16);
  const int tid = get_tid(), lane = tid & 63, wid = tid >> 6, c31 = lane & 31, hi = lane >> 5;
  float* rstd = (float*)(lds + LDS_RSTD);
  constexpr int N_UQ = 66 * 3, N_UKV = 66 * 4, N_CH = 132;
  const float* ssq = (const float*)(pp->ws + OFF_SSQ);
  for (int it = get_bid(); it < N_UQ + N_UKV; it += gridDim.x) {
    {
      const bool isq = it < N_UQ; const int q = isq ? it : it - N_UQ; const int nN = isq ? 3 : 4;
      const int mt = q / nN, nt2 = q % nN, row0 = mt * 256, b = mt / 33, j0 = row0 - b * SB; const bool isctx = (mt % 33) == 0;
      if (tid < 256) rstd[tid] = rsqrtf(ssq[(size_t)(row0 + tid) * 2 + (isq ? 0 : 1)] * (isq ? 1.f / 384.f : 1.f / 256.f) + EPS);
      float* ut = (float*)lds;
      auto post = [&](int h) {
        const int nt = 2 * nt2 + h;
        if (isq || (nt & 1) == 0) {
          const int cc = tid & 15, seg = 2 * nt + (cc >> 3), col = nt * 128 + cc * 8;
#pragma unroll 2
          for (int i = 0; i < 8; ++i) {
            const int row = (tid >> 4) + 32 * i, t = row0 + row; const float* up = ut + row * 128 + cc * 8; const float rs = rstd[row];
            f32x4 va = *(const f32x4*)up, vb = *(const f32x4*)(up + 4);
            if (isq) {
              if ((seg % 3) == 2 && !isctx) { const float* qp = ut + row * 128 + (cc ^ 2) * 8; const f32x4 pa = *(const f32x4*)qp, pb = *(const f32x4*)(qp + 4);
                const int ppos = j0 + row - CTX, pos = ((cc & 4) == 0) ? (ppos >> 6) : (ppos & 63);
                rope8(va, vb, pa, pb, cs16 + pos * 16 + (cc & 1) * 8, (cc & 2) != 0); }
              va *= rs * QS_MLA; vb *= rs * QS_MLA;
              *(u32x4*)(Qm + (size_t)t * 768 + col) = pack8f(va, vb);
            } else {
              va *= rs; vb *= rs;
              *(u32x4*)(Km + (size_t)t * 512 + (nt >> 1) * 128 + cc * 8) = pack8f(va, vb);
            }
          }
        } else {
          store_transposed<128>(ut, 0, VmT + (size_t)(b * 4 + (nt >> 1)) * 128 * SB + j0, rstd);
        }
      };
      gemm_tile256(isq ? zq : zq + 384, 640, RowId{row0}, isq ? wl + W_UQ : wl + W_UKV, isq ? 384 : 256, nt2 * 256, isq ? 384 : 256, lds, post);
    }
  }
  for (int it = (get_bid() + gridDim.x - ((N_UQ + N_UKV) % gridDim.x)) % gridDim.x; it < N_CH * 4; it += gridDim.x) {
    {
      const int ch = it >> 2, g0 = it & 3, t0 = ch * 128;
      float* st = (float*)lds;
      bf16_t* vT = (bf16_t*)(lds + 1024);
      if (tid < 256) {
        const int r = tid >> 1, hf = tid & 1; const bf16_t* rp = zc + (size_t)(t0 + r) * 512 + 256 + hf * 128;
        float s = 0.f, ss = 0.f;
        for (int i = 0; i < 16; ++i) { const u32x4 w = *(const u32x4*)(rp + i * 8);
#pragma unroll
          for (int e = 0; e < 4; ++e) { const float a = bflo(w[e]), c = bfhi(w[e]); s += a + c; ss += a * a + c * c; } }
        s += __shfl_xor(s, 1); ss += __shfl_xor(ss, 1);
        const float mu = s * (1.f / 256.f); const float var = fmaxf(ss * (1.f / 256.f) - mu * mu, 0.f);
        if (hf == 0) { st[2 * r] = mu; st[2 * r + 1] = rsqrtf(var + EPS); }
      }
      __syncthreads();
      const bf16_t* Ws = wl + W_SG;
      for (int g = g0; g < g0 + 1; ++g) {
        {
          const int r = tid >> 2, q4 = tid & 3; const bf16_t* rp = zc + (size_t)(t0 + r) * 512 + 256 + g * 64 + q4 * 16;
          const float mu = st[2 * r], rs = st[2 * r + 1];
          const float* lg = pp->sgu_ln_g + l * 256 + g * 64 + q4 * 16; const float* lb = pp->sgu_ln_b + l * 256 + g * 64 + q4 * 16;
#pragma unroll
          for (int i = 0; i < 2; ++i) { const u32x4 w = *(const u32x4*)(rp + i * 8);
#pragma unroll
            for (int e = 0; e < 4; ++e) { const int c = i * 8 + 2 * e;
              vT[(q4 * 16 + c) * 136 + r] = f2bf((bflo(w[e]) - mu) * rs * lg[c] + lb[c]);
              vT[(q4 * 16 + c + 1) * 136 + r] = f2bf((bfhi(w[e]) - mu) * rs * lg[c + 1] + lb[c + 1]); } }
        }
        __syncthreads();
        if (wid < 4) {
          f32x16 a0 = {}, a1 = {};
          const bf16_t* wrow = Ws + ((size_t)g * 128 + 32 * wid + c31) * 128 + hi * 8;
#pragma unroll
          for (int ks = 0; ks < 8; ++ks) {
            const bf16x8 a = *(const bf16x8*)(wrow + ks * 16);
            const bf16x8 b0 = *(const bf16x8*)((const char*)vT + (c31) * 272 + ks * 32 + hi * 16);
            const bf16x8 b1 = *(const bf16x8*)((const char*)vT + (32 + c31) * 272 + ks * 32 + hi * 16);
            a0 = __builtin_amdgcn_mfma_f32_32x32x16_bf16(a, b0, a0, 0, 0, 0);
            a1 = __builtin_amdgcn_mfma_f32_32x32x16_bf16(a, b1, a1, 0, 0, 0);
          }
#pragma unroll
          for (int r = 0; r < 16; ++r) { const int pr = 32 * wid + crow(r, hi); const float bs = pp->sgu_bs[(l * 4 + g) * 128 + pr];
            const size_t t = (size_t)(t0 + pr);
            const float u0 = bf2f(zc[t * 512 + g * 64 + c31]), u1 = bf2f(zc[t * 512 + g * 64 + 32 + c31]);
            Y[t * KP + 768 + g * 64 + c31] = f2bf(u0 * (a0[r] + bs)); Y[t * KP + 768 + g * 64 + 32 + c31] = f2bf(u1 * (a1[r] + bs)); }
        }
        __syncthreads();
      }
    }
  }
}

__device__ __forceinline__ bf16x8 pack8(const f32x16& pv, int base) {
  u32x4 w; w[0] = cvtpk(pv[base], pv[base + 1]); w[1] = cvtpk(pv[base + 2], pv[base + 3]); w[2] = cvtpk(pv[base + 4], pv[base + 5]); w[3] = cvtpk(pv[base + 6], pv[base + 7]);
  return *(bf16x8*)&w;
}
__device__ __forceinline__ bf16x8 ld_vfrag(const char* base) { return *(const bf16x8*)base; }
__device__ __forceinline__ int kperm(int r) { return (r & ~12) | ((r & 4) << 1) | ((r & 8) >> 1); }

constexpr int MLA_KS = 400, MLA_KBYTES = 64 * MLA_KS, VT_S = 144, MLA_VBYTES = 128 * VT_S, MLA_STAGE = MLA_KBYTES + MLA_VBYTES;
constexpr int DF_KS = 144, DF_KBYTES = 64 * DF_KS, DF_VBYTES = 64 * VT_S, DF_STAGE = DF_KBYTES + DF_VBYTES;

template <int NKS>
__device__ __forceinline__ f32x16 qk_tile(const char* krow, const bf16x8* qf, const f32x16& negm) {
  f32x16 p = __builtin_amdgcn_mfma_f32_32x32x16_bf16(*(const bf16x8*)krow, qf[0], negm, 0, 0, 0);
#pragma unroll
  for (int ks = 1; ks < NKS; ++ks) p = __builtin_amdgcn_mfma_f32_32x32x16_bf16(*(const bf16x8*)(krow + ks * 32), qf[ks], p, 0, 0, 0);
  return p;
}
template <int NOB>
__device__ __forceinline__ void sm_pv(f32x16& p, const char* vrow, f32x16& negm, float& m, f32x16& lacc, f32x16* oT, bool first, f32x16* pend) {
  float pm = p[0];
#pragma unroll
  for (int r = 1; r < 16; ++r) pm = fmaxf(pm, p[r]);
  if (first || !__all(pm <= 8.f)) {
    const float pmx = fmaxf(pm, __shfl_xor(pm, 32));
    const float d = first ? pmx : fmaxf(pmx, 0.f);
    if (!first) { const float alpha = fexp2(-d); lacc *= alpha;
#pragma unroll
      for (int nb = 0; nb < NOB; ++nb) oT[nb] *= alpha; }
    m += d;
#pragma unroll
    for (int r = 0; r < 16; ++r) { negm[r] = -m; p[r] -= d; }
    if (pend) {
#pragma unroll
      for (int r = 0; r < 16; ++r) (*pend)[r] -= d; }
  }
#pragma unroll
  for (int r = 0; r < 16; ++r) p[r] = fexp2(p[r]);
  const bf16x8 pb0 = pack8(p, 0), pb1 = pack8(p, 8);
  const bf16x8 ones = {0x3F80, 0x3F80, 0x3F80, 0x3F80, 0x3F80, 0x3F80, 0x3F80, 0x3F80};
  lacc = __builtin_amdgcn_mfma_f32_32x32x16_bf16(ones, pb0, lacc, 0, 0, 0);
  lacc = __builtin_amdgcn_mfma_f32_32x32x16_bf16(ones, pb1, lacc, 0, 0, 0);
#pragma unroll
  for (int nb = 0; nb < NOB; ++nb) {
    oT[nb] = __builtin_amdgcn_mfma_f32_32x32x16_bf16(ld_vfrag(vrow + nb * 32 * VT_S), pb0, oT[nb], 0, 0, 0);
    oT[nb] = __builtin_amdgcn_mfma_f32_32x32x16_bf16(ld_vfrag(vrow + nb * 32 * VT_S + 32), pb1, oT[nb], 0, 0, 0);
  }
}

template <int NOB, int VS = VT_S>
__device__ __forceinline__ void sm_pv_sv(f32x16& p, const char* vrow, f32x16& negm, float& m, float& l, f32x16* oT, bool first) {
  float pm = p[0];
#pragma unroll
  for (int r = 1; r < 16; ++r) pm = fmaxf(pm, p[r]);
  if (first || !__all(pm <= 8.f)) {
    const float pmx = fmaxf(pm, __shfl_xor(pm, 32));
    const float d = first ? pmx : fmaxf(pmx, 0.f);
    if (!first) { const float alpha = fexp2(-d); l *= alpha;
#pragma unroll
      for (int nb = 0; nb < NOB; ++nb) oT[nb] *= alpha; }
    m += d;
#pragma unroll
    for (int r = 0; r < 16; ++r) { negm[r] = -m; p[r] -= d; }
  }
  float ps = 0.f;
#pragma unroll
  for (int r = 0; r < 16; ++r) { p[r] = fexp2(p[r]); ps += p[r]; }
  l += ps;
  const bf16x8 pb0 = pack8(p, 0), pb1 = pack8(p, 8);
#pragma unroll
  for (int nb = 0; nb < NOB; ++nb) {
    oT[nb] = __builtin_amdgcn_mfma_f32_32x32x16_bf16(ld_vfrag(vrow + nb * 32 * VS), pb0, oT[nb], 0, 0, 0);
    oT[nb] = __builtin_amdgcn_mfma_f32_32x32x16_bf16(ld_vfrag(vrow + nb * 32 * VS + 32), pb1, oT[nb], 0, 0, 0);
  }
}

template <int NOB>
__device__ __forceinline__ void sm_pv_valu(f32x16& p, const char* vrow, float& m, float& l, f32x16* oT, bool first) {
  float pm = p[0];
#pragma unroll
  for (int r = 1; r < 16; ++r) pm = fmaxf(pm, p[r]);
  if (first || !__all(pm <= m + 8.f)) {
    const float pmx = fmaxf(pm, __shfl_xor(pm, 32));
    const float mn = first ? pmx : fmaxf(m, pmx);
    if (!first) { const float alpha = fexp2(m - mn); l *= alpha;
#pragma unroll
      for (int nb = 0; nb < NOB; ++nb) oT[nb] *= alpha; }
    m = mn;
  }
  float ps = 0.f;
#pragma unroll
  for (int r = 0; r < 16; ++r) { p[r] = fexp2(p[r] - m); ps += p[r]; }
  l += ps;
  const bf16x8 pb0 = pack8(p, 0), pb1 = pack8(p, 8);
#pragma unroll
  for (int nb = 0; nb < NOB; ++nb) {
    oT[nb] = __builtin_amdgcn_mfma_f32_32x32x16_bf16(ld_vfrag(vrow + nb * 32 * VT_S), pb0, oT[nb], 0, 0, 0);
    oT[nb] = __builtin_amdgcn_mfma_f32_32x32x16_bf16(ld_vfrag(vrow + nb * 32 * VT_S + 32), pb1, oT[nb], 0, 0, 0);
  }
}

__device__ __forceinline__ void attn_mla_item(PP pp, int b, int h, int tq0, int NT, char* lds) {
  const bf16_t* Qm = (const bf16_t*)(pp->ws + OFF_QM); const bf16_t* Km = (const bf16_t*)(pp->ws + OFF_KM); const bf16_t* Kr = (const bf16_t*)(pp->ws + OFF_KR);
  const bf16_t* VmT = (const bf16_t*)(pp->ws + OFF_VMT) + (size_t)(b * 4 + h) * 128 * SB; bf16_t* Y = (bf16_t*)(pp->ws + OFF_Y);
  const int tid = get_tid(), lane = tid & 63, wid = tid >> 6, c31 = lane & 31, hi = lane >> 5;
  const int tk0 = b * SB;
  bf16x8 qf[12];
  { const bf16_t* qp = Qm + (size_t)(tq0 + 32 * wid + c31) * 768 + h * 192 + hi * 8;
#pragma unroll
    for (int ks = 0; ks < 12; ++ks) qf[ks] = *(const bf16x8*)(qp + ks * 16); }
  f32x16 oT[4];
#pragma unroll
  for (int nb = 0; nb < 4; ++nb)
#pragma unroll
    for (int r = 0; r < 16; ++r) oT[nb][r] = 0.f;
  float m = 0.f, l = 0.f; f32x16 negm;
#pragma unroll
  for (int r = 0; r < 16; ++r) negm[r] = 0.f;
  u32x4 rk0, rk1, rk2, rv0, rv1;
  int kkey[3], kc[3];
#pragma unroll
  for (int i = 0; i < 3; ++i) { const int id = tid + 512 * i; kkey[i] = id / 24; kc[i] = id % 24; }
  const int vdv0 = tid >> 3, vkc = tid & 7;
#define A_KSRC(i, key0) (kc[i] < 16 ? Km + (size_t)(tk0 + (key0) + kkey[i]) * 512 + h * 128 + kc[i] * 8 : Kr + (size_t)(tk0 + (key0) + kkey[i]) * 64 + (kc[i] - 16) * 8)
#define A_LOAD(key0) do { rk0 = *(const u32x4*)A_KSRC(0, key0); rk1 = *(const u32x4*)A_KSRC(1, key0); rk2 = *(const u32x4*)A_KSRC(2, key0); \
    rv0 = *(const u32x4*)(VmT + (size_t)vdv0 * SB + (key0) + vkc * 8); rv1 = *(const u32x4*)(VmT + (size_t)(vdv0 + 64) * SB + (key0) + vkc * 8); } while (0)
#define A_STORE(s) do { char* kb_ = lds + (s) * MLA_STAGE; char* vb_ = kb_ + MLA_KBYTES; \
    *(u32x4*)(kb_ + kkey[0] * MLA_KS + kc[0] * 16) = rk0; *(u32x4*)(kb_ + kkey[1] * MLA_KS + kc[1] * 16) = rk1; *(u32x4*)(kb_ + kkey[2] * MLA_KS + kc[2] * 16) = rk2; \
    { char* d_ = vb_ + vdv0 * VT_S + vkc * 16; *(u32x4*)d_ = rv0; *(u32x4*)(d_ + 64 * VT_S) = rv1; } } while (0)
  A_LOAD(0); A_STORE(0); __syncthreads();
  for (int t = 0; t < NT; ++t) {
    const int s = t & 1;
    if (t + 1 < NT) A_LOAD((t + 1) * 64);
    const char* kb = lds + s * MLA_STAGE; const char* vb = kb + MLA_KBYTES;
    const char* ka = kb + kperm(c31) * MLA_KS + hi * 16; const char* va = vb + c31 * VT_S + hi * 16;
    f32x16 pa = qk_tile<12>(ka, qf, negm);
    sm_pv_sv<4>(pa, va, negm, m, l, oT, t == 0);
    f32x16 pbb = qk_tile<12>(ka + 32 * MLA_KS, qf, negm);
    sm_pv_sv<4>(pbb, va + 64, negm, m, l, oT, false);
    if (t + 1 < NT) A_STORE(s ^ 1);
    __syncthreads();
  }
#undef A_KSRC
#undef A_LOAD
#undef A_STORE
  l += __shfl_xor(l, 32);
  const float il = 1.f / l;
  bf16_t* yp = Y + (size_t)(tq0 + 32 * wid + c31) * KP + h * 128;
#pragma unroll
  for (int nb = 0; nb < 4; ++nb)
#pragma unroll
    for (int i4 = 0; i4 < 4; ++i4) { u32x2 w; w[0] = cvtpk(oT[nb][4 * i4] * il, oT[nb][4 * i4 + 1] * il); w[1] = cvtpk(oT[nb][4 * i4 + 2] * il, oT[nb][4 * i4 + 3] * il);
      *(u32x2*)(yp + 32 * nb + 8 * i4 + 4 * hi) = w; }
}

__device__ __forceinline__ void attn_diff_item(PP pp, int l, int b, int h, int tq0, int NT, float lam, float lam_init, char* lds) {
  const bf16_t* Qd = (const bf16_t*)(pp->ws + OFF_QD); const bf16_t* Kd = (const bf16_t*)(pp->ws + OFF_KD);
  const bf16_t* VdT = (const bf16_t*)(pp->ws + OFF_VDT) + (size_t)(b * 4 + h) * 64 * SB; bf16_t* Y = (bf16_t*)(pp->ws + OFF_Y);
  const int tid = get_tid(), lane = tid & 63, wid = tid >> 6, c31 = lane & 31, hi = lane >> 5;
  const int tk0 = b * SB;
  bf16x8 qf[2][2];
  { const bf16_t* qp = Qd + (size_t)(tq0 + 32 * wid + c31) * 256 + h * 64 + hi * 8;
#pragma unroll
    for (int mp = 0; mp < 2; ++mp)
#pragma unroll
      for (int ks = 0; ks < 2; ++ks) qf[mp][ks] = *(const bf16x8*)(qp + mp * 32 + ks * 16); }
  f32x16 oA[2], oB[2];
#pragma unroll
  for (int nb = 0; nb < 2; ++nb)
#pragma unroll
    for (int r = 0; r < 16; ++r) { oA[nb][r] = 0.f; oB[nb][r] = 0.f; }
  float mA = 0.f, mB = 0.f, lA = 0.f, lB = 0.f; f32x16 negA, negB;
#pragma unroll
  for (int r = 0; r < 16; ++r) { negA[r] = 0.f; negB[r] = 0.f; }
  constexpr int DV2S = 272, D2K = 128 * DF_KS, D2STAGE = D2K + 64 * DV2S;
  u32x4 rk, rk2, rv, rv2;
  const int kkey = tid >> 3, kch = tid & 7;
#define D_LOAD(key0) do { const bf16_t* kp_ = Kd + (size_t)(tk0 + (key0) + kkey) * 256 + h * 64 + kch * 8; rk = *(const u32x4*)kp_; rk2 = *(const u32x4*)(kp_ + 64 * 256); \
    const bf16_t* vp_ = VdT + (size_t)kkey * SB + (key0) + kch * 8; rv = *(const u32x4*)vp_; rv2 = *(const u32x4*)(vp_ + 64); } while (0)
#define D_STORE(s) do { char* kb_ = lds + (s) * D2STAGE; char* vb_ = kb_ + D2K; *(u32x4*)(kb_ + kkey * DF_KS + kch * 16) = rk; *(u32x4*)(kb_ + (kkey + 64) * DF_KS + kch * 16) = rk2; \
    *(u32x4*)(vb_ + kkey * DV2S + kch * 16) = rv; *(u32x4*)(vb_ + kkey * DV2S + 128 + kch * 16) = rv2; } while (0)
  const int NT2 = NT >> 1;
  D_LOAD(0); D_STORE(0); __syncthreads();
  for (int t = 0; t < NT2; ++t) {
    const int s = t & 1;
    if (t + 1 < NT2) D_LOAD((t + 1) * 128);
    const char* kb = lds + s * D2STAGE; const char* vb = kb + D2K;
#pragma unroll
    for (int sub = 0; sub < 2; ++sub) {
      const char* ka = kb + (kperm(c31) + 64 * sub) * DF_KS + hi * 16; const char* va = vb + c31 * DV2S + hi * 16 + 128 * sub;
      const bool f0 = (t == 0) && (sub == 0);
      f32x16 pA0 = qk_tile<2>(ka, qf[0], negA);
      f32x16 pB0 = qk_tile<2>(ka + 64, qf[1], negB);
      sm_pv_sv<2, DV2S>(pA0, va, negA, mA, lA, oA, f0);
      f32x16 pA1 = qk_tile<2>(ka + 32 * DF_KS, qf[0], negA);
      sm_pv_sv<2, DV2S>(pB0, va, negB, mB, lB, oB, f0);
      f32x16 pB1 = qk_tile<2>(ka + 32 * DF_KS + 64, qf[1], negB);
      sm_pv_sv<2, DV2S>(pA1, va + 64, negA, mA, lA, oA, false);
      sm_pv_sv<2, DV2S>(pB1, va + 64, negB, mB, lB, oB, false);
    }
    if (t + 1 < NT2) D_STORE(s ^ 1);
    __syncthreads();
  }
#undef D_LOAD
#undef D_STORE
  lA += __shfl_xor(lA, 32); lB += __shfl_xor(lB, 32);
  const float ia = 1.f / lA, ib = lam / lB;
  float ss = 0.f;
#pragma unroll
  for (int nb = 0; nb < 2; ++nb)
#pragma unroll
    for (int r = 0; r < 16; ++r) { const float d = oA[nb][r] * ia - oB[nb][r] * ib; oA[nb][r] = d; ss += d * d; }
  ss += __shfl_xor(ss, 32);
  const float rs = rsqrtf(ss * (1.f / 64.f) + EPS) * (1.f - lam_init);
  const float* g = pp->subln_g + l * 64;
  bf16_t* yp = Y + (size_t)(tq0 + 32 * wid + c31) * KP + 512 + h * 64;
#pragma unroll
  for (int nb = 0; nb < 2; ++nb)
#pragma unroll
    for (int i4 = 0; i4 < 4; ++i4) { const int dv = 32 * nb + 8 * i4 + 4 * hi; const f32x4 gg = *(const f32x4*)(g + dv);
      u32x2 w; w[0] = cvtpk(oA[nb][4 * i4] * rs * gg[0], oA[nb][4 * i4 + 1] * rs * gg[1]); w[1] = cvtpk(oA[nb][4 * i4 + 2] * rs * gg[2], oA[nb][4 * i4 + 3] * rs * gg[3]);
      *(u32x2*)(yp + dv) = w; }
}

__device__ __forceinline__ void phase_attn(PP pp, int l, bool need_ctx, char* lds) {
  const int n_items = 256 + (need_ctx ? 8 : 0);
  for (int it = get_bid(); it < n_items; it += gridDim.x) {
    const int bh = it & 7, b = bh >> 2, h = bh & 3; const bool lat = it < 256;
    attn_mla_item(pp, b, h, lat ? b * SB + CTX + (it >> 3) * 256 : b * SB, lat ? SB / 64 : CTX / 64, lds);
  }
  float d1 = 0.f, d2 = 0.f;
#pragma unroll 1
  for (int i = 0; i < 32; ++i) { d1 += pp->lq1[l * 32 + i] * pp->lk1[l * 32 + i]; d2 += pp->lq2[l * 32 + i] * pp->lk2[l * 32 + i]; }
  const float lam_init = 0.8f - 0.6f * __expf(-0.3f * (float)l);
  const float lam = __expf(d1) - __expf(d2) + lam_init;
  for (int it = get_bid(); it < n_items; it += gridDim.x) {
    const int bh = it & 7, b = bh >> 2, h = bh & 3; const bool lat = it < 256;
    attn_diff_item(pp, l, b, h, lat ? b * SB + CTX + (it >> 3) * 256 : b * SB, lat ? SB / 64 : CTX / 64, lam, lam_init, lds);
  }
}

__device__ __forceinline__ void phase_res_gemm(PP pp, int l, const bf16_t* A, int K, int ld, const bf16_t* Bt, int gchunk, bool skip_ctx, char* lds) {
  const float* mod = (const float*)(pp->ws + OFF_MOD) + (size_t)l * 3 * 6144;
  const int tid = get_tid(), lane = tid & 63, c31 = lane & 31, hi = lane >> 5;
  float* ut = (float*)lds;
  for (int it0 = get_bid(); it0 < 64 * 4; it0 += gridDim.x) {
    const int it = gridDim.x == 256 ? (((it0 & 7) * 8 + (it0 >> 5)) << 2) + ((it0 >> 3) & 3) : it0;
    const int mi = it >> 2, nt2 = it & 3, mt = (mi >> 5) * 33 + 1 + (mi & 31), row0 = mt * 256, b = mt / 33;
    const float* gv = mod + (size_t)b * 6144 + gchunk * 1024;
    auto post = [&](int h) {
      const int cc = tid & 15, col = nt2 * 256 + h * 128 + cc * 8;
      const f32x4 g0 = *(const f32x4*)(gv + col), g1 = *(const f32x4*)(gv + col + 4);
#pragma unroll 2
      for (int i = 0; i < 8; ++i) {
        const int row = (tid >> 4) + 32 * i; const float* up = ut + row * 128 + cc * 8;
        float* xp = xrow(pp, row0 + row) + col;
        const f32x4 ua = *(const f32x4*)up, ub = *(const f32x4*)(up + 4);
        f32x4 xa = *(const f32x4*)xp, xb = *(const f32x4*)(xp + 4);
        xa = xa * DN_ALPHA + g0 * ua; xb = xb * DN_ALPHA + g1 * ub;
        *(f32x4*)xp = xa; *(f32x4*)(xp + 4) = xb;
      }
    };
    gemm_tile256b(A, ld, RowId{row0}, Bt, ld, nt2 * 256, K, lds, post);
  }
  if (!skip_ctx) {
    const float* gv = mod + (size_t)2 * 6144 + gchunk * 1024;
    const int Kc = K >> 2;
    for (int it = get_bid(); it < 64; it += gridDim.x) {
      const int sp = it & 3, nt = (it >> 2) & 7, row0 = (it >> 5) * 33 * 256;
      auto epi = [&](f32x16 (&acc)[2][2], int rbase, int cbase) {
#pragma unroll
        for (int mb = 0; mb < 2; ++mb)
#pragma unroll
          for (int nb = 0; nb < 2; ++nb) { const int col = cbase + 32 * nb + c31; const float g = gv[col];
#pragma unroll
            for (int r = 0; r < 16; ++r) atomicAdd(xrow(pp, row0 + rbase + 32 * mb + crow(r, hi)) + col, g * acc[mb][nb][r]); }
      };
      gemm_tile(A + sp * Kc, ld, RowId{row0}, Bt + sp * Kc, ld, nt * 128, Kc, lds, epi);
    }
  }
}

__device__ __forceinline__ void phase_ffn_up(PP pp, int l, char* lds) {
  const bf16_t* A = (const bf16_t*)(pp->ws + OFF_HMOD);
  const bf16_t* Bt = (const bf16_t*)(pp->ws + OFF_W) + (size_t)l * W_LAYER + W_UP;
  bf16_t* A2 = (bf16_t*)(pp->ws + OFF_A2);
  const float* cw = pp->ffn_convw + (size_t)l * 3 * 5632; const float* cb = pp->ffn_convb + (size_t)l * 5632;
  const int tid = get_tid(), lane = tid & 63, c31 = lane & 31, hi = lane >> 5;
  float* ut = (float*)lds;
  const bool xmap = gridDim.x == 256; const int xq = get_bid() & 7, xj = get_bid() >> 3;
  const int n_it = xmap ? 6 * 32 : 67 * 22;
  for (int it = xmap ? xj : get_bid(); it < n_it; it += xmap ? 32 : gridDim.x) {
    int mt, nt2;
    if (xmap) { mt = 4 * (it / 11) + (xq >> 1); nt2 = 11 * (xq & 1) + it % 11; if (mt >= 67) continue; }
    else { mt = it / 22; nt2 = it % 22; }
    const int o0 = mt * 254;
    auto post = [&](int h) {
      const int nt = 2 * nt2 + h;
    {
      const int fp = tid & 31, rg = tid >> 5, f = nt * 64 + 2 * fp;
      const int cg = (fp >> 4) * 64 + ((2 * fp) & 31), cv = cg + 32;
      const f32x2 wg0 = *(const f32x2*)(cw + f), wg1 = *(const f32x2*)(cw + 5632 + f), wg2 = *(const f32x2*)(cw + 2 * 5632 + f), bg = *(const f32x2*)(cb + f);
      const f32x2 wv0 = *(const f32x2*)(cw + DFF + f), wv1 = *(const f32x2*)(cw + 5632 + DFF + f), wv2 = *(const f32x2*)(cw + 2 * 5632 + DFF + f), bv = *(const f32x2*)(cb + DFF + f);
      int i0 = rg * 16; int i1 = i0 + 16; if (i0 < 1) i0 = 1; if (i1 > 255) i1 = 255;
      if (i1 > T - (o0 - 1)) i1 = T - (o0 - 1);
      f32x2 gp = *(const f32x2*)(ut + (i0 - 1) * 128 + cg), gc = *(const f32x2*)(ut + i0 * 128 + cg);
      f32x2 vp = *(const f32x2*)(ut + (i0 - 1) * 128 + cv), vc = *(const f32x2*)(ut + i0 * 128 + cv);
      int t = o0 - 1 + i0; int j = t % SB;
      bf16_t* dst = A2 + (size_t)t * DFF + f;
      for (int i = i0; i < i1; ++i) {
        const f32x2 gn = *(const f32x2*)(ut + (i + 1) * 128 + cg), vn = *(const f32x2*)(ut + (i + 1) * 128 + cv);
        f32x2 gate = wg1 * gc + bg, val = wv1 * vc + bv;
        if (j != 0 && j != CTX) { gate += wg0 * gp; val += wv0 * vp; }
        if (j != CTX - 1 && j != SB - 1) { gate += wg2 * gn; val += wv2 * vn; }
        *(unsigned*)dst = cvtpk(silu_f(gate[0]) * val[0], silu_f(gate[1]) * val[1]);
        dst += DFF; j = (j == SB - 1) ? 0 : j + 1;
        gp = gc; gc = gn; vp = vc; vc = vn;
      }
    }
    };
    gemm_tile256b(A, KP, RowHalo{o0 - 1}, Bt, KP, nt2 * 256, DM, lds, post);
  }
}


#define XB_TMO      128
#define XB_XCNT(j)  (256  + 64 * (j))
#define XB_XSUB(j)  (1280 + 64 * (j))
#define XB_XGEN(j)  (2304 + 64 * (j))
#define XB_TOP      3328
#define XB_TOPGEN   3392
#define XCD_BAR_WORDS 3456
#define XB_SPIN_CAP (1u << 18)
#define LAS __attribute__((address_space(3)))

__device__ __forceinline__ unsigned xb_ld(unsigned* p)              { return __hip_atomic_load(p, __ATOMIC_RELAXED, __HIP_MEMORY_SCOPE_AGENT); }
__device__ __forceinline__ unsigned xb_add(unsigned* p, unsigned v) { return __hip_atomic_fetch_add(p, v, __ATOMIC_RELAXED, __HIP_MEMORY_SCOPE_AGENT); }
__device__ __forceinline__ unsigned xb_xcc_id() { return (unsigned)__builtin_amdgcn_s_getreg((3 << 11) | 20) & 0xFu; }
#define XB_SPIN(cond, bar) do { unsigned _sp = 0; while (cond) { __builtin_amdgcn_s_sleep(1); \
    if ((++_sp & 255u) == 0u) { if (xb_ld(&(bar)[XB_TMO])) break; if (_sp > XB_SPIN_CAP) { atomicAdd(&(bar)[XB_TMO], 1u); break; } } } } while (0)

struct XcdBarrier {
    unsigned* bar; unsigned x;
    volatile LAS unsigned* st;
};

__device__ __forceinline__ XcdBarrier xcd_barrier_post(unsigned* bar, volatile LAS unsigned* st) {
    XcdBarrier b; b.bar = bar; b.x = xb_xcc_id(); b.st = st;
    if (get_tid() == 0) (void)xb_add(&bar[XB_XCNT(b.x)], 1u);
    return b;
}
__device__ __forceinline__ void xcd_barrier_complete(unsigned* bar, unsigned x, unsigned& nloc, unsigned& nx) {
    const unsigned G = gridDim.x * gridDim.y * gridDim.z;
    unsigned sum, cnt, mine, sp = 0u;
    for (;;) {
        sum = 0u; cnt = 0u; mine = 0u;
#pragma unroll
        for (unsigned j = 0; j < 16; ++j) { const unsigned c = xb_ld(&bar[XB_XCNT(j)]); sum += c; cnt += (c > 0u) ? 1u : 0u; mine = (j == x) ? c : mine; }
        if (sum == G) break;
        __builtin_amdgcn_s_sleep(1);
        if ((++sp & 255u) == 0u) { if (xb_ld(&bar[XB_TMO])) break; if (sp > XB_SPIN_CAP) { atomicAdd(&bar[XB_TMO], 1u); break; } }
    }
    nloc = mine > 0u ? mine : 1u; nx = cnt > 0u ? cnt : 1u;
}

__device__ __forceinline__ void xcd_barrier(const XcdBarrier& b) {
    asm volatile("s_waitcnt vmcnt(0)" ::: "memory");
    __syncthreads();
    if (get_tid() == 0) {
        unsigned* bar = b.bar;
        __builtin_amdgcn_s_waitcnt(0);
        unsigned nloc = b.st[0], nx = b.st[1];
        if (nloc == 0u) { xcd_barrier_complete(bar, b.x, nloc, nx); b.st[0] = nloc; b.st[1] = nx; }
        const unsigned old = xb_add(&bar[XB_XSUB(b.x)], 1u);
        const unsigned gen = old / nloc;
        if (old + 1u == (gen + 1u) * nloc) {
            __builtin_amdgcn_fence(__ATOMIC_RELEASE, "agent");
            asm volatile("s_waitcnt vmcnt(0)" ::: "memory");
            const unsigned og = xb_add(&bar[XB_TOP], 1u);
            const unsigned tg = og / nx;
            if (og + 1u == (tg + 1u) * nx) xb_add(&bar[XB_TOPGEN], 1u);
            else XB_SPIN(xb_ld(&bar[XB_TOPGEN]) == tg, bar);
            __builtin_amdgcn_fence(__ATOMIC_ACQUIRE, "agent");
            xb_add(&bar[XB_XGEN(b.x)], 1u);
            asm volatile("s_waitcnt vmcnt(0)" ::: "memory");
        } else {
            XB_SPIN(xb_ld(&bar[XB_XGEN(b.x)]) == gen, bar);
            __builtin_amdgcn_fence(__ATOMIC_ACQUIRE, "agent");
            asm volatile("s_waitcnt vmcnt(0)" ::: "memory");
        }
    }
    __syncthreads();
}

constexpr size_t OFF_BAR = OFF_END;
constexpr int LDS_XB = 3 * 49152 + 1024;
__device__ __forceinline__ void grid_bar(PP pp, char* lds) {
  XcdBarrier b; b.bar = (unsigned*)(pp->ws + OFF_BAR); b.x = xb_xcc_id(); b.st = (volatile LAS unsigned*)(lds + LDS_XB);
  xcd_barrier(b);
}
__global__ void __launch_bounds__(512) fwd_megakernel(Params p_arg) {
  extern __shared__ __attribute__((aligned(16))) char lds[];
  cg::grid_group grid = cg::this_grid();
  PP pp = (PP)__builtin_amdgcn_kernarg_segment_ptr();
  { const int t0_ = get_tid(); if (t0_ < 4) ((volatile LAS unsigned*)(lds + LDS_XB))[t0_] = 0u; }
  __syncthreads();
  (void)xcd_barrier_post((unsigned*)(pp->ws + OFF_BAR), (volatile LAS unsigned*)(lds + LDS_XB));
  grid.sync();
  phase0(launder(pp), lds);
  grid_bar(launder(pp), lds);
  row_pass(launder(pp), 0, nullptr, nullptr, 0, 0, 1, true, false, NLAYER > 1);
  grid_bar(launder(pp), lds);
#pragma unroll 1
  for (int l = 0; l < NLAYER; ++l) {
    const bool last = (l == NLAYER - 1);
    const bf16_t* wl = (const bf16_t*)(pp->ws + OFF_W) + (size_t)l * W_LAYER;
    phase_win(launder(pp), l, lds);
    grid_bar(launder(pp), lds);
    phase_up2(launder(pp), l, lds);
    grid_bar(launder(pp), lds);
    phase_attn(launder(pp), l, !last, lds);
    grid_bar(launder(pp), lds);
    phase_res_gemm(launder(pp), l, (const bf16_t*)(pp->ws + OFF_Y), 1024, KP, wl + W_O, 2, last, lds);
    grid_bar(launder(pp), lds);
    row_pass(launder(pp), 1, pp->ln1_g + l * DM, pp->ln1_b + l * DM, l, 3, 4, true, last, !last);
    grid_bar(launder(pp), lds);
    phase_ffn_up(launder(pp), l, lds);
    grid_bar(launder(pp), lds);
    phase_res_gemm(launder(pp), l, (const bf16_t*)(pp->ws + OFF_A2), DFF, DFF, wl + W_DN, 5, last, lds);
    grid_bar(launder(pp), lds);
    row_pass(launder(pp), 1, pp->ln2_g + l * DM, pp->ln2_b + l * DM, l + 1, 0, 1, !last, last, l + 2 < NLAYER);
    if (!last) grid_bar(launder(pp), lds);
  }
}

extern "C" void kernel_launch(void* const* d_in, const int* in_sizes, int n_in, void* d_out, int out_size, void* d_ws, size_t ws_size, hipStream_t stream) {
  static int grid_blocks = 0;
  if (!grid_blocks) {
    int dev = 0, cus = 0, per_cu = 0;
    hipGetDevice(&dev);
    hipDeviceGetAttribute(&cus, hipDeviceAttributeMultiprocessorCount, dev);
    hipFuncSetAttribute((const void*)fwd_megakernel, hipFuncAttributeMaxDynamicSharedMemorySize, LDS_BYTES);
    hipOccupancyMaxActiveBlocksPerMultiprocessor(&per_cu, fwd_megakernel, 512, LDS_BYTES);
    if (per_cu < 1) { fprintf(stderr, "occupancy query returned %d\n", per_cu); per_cu = 1; }
    if (per_cu > 1) per_cu = 1;
    grid_blocks = cus * per_cu;
  }
  Params p{};
  const float** f = (const float**)&p;
  for (int i = 0; i < 29; ++i) f[i] = (const float*)d_in[i];
  p.out = (float*)d_out; p.ws = (char*)d_ws;
  (void)hipMemsetAsync((char*)d_ws + OFF_BAR, 0, XCD_BAR_WORDS * sizeof(unsigned), stream);
  void* args[] = {&p};
  hipError_t e = hipLaunchCooperativeKernel((void*)fwd_megakernel, dim3(grid_blocks), dim3(512), args, LDS_BYTES, stream);
  if (e != hipSuccess) fprintf(stderr, "cooperative launch failed: %s (grid %d)\n", hipGetErrorString(e), grid_blocks);
}
```

```cpp
#include <hip/hip_runtime.h>
#include <hip/hip_cooperative_groups.h>
#include <stdint.h>
#include <cstdio>
namespace cg = cooperative_groups;

typedef unsigned short bf16_t;
typedef short bf16x8 __attribute__((ext_vector_type(8)));
typedef float f32x16 __attribute__((ext_vector_type(16)));
typedef float f32x4 __attribute__((ext_vector_type(4)));
typedef float f32x2 __attribute__((ext_vector_type(2)));
typedef unsigned u32x4 __attribute__((ext_vector_type(4)));
typedef unsigned u32x2 __attribute__((ext_vector_type(2)));

constexpr int DM = 1024, NBATCH = 2, SEQ = 8192, CTX = 256, SB = SEQ + CTX  , T = NBATCH * SB  ;
constexpr int INW = 1984, DFF = 2816, NLAYER = 2;
constexpr int KP = 1088;
constexpr float EPS = 1e-6f;
constexpr float DN_ALPHA = 1.4142135623730951f;
constexpr float LOG2E = 1.4426950408889634f;
constexpr float QS_MLA = 0.07216878364870322f * LOG2E;
constexpr float QS_DIFF = 0.17677669529663687f * LOG2E;

constexpr size_t al256(size_t x) { return (x + 255) / 256 * 256; }
constexpr size_t W_IN = 0;
constexpr size_t W_UQ = W_IN + 2048ull * KP;
constexpr size_t W_UKV = W_UQ + 768ull * 384;
constexpr size_t W_O = W_UKV + 1024ull * 256;
constexpr size_t W_UP = W_O + 1024ull * KP;
constexpr size_t W_DN = W_UP + 5632ull * KP;
constexpr size_t W_SG = W_DN + 1024ull * 2816;
constexpr size_t W_LAYER = W_SG + 4ull * 128 * 128;
constexpr size_t OFF_W = 0;
constexpr size_t OFF_MOD = al256(OFF_W + W_LAYER * 2 * NLAYER);
constexpr size_t OFF_CS16 = al256(OFF_MOD + 2ull * 3 * 6144 * 4);
constexpr size_t OFF_CS8 = al256(OFF_CS16 + 128ull * 16 * 8);
constexpr size_t OFF_CTXRES = al256(OFF_CS8 + 128ull * 8 * 8);
constexpr size_t OFF_HMOD = al256(OFF_CTXRES + 512ull * 1024 * 4);
constexpr size_t OFF_R = al256(OFF_HMOD + (size_t)T * KP * 2);
constexpr size_t OFF_ZQ = OFF_R;
constexpr size_t OFF_KR = al256(OFF_ZQ + (size_t)T * 640 * 2);
constexpr size_t OFF_QD = al256(OFF_KR + (size_t)T * 64 * 2);
constexpr size_t OFF_KD = al256(OFF_QD + (size_t)T * 256 * 2);
constexpr size_t OFF_VDT = al256(OFF_KD + (size_t)T * 256 * 2);
constexpr size_t OFF_ZC = al256(OFF_VDT + (size_t)T * 256 * 2);
constexpr size_t OFF_QM = al256(OFF_ZC + (size_t)T * 512 * 2);
constexpr size_t OFF_KM = al256(OFF_QM + (size_t)T * 768 * 2);
constexpr size_t OFF_VMT = al256(OFF_KM + (size_t)T * 512 * 2);
constexpr size_t OFF_Y = al256(OFF_VMT + (size_t)T * 512 * 2);
constexpr size_t OFF_END = al256(OFF_Y + (size_t)T * KP * 2);
constexpr size_t OFF_A2 = OFF_R;
static_assert(OFF_A2 + (size_t)T * 2816 * 2 <= OFF_END, "A2 alias fits");
constexpr size_t OFF_SSQ = OFF_END + 16384;
static_assert(OFF_SSQ + (size_t)T * 8 <= 268435456ull, "workspace fits 256 MiB");

constexpr int LDS_A_STAGE = 256 * 144, LDS_B_STAGE = 128 * 144;
constexpr int LDS_GEMM = 2 * (LDS_A_STAGE + LDS_B_STAGE);
constexpr int LDS_RSTD = 3 * 49152;
constexpr int LDS_BYTES = 3 * 49152 + 1024 + 16;

struct Params {
  const float *x, *c, *ctx, *c_ctx, *ada_w, *ada_b, *w_in, *mla_gq, *mla_wuq, *mla_gkv, *mla_wukv;
  const float *lq1, *lk1, *lq2, *lk2, *subln_g, *sgu_ln_g, *sgu_ln_b, *sgu_ws, *sgu_bs, *w_o, *ln1_g, *ln1_b;
  const float *ffn_wup, *ffn_convw, *ffn_convb, *ffn_wdown, *ln2_g, *ln2_b;
  float* out; char* ws;
};
typedef const __attribute__((address_space(4))) Params* PP;
__device__ __forceinline__ PP launder(PP q) { asm volatile("" : "+s"(q)); return q; }

__device__ __forceinline__ int get_tid() { int t = threadIdx.x; asm volatile("" : "+v"(t)); return t; }
__device__ __forceinline__ int get_bid() { int t = blockIdx.x; asm volatile("" : "+s"(t)); return t; }
typedef __bf16 bf16x2_t __attribute__((ext_vector_type(2)));
__device__ __forceinline__ unsigned cvtpk(float lo, float hi) { f32x2 v = {lo, hi}; bf16x2_t b = __builtin_convertvector(v, bf16x2_t); return __builtin_bit_cast(unsigned, b); }
__device__ __forceinline__ bf16_t f2bf(float x) { return (bf16_t)(cvtpk(x, 0.f) & 0xffffu); }
__device__ __forceinline__ float bf2f(bf16_t v) { return __uint_as_float(((unsigned)v) << 16); }
__device__ __forceinline__ float bflo(unsigned w) { return __uint_as_float(w << 16); }
__device__ __forceinline__ float bfhi(unsigned w) { return __uint_as_float(w & 0xffff0000u); }
__device__ __forceinline__ int crow(int r, int hi) { return (r & 3) + 8 * (r >> 2) + 4 * hi; }
__device__ __forceinline__ float fexp2(float x) { return __builtin_amdgcn_exp2f(x); }
__device__ __forceinline__ float silu_f(float x) { return x * __builtin_amdgcn_rcpf(1.f + __expf(-x)); }
__device__ __forceinline__ float gelu_tanh(float x) {
  const float u = 0.7978845608028654f * (x + 0.044715f * x * x * x);
  return x * __builtin_amdgcn_rcpf(1.f + __expf(-2.f * u));
}
__device__ __forceinline__ float* xrow(PP pp, int t) {
  const int b = t / SB, j = t - b * SB;
  return j < CTX ? (float*)(pp->ws + OFF_CTXRES) + (size_t)(b * CTX + j) * DM : pp->out + (size_t)(b * SEQ + j - CTX) * DM;
}

constexpr int G_STAGE = 256 * 128 + 128 * 128;
template <class RowMap, class Epi>
__device__ __forceinline__ void gemm_tile(const bf16_t* __restrict__ A, int lda, RowMap rowmap, const bf16_t* __restrict__ Bt, int ldb, int col0, int K,
                                          char* lds, Epi epi) {
  const int tid = get_tid(), lane = tid & 63, wid = tid >> 6, wm = wid >> 1, wn = wid & 1, l31 = lane & 31, hi = lane >> 5;
  const int lr = tid >> 3, lc = tid & 7, kc = lc ^ ((lr >> 1) & 7);
  const bf16_t* ap0 = A + (size_t)rowmap(lr) * lda + kc * 8;
  const bf16_t* ap1 = A + (size_t)rowmap(lr + 64) * lda + kc * 8;
  const bf16_t* ap2 = A + (size_t)rowmap(lr + 128) * lda + kc * 8;
  const bf16_t* ap3 = A + (size_t)rowmap(lr + 192) * lda + kc * 8;
  const bf16_t* bp0 = Bt + (size_t)(col0 + lr) * ldb + kc * 8;
  const bf16_t* bp1 = Bt + (size_t)(col0 + lr + 64) * ldb + kc * 8;
  f32x16 acc[2][2];
#pragma unroll
  for (int i = 0; i < 2; ++i)
#pragma unroll
    for (int j = 0; j < 2; ++j)
#pragma unroll
      for (int r = 0; r < 16; ++r) acc[i][j][r] = 0.f;
#define G_DMA(gp, lp) __builtin_amdgcn_global_load_lds((const unsigned*)(gp), (__attribute__((address_space(3))) unsigned*)(lp), 16, 0, 0)
#define G_ISSUE(st, k0) do { char* sa_ = lds + (st) * G_STAGE + tid * 16; \
    G_DMA(ap0 + (k0), sa_); G_DMA(ap1 + (k0), sa_ + 8192); G_DMA(ap2 + (k0), sa_ + 16384); G_DMA(ap3 + (k0), sa_ + 24576); \
    G_DMA(bp0 + (k0), sa_ + 32768); G_DMA(bp1 + (k0), sa_ + 40960); } while (0)
  const int fsw = (l31 >> 1) & 7, g = fsw >> 1, c0 = l31 * 128 + ((hi ^ (fsw & 1)) << 4);
  const int o0 = c0 + ((0 ^ g) << 5), o1 = c0 + ((1 ^ g) << 5), o2 = c0 + ((2 ^ g) << 5), o3 = c0 + ((3 ^ g) << 5);
  const int abase = (64 * wm) * 128, bbase = 32768 + (64 * wn) * 128;
#define G_FRAG(O, A0, A1, B0, B1) do { A0 = *(const bf16x8*)(cS + abase + (O)); B0 = *(const bf16x8*)(cS + bbase + (O)); \
    A1 = *(const bf16x8*)(cS + abase + 4096 + (O)); B1 = *(const bf16x8*)(cS + bbase + 4096 + (O)); } while (0)
#define G_MMA(A0, A1, B0, B1) do { \
    acc[0][0] = __builtin_amdgcn_mfma_f32_32x32x16_bf16(A0, B0, acc[0][0], 0, 0, 0); \
    acc[0][1] = __builtin_amdgcn_mfma_f32_32x32x16_bf16(A0, B1, acc[0][1], 0, 0, 0); \
    acc[1][0] = __builtin_amdgcn_mfma_f32_32x32x16_bf16(A1, B0, acc[1][0], 0, 0, 0); \
    acc[1][1] = __builtin_amdgcn_mfma_f32_32x32x16_bf16(A1, B1, acc[1][1], 0, 0, 0); } while (0)
  const int nk = K >> 6;
  G_ISSUE(0, 0);
  if (nk > 1) G_ISSUE(1, 64);
  int st = 0, st2 = 2;
  for (int kt = 0; kt < nk; ++kt) {
    if (kt + 1 < nk) asm volatile("s_waitcnt vmcnt(6)" ::: "memory"); else asm volatile("s_waitcnt vmcnt(0)" ::: "memory");
    __builtin_amdgcn_s_barrier();
    if (kt + 2 < nk) G_ISSUE(st2, (kt + 2) * 64);
    const char* cS = lds + st * G_STAGE;
    bf16x8 pa0, pa1, pb0, pb1, qa0, qa1, qb0, qb1, ra0_, ra1_, rb0_, rb1_;
    G_FRAG(o0, pa0, pa1, pb0, pb1); G_FRAG(o1, qa0, qa1, qb0, qb1); __builtin_amdgcn_sched_barrier(0);
    G_MMA(pa0, pa1, pb0, pb1); G_FRAG(o2, ra0_, ra1_, rb0_, rb1_); __builtin_amdgcn_sched_barrier(0);
    G_MMA(qa0, qa1, qb0, qb1); G_FRAG(o3, pa0, pa1, pb0, pb1); __builtin_amdgcn_sched_barrier(0);
    G_MMA(ra0_, ra1_, rb0_, rb1_); G_MMA(pa0, pa1, pb0, pb1);
    st = st == 2 ? 0 : st + 1; st2 = st2 == 2 ? 0 : st2 + 1;
  }
#undef G_DMA
#undef G_ISSUE
#undef G_FRAG
#undef G_MMA
  __syncthreads();
  epi(acc, 64 * wm, col0 + 64 * wn);
}

template <class RowMap, class Post>
__device__ __forceinline__ void gemm_tile256b(const bf16_t* __restrict__ A, int lda, RowMap rowmap, const bf16_t* __restrict__ Bt, int ldb, int col0, int K,
                                             char* lds, Post post) {
  const int tid = get_tid(), lane = tid & 63, wid = tid >> 6, wm = wid >> 1, wn = wid & 1, l31 = lane & 31, hi = lane >> 5;
  const int lr = tid >> 3, lc = tid & 7, kc = lc ^ ((lr >> 1) & 7);
  const bf16_t* ap0 = A + (size_t)rowmap(lr) * lda + kc * 8;
  const bf16_t* ap1 = A + (size_t)rowmap(lr + 64) * lda + kc * 8;
  const bf16_t* ap2 = A + (size_t)rowmap(lr + 128) * lda + kc * 8;
  const bf16_t* ap3 = A + (size_t)rowmap(lr + 192) * lda + kc * 8;
  const bf16_t* bp0 = Bt + (size_t)(col0 + lr) * ldb + kc * 8;
  const size_t bstep = (size_t)64 * ldb;
  const int l15 = lane & 15, q4 = lane >> 4;
  f32x4 acc[4][8];
#pragma unroll
  for (int i = 0; i < 4; ++i)
#pragma unroll
    for (int j = 0; j < 8; ++j) { acc[i][j][0] = 0.f; acc[i][j][1] = 0.f; acc[i][j][2] = 0.f; acc[i][j][3] = 0.f; }
#define H_DMA(gp, lp) __builtin_amdgcn_global_load_lds((const unsigned*)(gp), (__attribute__((address_space(3))) unsigned*)(lp), 16, 0, 0)
#define H_ISSUE(st, k0) do { char* sa_ = lds + (st) * 65536 + tid * 16; \
    H_DMA(ap0 + (k0), sa_); H_DMA(ap1 + (k0), sa_ + 8192); H_DMA(ap2 + (k0), sa_ + 16384); H_DMA(ap3 + (k0), sa_ + 24576); \
    H_DMA(bp0 + (k0), sa_ + 32768); H_DMA(bp0 + bstep + (k0), sa_ + 40960); H_DMA(bp0 + 2 * bstep + (k0), sa_ + 49152); H_DMA(bp0 + 3 * bstep + (k0), sa_ + 57344); } while (0)
  const int fsw = l15 >> 1, c0 = l15 * 128;
  const int ok0 = c0 + (((0 + q4) ^ fsw) << 4), ok1 = c0 + (((4 + q4) ^ fsw) << 4);
  const int abase = (64 * wm) * 128, bbase = 32768 + (128 * wn) * 128;
#define H_FA(O, F) do { F[0] = *(const bf16x8*)(cS + abase + (O)); F[1] = *(const bf16x8*)(cS + abase + 2048 + (O)); \
    F[2] = *(const bf16x8*)(cS + abase + 4096 + (O)); F[3] = *(const bf16x8*)(cS + abase + 6144 + (O)); } while (0)
#define H_FB(O, NH, F) do { F[0] = *(const bf16x8*)(cS + bbase + (NH) * 8192 + (O)); F[1] = *(const bf16x8*)(cS + bbase + (NH) * 8192 + 2048 + (O)); \
    F[2] = *(const bf16x8*)(cS + bbase + (NH) * 8192 + 4096 + (O)); F[3] = *(const bf16x8*)(cS + bbase + (NH) * 8192 + 6144 + (O)); } while (0)
#define H_MMA(FA, FB, NH) do { _Pragma("unroll") for (int mi_ = 0; mi_ < 4; ++mi_) { _Pragma("unroll") for (int nj_ = 0; nj_ < 4; ++nj_) \
    acc[mi_][(NH) * 4 + nj_] = __builtin_amdgcn_mfma_f32_16x16x32_bf16(FA[mi_], FB[nj_], acc[mi_][(NH) * 4 + nj_], 0, 0, 0); } } while (0)
  const int nk = K >> 6;
  H_ISSUE(0, 0);
  for (int kt = 0; kt < nk; ++kt) {
    asm volatile("s_waitcnt vmcnt(0)" ::: "memory");
    __builtin_amdgcn_s_barrier();
    if (kt + 1 < nk) H_ISSUE((kt + 1) & 1, (kt + 1) * 64);
    const char* cS = lds + (kt & 1) * 65536;
    bf16x8 fa0[4], fb0[4];
    H_FA(ok0, fa0); H_FB(ok0, 0, fb0); __builtin_amdgcn_sched_barrier(0);
    H_MMA(fa0, fb0, 0); __builtin_amdgcn_sched_barrier(0);
    H_FB(ok0, 1, fb0); __builtin_amdgcn_sched_barrier(0);
    H_MMA(fa0, fb0, 1); __builtin_amdgcn_sched_barrier(0);
    H_FA(ok1, fa0); H_FB(ok1, 0, fb0); __builtin_amdgcn_sched_barrier(0);
    H_MMA(fa0, fb0, 0); __builtin_amdgcn_sched_barrier(0);
    H_FB(ok1, 1, fb0); __builtin_amdgcn_sched_barrier(0);
    H_MMA(fa0, fb0, 1);
  }
#undef H_DMA
#undef H_ISSUE
#undef H_FA
#undef H_FB
#undef H_MMA
  float* ut = (float*)lds;
#pragma unroll
  for (int h = 0; h < 2; ++h) {
    __syncthreads();
    if (wn == h) {
#pragma unroll
      for (int mi = 0; mi < 4; ++mi)
#pragma unroll
        for (int ni = 0; ni < 8; ++ni)
#pragma unroll
          for (int r = 0; r < 4; ++r) ut[(64 * wm + 16 * mi + 4 * q4 + r) * 128 + 16 * ni + l15] = acc[mi][ni][r];
    }
    __syncthreads();
    post(h);
  }
  __syncthreads();
}

template <class RowMap, class Post>
__device__ __forceinline__ void gemm_tile256(const bf16_t* __restrict__ A, int lda, RowMap rowmap, const bf16_t* __restrict__ Bt, int ldb, int col0, int K,
                                             char* lds, Post post) {
  const int tid = get_tid(), lane = tid & 63, wid = tid >> 6, wm = wid >> 1, wn = wid & 1, l31 = lane & 31, hi = lane >> 5;
  const int lr = tid >> 3, lc = tid & 7, kc = lc ^ ((lr >> 1) & 7);
  const bf16_t* ap0 = A + (size_t)rowmap(lr) * lda + kc * 8;
  const bf16_t* ap1 = A + (size_t)rowmap(lr + 64) * lda + kc * 8;
  const bf16_t* ap2 = A + (size_t)rowmap(lr + 128) * lda + kc * 8;
  const bf16_t* ap3 = A + (size_t)rowmap(lr + 192) * lda + kc * 8;
  const bf16_t* bp0 = Bt + (size_t)(col0 + lr) * ldb + kc * 8;
  const size_t bstep = (size_t)64 * ldb;
  f32x16 acc[2][4];
#pragma unroll
  for (int i = 0; i < 2; ++i)
#pragma unroll
    for (int j = 0; j < 4; ++j)
#pragma unroll
      for (int r = 0; r < 16; ++r) acc[i][j][r] = 0.f;
#define H_DMA(gp, lp) __builtin_amdgcn_global_load_lds((const unsigned*)(gp), (__attribute__((address_space(3))) unsigned*)(lp), 16, 0, 0)
#define H_ISSUE(st, k0) do { char* sa_ = lds + (st) * 65536 + tid * 16; \
    H_DMA(ap0 + (k0), sa_); H_DMA(ap1 + (k0), sa_ + 8192); H_DMA(ap2 + (k0), sa_ + 16384); H_DMA(ap3 + (k0), sa_ + 24576); \
    H_DMA(bp0 + (k0), sa_ + 32768); H_DMA(bp0 + bstep + (k0), sa_ + 40960); H_DMA(bp0 + 2 * bstep + (k0), sa_ + 49152); H_DMA(bp0 + 3 * bstep + (k0), sa_ + 57344); } while (0)
  const int fsw = (l31 >> 1) & 7, g = fsw >> 1, c0 = l31 * 128 + ((hi ^ (fsw & 1)) << 4);
  const int o0 = c0 + ((0 ^ g) << 5), o1 = c0 + ((1 ^ g) << 5), o2 = c0 + ((2 ^ g) << 5), o3 = c0 + ((3 ^ g) << 5);
  const int abase = (64 * wm) * 128, bbase = 32768 + (128 * wn) * 128;
#define H_FRAG(O, F) do { F[0] = *(const bf16x8*)(cS + abase + (O)); F[1] = *(const bf16x8*)(cS + abase + 4096 + (O)); \
    F[2] = *(const bf16x8*)(cS + bbase + (O)); F[3] = *(const bf16x8*)(cS + bbase + 4096 + (O)); \
    F[4] = *(const bf16x8*)(cS + bbase + 8192 + (O)); F[5] = *(const bf16x8*)(cS + bbase + 12288 + (O)); } while (0)
#define H_MMA(F) do { _Pragma("unroll") for (int nb_ = 0; nb_ < 4; ++nb_) { \
    acc[0][nb_] = __builtin_amdgcn_mfma_f32_32x32x16_bf16(F[0], F[2 + nb_], acc[0][nb_], 0, 0, 0); \
    acc[1][nb_] = __builtin_amdgcn_mfma_f32_32x32x16_bf16(F[1], F[2 + nb_], acc[1][nb_], 0, 0, 0); } } while (0)
  const int nk = K >> 6;
  H_ISSUE(0, 0);
  for (int kt = 0; kt < nk; ++kt) {
    asm volatile("s_waitcnt vmcnt(0)" ::: "memory");
    __builtin_amdgcn_s_barrier();
    if (kt + 1 < nk) H_ISSUE((kt + 1) & 1, (kt + 1) * 64);
    const char* cS = lds + (kt & 1) * 65536;
    bf16x8 f0[6], f1[6];
    H_FRAG(o0, f0); H_FRAG(o1, f1); __builtin_amdgcn_sched_barrier(0);
    H_MMA(f0); H_FRAG(o2, f0); __builtin_amdgcn_sched_barrier(0);
    H_MMA(f1); H_FRAG(o3, f1); __builtin_amdgcn_sched_barrier(0);
    H_MMA(f0); H_MMA(f1);
  }
#undef H_DMA
#undef H_ISSUE
#undef H_FRAG
#undef H_MMA
  float* ut = (float*)lds;
#pragma unroll
  for (int h = 0; h < 2; ++h) {
    __syncthreads();
    if (wn == h) {
#pragma unroll
      for (int mb = 0; mb < 2; ++mb)
#pragma unroll
        for (int nb = 0; nb < 4; ++nb)
#pragma unroll
          for (int r = 0; r < 16; ++r) ut[(64 * wm + 32 * mb + crow(r, hi)) * 128 + 32 * nb + l31] = acc[mb][nb][r];
    }
    __syncthreads();
    post(h);
  }
  __syncthreads();
}

struct RowId { int r0; __device__ __forceinline__ int operator()(int i) const { return r0 + i; } };
struct RowHalo { int r0; __device__ __forceinline__ int operator()(int i) const { int r = r0 + i; r = r < 0 ? 0 : r; return r > T - 1 ? T - 1 : r; } };

__device__ __forceinline__ void transpose_item(const float* __restrict__ src, int ldsrc, int K  , bf16_t* __restrict__ dst, int kt, int ntile, int mode,
                               const float* __restrict__ kscale, float* tile) {
  const int tid = get_tid(), k0 = kt * 64, n0 = ntile * 64;
#pragma unroll
  for (int i = 0; i < 2; ++i) {
    const int kk = (tid >> 4) + 32 * i, n4 = (tid & 15) * 4, nn = n0 + n4;
    const int sc = mode == 1 ? (((nn & 63) < 32) ? (nn >> 6) * 32 + (nn & 31) : DFF + (nn >> 6) * 32 + (nn & 31)) : nn;
    f32x4 v = *(const f32x4*)(src + (size_t)(k0 + kk) * ldsrc + sc);
    if (kscale) { const float g = kscale[k0 + kk]; v *= g; }
    float* tp = tile + kk * 65 + n4; tp[0] = v[0]; tp[1] = v[1]; tp[2] = v[2]; tp[3] = v[3];
  }
  __syncthreads();
  {
    const int n = tid >> 3, kc = tid & 7; const float* tp = tile + (kc * 8) * 65 + n;
    u32x4 w; w[0] = cvtpk(tp[0], tp[65]); w[1] = cvtpk(tp[130], tp[195]); w[2] = cvtpk(tp[260], tp[325]); w[3] = cvtpk(tp[390], tp[455]);
    *(u32x4*)(dst + (size_t)(n0 + n) * K + k0 + kc * 8) = w;
  }
  __syncthreads();
}

__device__ __forceinline__ void phase0(PP pp, char* lds) {
  const int tid = get_tid();
  float* svec = (float*)lds; float* red = (float*)(lds + 12288); float* tile = (float*)(lds + 20480);
  for (int i = tid; i < 3072; i += 512) { const int v = i >> 10, k = i & 1023; const float val = v < 2 ? pp->c[v * 1024 + k] : pp->c_ctx[k]; svec[i] = silu_f(val); }
  __syncthreads();
  constexpr int N_ADA = 192, N_ROPE = 1, N_TR = 3000, N_SG = 16, PER_L = N_TR + N_SG;
  constexpr int N_ITEMS = N_ADA + N_ROPE + NLAYER * PER_L;
  for (int it = get_bid(); it < N_ITEMS; it += gridDim.x) {
    if (it < N_ADA) {
      const int l = it / 96, c0 = (it % 96) * 64, col = tid & 63, kg = tid >> 6;
      const float* wp = pp->ada_w + ((size_t)l * 1024 + kg * 128) * 6144 + c0 + col;
      float a0 = 0.f, a1 = 0.f, a2 = 0.f;
#pragma unroll 8
      for (int k = 0; k < 128; ++k) { const float w = wp[(size_t)k * 6144]; const int kk = kg * 128 + k; a0 += svec[kk] * w; a1 += svec[1024 + kk] * w; a2 += svec[2048 + kk] * w; }
      red[(kg * 3 + 0) * 64 + col] = a0; red[(kg * 3 + 1) * 64 + col] = a1; red[(kg * 3 + 2) * 64 + col] = a2;
      __syncthreads();
      if (tid < 192) { const int v = tid >> 6; float s = 0.f;
#pragma unroll
        for (int g = 0; g < 8; ++g) s += red[(g * 3 + v) * 64 + col];
        ((float*)(pp->ws + OFF_MOD))[(size_t)(l * 3 + v) * 6144 + c0 + col] = s + pp->ada_b[l * 6144 + c0 + col]; }
      __syncthreads();
    } else if (it < N_ADA + N_ROPE) {
      for (int e = tid; e < 128 * 24; e += 512) {
        const int pos = e / 24, i = e % 24; const bool big = i < 16; const int ii = big ? i : i - 16;
        const float inv = exp2f(-(float)ii / (big ? 16.f : 8.f) * 13.287712379549449f);
        const float ang = (float)pos * inv;
        const double a = (double)ang; const double n = rint(a * 0.15915494309189535); const float y = (float)(a - n * 6.283185307179586);
        f32x2 cs; cs[0] = cosf(y); cs[1] = sinf(y);
        if (big) ((f32x2*)(pp->ws + OFF_CS16))[pos * 16 + ii] = cs; else ((f32x2*)(pp->ws + OFF_CS8))[pos * 8 + ii] = cs;
      }
    } else {
      const int q = it - N_ADA - N_ROPE, l = q / PER_L; int t = q % PER_L;
      bf16_t* wl = (bf16_t*)(pp->ws + OFF_W) + (size_t)l * W_LAYER;
      if (t < 496) transpose_item(pp->w_in + (size_t)l * 1024 * INW, INW, KP, wl + W_IN, t % 16, t / 16, 0, nullptr, tile);
      else if (t < 568) { t -= 496; transpose_item(pp->mla_wuq + (size_t)l * 384 * 768, 768, 384, wl + W_UQ, t % 6, t / 6, 0, pp->mla_gq + l * 384, tile); }
      else if (t < 632) { t -= 568; transpose_item(pp->mla_wukv + (size_t)l * 256 * 1024, 1024, 256, wl + W_UKV, t % 4, t / 4, 0, pp->mla_gkv + l * 256, tile); }
      else if (t < 888) { t -= 632; transpose_item(pp->w_o + (size_t)l * 1024 * 1024, 1024, KP, wl + W_O, t % 16, t / 16, 0, nullptr, tile); }
      else if (t < 2296) { t -= 888; transpose_item(pp->ffn_wup + (size_t)l * 1024 * 5632, 5632, KP, wl + W_UP, t % 16, t / 16, 1, nullptr, tile); }
      else if (t < 3000) { t -= 2296; transpose_item(pp->ffn_wdown + (size_t)l * DFF * 1024, 1024, DFF, wl + W_DN, t % 44, t / 44, 0, nullptr, tile); }
      else { t -= 3000; const size_t idx = (size_t)t * 4096 + tid * 8; const float* s = pp->sgu_ws + (size_t)l * 65536 + idx;
        const f32x4 v0 = *(const f32x4*)s, v1 = *(const f32x4*)(s + 4);
        u32x4 w; w[0] = cvtpk(v0[0], v0[1]); w[1] = cvtpk(v0[2], v0[3]); w[2] = cvtpk(v1[0], v1[1]); w[3] = cvtpk(v1[2], v1[3]);
        *(u32x4*)(wl + W_SG + idx) = w; }
    }
  }
}

__device__ __forceinline__ void row_pass(PP pp, int mode, const float* __restrict__ lg, const float* __restrict__ lb, int lm, int shc, int scc, bool want_h, bool skip_ctx, bool alpha_ctx) {
  const int lane = get_tid() & 63, wid = get_tid() >> 6;
  const float* mod = (const float*)(pp->ws + OFF_MOD) + (size_t)lm * 3 * 6144;
  bf16_t* hmod = (bf16_t*)(pp->ws + OFF_HMOD);
  for (int t = get_bid() * 8 + wid; t < T; t += gridDim.x * 8) {
    const int b = t / SB, j = t - b * SB; const bool isctx = j < CTX;
    if (isctx && skip_ctx) continue;
    float* xr = xrow(pp, t);
    const float* src = mode == 0 ? (isctx ? pp->ctx + (size_t)(b * CTX + j) * DM : pp->x + (size_t)(b * SEQ + j - CTX) * DM) : xr;
    f32x4 v[4];
#pragma unroll
    for (int i = 0; i < 4; ++i) v[i] = *(const f32x4*)(src + (i * 64 + lane) * 4);
    if (mode == 1) {
      float s = 0.f;
#pragma unroll
      for (int i = 0; i < 4; ++i) s += (v[i][0] + v[i][1]) + (v[i][2] + v[i][3]);
#pragma unroll
      for (int o = 32; o > 0; o >>= 1) s += __shfl_xor(s, o);
      const float mu = s * (1.f / 1024.f);
      float q = 0.f;
#pragma unroll
      for (int i = 0; i < 4; ++i) { v[i] -= mu; q += (v[i][0] * v[i][0] + v[i][1] * v[i][1]) + (v[i][2] * v[i][2] + v[i][3] * v[i][3]); }
#pragma unroll
      for (int o = 32; o > 0; o >>= 1) q += __shfl_xor(q, o);
      const float rstd = rsqrtf(q * (1.f / 1024.f) + EPS);
#pragma unroll
      for (int i = 0; i < 4; ++i) { const int c = (i * 64 + lane) * 4; const f32x4 g = *(const f32x4*)(lg + c), bb = *(const f32x4*)(lb + c); v[i] = v[i] * rstd * g + bb; }
    }
    { const float sca = (isctx && alpha_ctx) ? DN_ALPHA : 1.f;
#pragma unroll
      for (int i = 0; i < 4; ++i) *(f32x4*)(xr + (i * 64 + lane) * 4) = v[i] * sca; }
    if (want_h) {
      if (lane == 0) { float z0 = 0.f; asm volatile("" : "+v"(z0)); f32x2 z; z[0] = z0; z[1] = z0; *(f32x2*)(pp->ws + OFF_SSQ + (size_t)t * 8) = z; }
      const float* mv = mod + (size_t)(isctx ? 2 : b) * 6144;
#pragma unroll
      for (int i = 0; i < 4; ++i) { const int c = (i * 64 + lane) * 4; const f32x4 sh = *(const f32x4*)(mv + shc * 1024 + c), sc = *(const f32x4*)(mv + scc * 1024 + c);
        const f32x4 h = v[i] * (sc + 1.f) + sh; u32x2 w; w[0] = cvtpk(h[0], h[1]); w[1] = cvtpk(h[2], h[3]); *(u32x2*)(hmod + (size_t)t * KP + c) = w; }
    }
  }
}

__device__ __forceinline__ void dump_tile(f32x16 (&acc)[2][2], int rbase, int cl, float* ut, int c31, int hi) {
#pragma unroll
  for (int mb = 0; mb < 2; ++mb)
#pragma unroll
    for (int nb = 0; nb < 2; ++nb)
#pragma unroll
      for (int r = 0; r < 16; ++r) ut[(rbase + 32 * mb + crow(r, hi)) * 128 + cl + 32 * nb + c31] = acc[mb][nb][r];
}
__device__ __forceinline__ u32x4 pack8f(const f32x4 a, const f32x4 b) { u32x4 w; w[0] = cvtpk(a[0], a[1]); w[1] = cvtpk(a[2], a[3]); w[2] = cvtpk(b[0], b[1]); w[3] = cvtpk(b[2], b[3]); return w; }
__device__ __forceinline__ void rope8(f32x4& a, f32x4& b, const f32x4 pa, const f32x4 pb, const f32x2* cs, bool upper) {
  const float sg = upper ? 1.f : -1.f;
#pragma unroll
  for (int e = 0; e < 4; ++e) { const f32x2 c0 = cs[e], c1 = cs[4 + e]; a[e] = a[e] * c0[0] + sg * pa[e] * c0[1]; b[e] = b[e] * c1[0] + sg * pb[e] * c1[1]; }
}
template <int NCOL>
__device__ __forceinline__ void store_transposed(const float* ut, int lc0, bf16_t* dst  , const float* rscale) {
  const int tid = get_tid(), col = tid & (NCOL - 1), rc0 = tid / NCOL;
#pragma unroll 2
  for (int rc = rc0; rc < 32; rc += 512 / NCOL) {
    float v[8];
#pragma unroll
    for (int e = 0; e < 8; ++e) { v[e] = ut[(rc * 8 + e) * 128 + lc0 + col]; if (rscale) v[e] *= rscale[rc * 8 + e]; }
    u32x4 w; w[0] = cvtpk(v[0], v[1]); w[1] = cvtpk(v[2], v[3]); w[2] = cvtpk(v[4], v[5]); w[3] = cvtpk(v[6], v[7]);
    *(u32x4*)(dst + (size_t)col * SB + rc * 8) = w;
  }
}

__device__ __forceinline__ void phase_win(PP pp, int l, char* lds) {
  const bf16_t* A = (const bf16_t*)(pp->ws + OFF_HMOD);
  const bf16_t* Bt = (const bf16_t*)(pp->ws + OFF_W) + (size_t)l * W_LAYER + W_IN;
  bf16_t* zq = (bf16_t*)(pp->ws + OFF_ZQ); bf16_t* Kr = (bf16_t*)(pp->ws + OFF_KR); bf16_t* Qd = (bf16_t*)(pp->ws + OFF_QD); bf16_t* Kd = (bf16_t*)(pp->ws + OFF_KD);
  bf16_t* VdT = (bf16_t*)(pp->ws + OFF_VDT); bf16_t* zc = (bf16_t*)(pp->ws + OFF_ZC);
  const f32x2* cs16 = (const f32x2*)(pp->ws + OFF_CS16); const f32x2* cs8 = (const f32x2*)(pp->ws + OFF_CS8);
  const int tid = get_tid(), lane = tid & 63, c31 = lane & 31, hi = lane >> 5;
  float* ut = (float*)lds;
  const bool xmap = gridDim.x == 256; const int xq = get_bid() & 7, xj = get_bid() >> 3;
  for (int it0 = get_bid(); it0 < 64 * 8 + 32; it0 += gridDim.x) {
    const int it = (xmap && it0 < 512) ? ((xq * 8 + (((it0 >> 8) * 32 + xj) >> 3)) << 3) + (xj & 7) : it0;
    const bool lat = it < 512; const int mi = it >> 3;
    const int mt = lat ? (mi >> 5) * 33 + 1 + (mi & 31) : ((it - 512) >> 4) * 33, nt2 = it & 7, ntc = (it - 512) & 15;
    const int row0 = mt * 256, b = mt / 33, j0 = row0 - b * SB; const bool isctx = !lat;
    auto post_nt = [&](int nt) {
    {
      const int cc = tid & 15, seg = 2 * nt + (cc >> 3), col = nt * 128 + cc * 8;
      if (seg < 31 && !(seg >= 19 && seg < 23)) {
#pragma unroll 2
        for (int i = 0; i < 8; ++i) {
          const int row = (tid >> 4) + 32 * i, t = row0 + row; const float* up = ut + row * 128 + cc * 8;
          f32x4 va = *(const f32x4*)up, vb = *(const f32x4*)(up + 4);
          if (seg < 10) { *(u32x4*)(zq + (size_t)t * 640 + col) = pack8f(va, vb);
            float ss = (va[0] * va[0] + va[1] * va[1]) + (va[2] * va[2] + va[3] * va[3]) + (vb[0] * vb[0] + vb[1] * vb[1]) + (vb[2] * vb[2] + vb[3] * vb[3]);
            ss += __shfl_xor(ss, 1); ss += __shfl_xor(ss, 2); ss += __shfl_xor(ss, 4);
            if ((cc & 7) == 0) atomicAdd((float*)(pp->ws + OFF_SSQ) + (size_t)t * 2 + (seg < 6 ? 0 : 1), ss); }
          else if (seg == 10) {
            if (!isctx) { const float* qp = ut + row * 128 + (cc ^ 2) * 8; const f32x4 pa = *(const f32x4*)qp, pb = *(const f32x4*)(qp + 4);
              const int ppos = j0 + row - CTX, pos = ((cc & 4) == 0) ? (ppos >> 6) : (ppos & 63);
              rope8(va, vb, pa, pb, cs16 + pos * 16 + (cc & 1) * 8, (cc & 2) != 0); }
            *(u32x4*)(Kr + (size_t)t * 64 + (cc & 7) * 8) = pack8f(va, vb);
          } else if (seg < 19) {
            if (!isctx) { const float* qp = ut + row * 128 + (cc ^ 1) * 8; const f32x4 pa = *(const f32x4*)qp, pb = *(const f32x4*)(qp + 4);
              const int ppos = j0 + row - CTX, pos = ((cc & 2) == 0) ? (ppos >> 6) : (ppos & 63);
              rope8(va, vb, pa, pb, cs8 + pos * 8, (cc & 1) != 0); }
            if (seg < 15) { va *= QS_DIFF; vb *= QS_DIFF; *(u32x4*)(Qd + (size_t)t * 256 + col - 704) = pack8f(va, vb); }
            else *(u32x4*)(Kd + (size_t)t * 256 + col - 960) = pack8f(va, vb);
          } else {
#pragma unroll
            for (int e = 0; e < 4; ++e) { va[e] = gelu_tanh(va[e]); vb[e] = gelu_tanh(vb[e]); }
            *(u32x4*)(zc + (size_t)t * 512 + col - 1472) = pack8f(va, vb);
          }
        }
      }
#pragma unroll
      for (int sh = 0; sh < 2; ++sh) { const int sg = 2 * nt + sh;
        if (sg >= 19 && sg < 23) store_transposed<64>(ut, sh * 64, VdT + (size_t)(b * 4 + (sg - 19)) * 64 * SB + j0, nullptr); }
    }
    };
    if (lat) { auto post = [&](int h) { post_nt(2 * nt2 + h); }; gemm_tile256b(A, KP, RowId{row0}, Bt, KP, nt2 * 256, DM, lds, post); }
    else {
      auto epi = [&](f32x16 (&acc)[2][2], int rbase, int cbase) { dump_tile(acc, rbase, cbase - ntc * 128, ut, c31, hi); };
      gemm_tile(A, KP, RowId{row0}, Bt, KP, ntc * 128, DM, lds, epi);
      __syncthreads(); post_nt(ntc); __syncthreads();
    }
  }
}

__device__ __forceinline__ void phase_up2(PP pp, int l, char* lds) {
  const bf16_t* zq = (const bf16_t*)(pp->ws + OFF_ZQ);
  const bf16_t* wl = (const bf16_t*)(pp->ws + OFF_W) + (size_t)l * W_LAYER;
  bf16_t* Qm = (bf16_t*)(pp->ws + OFF_QM); bf16_t* Km = (bf16_t*)(pp->ws + OFF_KM); bf16_t* VmT = (bf16_t*)(pp->ws + OFF_VMT);
  const bf16_t* zc = (const bf16_t*)(pp->ws + OFF_ZC); bf16_t* Y = (bf16_t*)(pp->ws + OFF_Y);
  const f32x2* cs16 = (const f32x2*)(pp->ws + OFF_CS16);
  const int tid = get_tid(), lane = tid & 63, wid = tid >> 6, c31 = lane & 31, hi = lane >> 5;
  float* rstd = (float*)(lds + LDS_RSTD);
  constexpr int N_UQ = 66 * 3, N_UKV = 66 * 4, N_CH = 132;
  const float* ssq = (const float*)(pp->ws + OFF_SSQ);
  for (int it = get_bid(); it < N_UQ + N_UKV; it += gridDim.x) {
    {
      const bool isq = it < N_UQ; const int q = isq ? it : it - N_UQ; const int nN = isq ? 3 : 4;
      const int mt = q / nN, nt2 = q % nN, row0 = mt * 256, b = mt / 33, j0 = row0 - b * SB; const bool isctx = (mt % 33) == 0;
      if (tid < 256) rstd[tid] = rsqrtf(ssq[(size_t)(row0 + tid) * 2 + (isq ? 0 : 1)] * (isq ? 1.f / 384.f : 1.f / 256.f) + EPS);
      float* ut = (float*)lds;
      auto post = [&](int h) {
        const int nt = 2 * nt2 + h;
        if (isq || (nt & 1) == 0) {
          const int cc = tid & 15, seg = 2 * nt + (cc >> 3), col = nt * 128 + cc * 8;
#pragma unroll 2
          for (int i = 0; i < 8; ++i) {
            const int row = (tid >> 4) + 32 * i, t = row0 + row; const float* up = ut + row * 128 + cc * 8; const float rs = rstd[row];
            f32x4 va = *(const f32x4*)up, vb = *(const f32x4*)(up + 4);
            if (isq) {
              if ((seg % 3) == 2 && !isctx) { const float* qp = ut + row * 128 + (cc ^ 2) * 8; const f32x4 pa = *(const f32x4*)qp, pb = *(const f32x4*)(qp + 4);
                const int ppos = j0 + row - CTX, pos = ((cc & 4) == 0) ? (ppos >> 6) : (ppos & 63);
                rope8(va, vb, pa, pb, cs16 + pos * 16 + (cc & 1) * 8, (cc & 2) != 0); }
              va *= rs * QS_MLA; vb *= rs * QS_MLA;
              *(u32x4*)(Qm + (size_t)t * 768 + col) = pack8f(va, vb);
            } else {
              va *= rs; vb *= rs;
              *(u32x4*)(Km + (size_t)t * 512 + (nt >> 1) * 128 + cc * 8) = pack8f(va, vb);
            }
          }
        } else {
          store_transposed<128>(ut, 0, VmT + (size_t)(b * 4 + (nt >> 1)) * 128 * SB + j0, rstd);
        }
      };
      gemm_tile256(isq ? zq : zq + 384, 640, RowId{row0}, isq ? wl + W_UQ : wl + W_UKV, isq ? 384 : 256, nt2 * 256, isq ? 384 : 256, lds, post);
    }
  }
  for (int it = (get_bid() + gridDim.x - ((N_UQ + N_UKV) % gridDim.x)) % gridDim.x; it < N_CH * 4; it += gridDim.x) {
    {
      const int ch = it >> 2, g0 = it & 3, t0 = ch * 128;
      float* st = (float*)lds;
      bf16_t* vT = (bf16_t*)(lds + 1024);
      if (tid < 256) {
        const int r = tid >> 1, hf = tid & 1; const bf16_t* rp = zc + (size_t)(t0 + r) * 512 + 256 + hf * 128;
        float s = 0.f, ss = 0.f;
        for (int i = 0; i < 16; ++i) { const u32x4 w = *(const u32x4*)(rp + i * 8);
#pragma unroll
          for (int e = 0; e < 4; ++e) { const float a = bflo(w[e]), c = bfhi(w[e]); s += a + c; ss += a * a + c * c; } }
        s += __shfl_xor(s, 1); ss += __shfl_xor(ss, 1);
        const float mu = s * (1.f / 256.f); const float var = fmaxf(ss * (1.f / 256.f) - mu * mu, 0.f);
        if (hf == 0) { st[2 * r] = mu; st[2 * r + 1] = rsqrtf(var + EPS); }
      }
      __syncthreads();
      const bf16_t* Ws = wl + W_SG;
      for (int g = g0; g < g0 + 1; ++g) {
        {
          const int r = tid >> 2, q4 = tid & 3; const bf16_t* rp = zc + (size_t)(t0 + r) * 512 + 256 + g * 64 + q4 * 16;
          const float mu = st[2 * r], rs = st[2 * r + 1];
          const float* lg = pp->sgu_ln_g + l * 256 + g * 64 + q4 * 16; const float* lb = pp->sgu_ln_b + l * 256 + g * 64 + q4 * 16;
#pragma unroll
          for (int i = 0; i < 2; ++i) { const u32x4 w = *(const u32x4*)(rp + i * 8);
#pragma unroll
            for (int e = 0; e < 4; ++e) { const int c = i * 8 + 2 * e;
              vT[(q4 * 16 + c) * 136 + r] = f2bf((bflo(w[e]) - mu) * rs * lg[c] + lb[c]);
              vT[(q4 * 16 + c + 1) * 136 + r] = f2bf((bfhi(w[e]) - mu) * rs * lg[c + 1] + lb[c + 1]); } }
        }
        __syncthreads();
        if (wid < 4) {
          f32x16 a0 = {}, a1 = {};
          const bf16_t* wrow = Ws + ((size_t)g * 128 + 32 * wid + c31) * 128 + hi * 8;
#pragma unroll
          for (int ks = 0; ks < 8; ++ks) {
            const bf16x8 a = *(const bf16x8*)(wrow + ks * 16);
            const bf16x8 b0 = *(const bf16x8*)((const char*)vT + (c31) * 272 + ks * 32 + hi * 16);
            const bf16x8 b1 = *(const bf16x8*)((const char*)vT + (32 + c31) * 272 + ks * 32 + hi * 16);
            a0 = __builtin_amdgcn_mfma_f32_32x32x16_bf16(a, b0, a0, 0, 0, 0);
            a1 = __builtin_amdgcn_mfma_f32_32x32x16_bf16(a, b1, a1, 0, 0, 0);
          }
#pragma unroll
          for (int r = 0; r < 16; ++r) { const int pr = 32 * wid + crow(r, hi); const float bs = pp->sgu_bs[(l * 4 + g) * 128 + pr];
            const size_t t = (size_t)(t0 + pr);
            const float u0 = bf2f(zc[t * 512 + g * 64 + c31]), u1 = bf2f(zc[t * 512 + g * 64 + 32 + c31]);
            Y[t * KP + 768 + g * 64 + c31] = f2bf(u0 * (a0[r] + bs)); Y[t * KP + 768 + g * 64 + 32 + c31] = f2bf(u1 * (a1[r] + bs)); }
        }
        __syncthreads();
      }
    }
  }
}

__device__ __forceinline__ bf16x8 pack8(const f32x16& pv, int base) {
  u32x4 w; w[0] = cvtpk(pv[base], pv[base + 1]); w[1] = cvtpk(pv[base + 2], pv[base + 3]); w[2] = cvtpk(pv[base + 4], pv[base + 5]); w[3] = cvtpk(pv[base + 6], pv[base + 7]);
  return *(bf16x8*)&w;
}
__device__ __forceinline__ bf16x8 ld_vfrag(const char* base) { return *(const bf16x8*)base; }
__device__ __forceinline__ int kperm(int r) { return (r & ~12) | ((r & 4) << 1) | ((r & 8) >> 1); }

constexpr int MLA_KS = 400, MLA_KBYTES = 64 * MLA_KS, VT_S = 144, MLA_VBYTES = 128 * VT_S, MLA_STAGE = MLA_KBYTES + MLA_VBYTES;
constexpr int DF_KS = 144, DF_KBYTES = 64 * DF_KS, DF_VBYTES = 64 * VT_S, DF_STAGE = DF_KBYTES + DF_VBYTES;

template <int NKS>
__device__ __forceinline__ f32x16 qk_tile(const char* krow, const bf16x8* qf, const f32x16& negm) {
  f32x16 p = __builtin_amdgcn_mfma_f32_32x32x16_bf16(*(const bf16x8*)krow, qf[0], negm, 0, 0, 0);
#pragma unroll
  for (int ks = 1; ks < NKS; ++ks) p = __builtin_amdgcn_mfma_f32_32x32x16_bf16(*(const bf16x8*)(krow + ks * 32), qf[ks], p, 0, 0, 0);
  return p;
}
template <int NOB>
__device__ __forceinline__ void sm_pv(f32x16& p, const char* vrow, f32x16& negm, float& m, f32x16& lacc, f32x16* oT, bool first, f32x16* pend) {
  float pm = p[0];
#pragma unroll
  for (int r = 1; r < 16; ++r) pm = fmaxf(pm, p[r]);
  if (first || !__all(pm <= 8.f)) {
    const float pmx = fmaxf(pm, __shfl_xor(pm, 32));
    const float d = first ? pmx : fmaxf(pmx, 0.f);
    if (!first) { const float alpha = fexp2(-d); lacc *= alpha;
#pragma unroll
      for (int nb = 0; nb < NOB; ++nb) oT[nb] *= alpha; }
    m += d;
#pragma unroll
    for (int r = 0; r < 16; ++r) { negm[r] = -m; p[r] -= d; }
    if (pend) {
#pragma unroll
      for (int r = 0; r < 16; ++r) (*pend)[r] -= d; }
  }
#pragma unroll
  for (int r = 0; r < 16; ++r) p[r] = fexp2(p[r]);
  const bf16x8 pb0 = pack8(p, 0), pb1 = pack8(p, 8);
  const bf16x8 ones = {0x3F80, 0x3F80, 0x3F80, 0x3F80, 0x3F80, 0x3F80, 0x3F80, 0x3F80};
  lacc = __builtin_amdgcn_mfma_f32_32x32x16_bf16(ones, pb0, lacc, 0, 0, 0);
  lacc = __builtin_amdgcn_mfma_f32_32x32x16_bf16(ones, pb1, lacc, 0, 0, 0);
#pragma unroll
  for (int nb = 0; nb < NOB; ++nb) {
    oT[nb] = __builtin_amdgcn_mfma_f32_32x32x16_bf16(ld_vfrag(vrow + nb * 32 * VT_S), pb0, oT[nb], 0, 0, 0);
    oT[nb] = __builtin_amdgcn_mfma_f32_32x32x16_bf16(ld_vfrag(vrow + nb * 32 * VT_S + 32), pb1, oT[nb], 0, 0, 0);
  }
}

template <int NOB, int VS = VT_S>
__device__ __forceinline__ void sm_pv_sv(f32x16& p, const char* vrow, f32x16& negm, float& m, float& l, f32x16* oT, bool first) {
  float pm = p[0];
#pragma unroll
  for (int r = 1; r < 16; ++r) pm = fmaxf(pm, p[r]);
  if (first || !__all(pm <= 8.f)) {
    const float pmx = fmaxf(pm, __shfl_xor(pm, 32));
    const float d = first ? pmx : fmaxf(pmx, 0.f);
    if (!first) { const float alpha = fexp2(-d); l *= alpha;
#pragma unroll
      for (int nb = 0; nb < NOB; ++nb) oT[nb] *= alpha; }
    m += d;
#pragma unroll
    for (int r = 0; r < 16; ++r) { negm[r] = -m; p[r] -= d; }
  }
  float ps = 0.f;
#pragma unroll
  for (int r = 0; r < 16; ++r) { p[r] = fexp2(p[r]); ps += p[r]; }
  l += ps;
  const bf16x8 pb0 = pack8(p, 0), pb1 = pack8(p, 8);
#pragma unroll
  for (int nb = 0; nb < NOB; ++nb) {
    oT[nb] = __builtin_amdgcn_mfma_f32_32x32x16_bf16(ld_vfrag(vrow + nb * 32 * VS), pb0, oT[nb], 0, 0, 0);
    oT[nb] = __builtin_amdgcn_mfma_f32_32x32x16_bf16(ld_vfrag(vrow + nb * 32 * VS + 32), pb1, oT[nb], 0, 0, 0);
  }
}

template <int NOB>
__device__ __forceinline__ void sm_pv_valu(f32x16& p, const char* vrow, float& m, float& l, f32x16* oT, bool first) {
  float pm = p[0];
#pragma unroll
  for (int r = 1; r < 16; ++r) pm = fmaxf(pm, p[r]);
  if (first || !__all(pm <= m + 8.f)) {
    const float pmx = fmaxf(pm, __shfl_xor(pm, 32));
    const float mn = first ? pmx : fmaxf(m, pmx);
    if (!first) { const float alpha = fexp2(m - mn); l *= alpha;
#pragma unroll
      for (int nb = 0; nb < NOB; ++nb) oT[nb] *= alpha; }
    m = mn;
  }
  float ps = 0.f;
#pragma unroll
  for (int r = 0; r < 16; ++r) { p[r] = fexp2(p[r] - m); ps += p[r]; }
  l += ps;
  const bf16x8 pb0 = pack8(p, 0), pb1 = pack8(p, 8);
#pragma unroll
  for (int nb = 0; nb < NOB; ++nb) {
    oT[nb] = __builtin_amdgcn_mfma_f32_32x32x16_bf16(ld_vfrag(vrow + nb * 32 * VT_S), pb0, oT[nb], 0, 0, 0);
    oT[nb] = __builtin_amdgcn_mfma_f32_32x32x16_bf16(ld_vfrag(vrow + nb * 32 * VT_S + 32), pb1, oT[nb], 0, 0, 0);
  }
}

__device__ __forceinline__ void attn_mla_item(PP pp, int b, int h, int tq0, int NT, char* lds) {
  const bf16_t* Qm = (const bf16_t*)(pp->ws + OFF_QM); const bf16_t* Km = (const bf16_t*)(pp->ws + OFF_KM); const bf16_t* Kr = (const bf16_t*)(pp->ws + OFF_KR);
  const bf16_t* VmT = (const bf16_t*)(pp->ws + OFF_VMT) + (size_t)(b * 4 + h) * 128 * SB; bf16_t* Y = (bf16_t*)(pp->ws + OFF_Y);
  const int tid = get_tid(), lane = tid & 63, wid = tid >> 6, c31 = lane & 31, hi = lane >> 5;
  const int tk0 = b * SB;
  bf16x8 qf[12];
  { const bf16_t* qp = Qm + (size_t)(tq0 + 32 * wid + c31) * 768 + h * 192 + hi * 8;
#pragma unroll
    for (int ks = 0; ks < 12; ++ks) qf[ks] = *(const bf16x8*)(qp + ks * 16); }
  f32x16 oT[4];
#pragma unroll
  for (int nb = 0; nb < 4; ++nb)
#pragma unroll
    for (int r = 0; r < 16; ++r) oT[nb][r] = 0.f;
  float m = 0.f, l = 0.f; f32x16 negm;
#pragma unroll
  for (int r = 0; r < 16; ++r) negm[r] = 0.f;
  u32x4 rk0, rk1, rk2, rv0, rv1;
  int kkey[3], kc[3];
#pragma unroll
  for (int i = 0; i < 3; ++i) { const int id = tid + 512 * i; kkey[i] = id / 24; kc[i] = id % 24; }
  const int vdv0 = tid >> 3, vkc = tid & 7;
#define A_KSRC(i, key0) (kc[i] < 16 ? Km + (size_t)(tk0 + (key0) + kkey[i]) * 512 + h * 128 + kc[i] * 8 : Kr + (size_t)(tk0 + (key0) + kkey[i]) * 64 + (kc[i] - 16) * 8)
#define A_LOAD(key0) do { rk0 = *(const u32x4*)A_KSRC(0, key0); rk1 = *(const u32x4*)A_KSRC(1, key0); rk2 = *(const u32x4*)A_KSRC(2, key0); \
    rv0 = *(const u32x4*)(VmT + (size_t)vdv0 * SB + (key0) + vkc * 8); rv1 = *(const u32x4*)(VmT + (size_t)(vdv0 + 64) * SB + (key0) + vkc * 8); } while (0)
#define A_STORE(s) do { char* kb_ = lds + (s) * MLA_STAGE; char* vb_ = kb_ + MLA_KBYTES; \
    *(u32x4*)(kb_ + kkey[0] * MLA_KS + kc[0] * 16) = rk0; *(u32x4*)(kb_ + kkey[1] * MLA_KS + kc[1] * 16) = rk1; *(u32x4*)(kb_ + kkey[2] * MLA_KS + kc[2] * 16) = rk2; \
    { char* d_ = vb_ + vdv0 * VT_S + vkc * 16; *(u32x4*)d_ = rv0; *(u32x4*)(d_ + 64 * VT_S) = rv1; } } while (0)
  A_LOAD(0); A_STORE(0); __syncthreads();
  for (int t = 0; t < NT; ++t) {
    const int s = t & 1;
    if (t + 1 < NT) A_LOAD((t + 1) * 64);
    const char* kb = lds + s * MLA_STAGE; const char* vb = kb + MLA_KBYTES;
    const char* ka = kb + kperm(c31) * MLA_KS + hi * 16; const char* va = vb + c31 * VT_S + hi * 16;
    f32x16 pa = qk_tile<12>(ka, qf, negm);
    sm_pv_sv<4>(pa, va, negm, m, l, oT, t == 0);
    f32x16 pbb = qk_tile<12>(ka + 32 * MLA_KS, qf, negm);
    sm_pv_sv<4>(pbb, va + 64, negm, m, l, oT, false);
    if (t + 1 < NT) A_STORE(s ^ 1);
    __syncthreads();
  }
#undef A_KSRC
#undef A_LOAD
#undef A_STORE
  l += __shfl_xor(l, 32);
  const float il = 1.f / l;
  bf16_t* yp = Y + (size_t)(tq0 + 32 * wid + c31) * KP + h * 128;
#pragma unroll
  for (int nb = 0; nb < 4; ++nb)
#pragma unroll
    for (int i4 = 0; i4 < 4; ++i4) { u32x2 w; w[0] = cvtpk(oT[nb][4 * i4] * il, oT[nb][4 * i4 + 1] * il); w[1] = cvtpk(oT[nb][4 * i4 + 2] * il, oT[nb][4 * i4 + 3] * il);
      *(u32x2*)(yp + 32 * nb + 8 * i4 + 4 * hi) = w; }
}

__device__ __forceinline__ void attn_diff_item(PP pp, int l, int b, int h, int tq0, int NT, float lam, float lam_init, char* lds) {
  const bf16_t* Qd = (const bf16_t*)(pp->ws + OFF_QD); const bf16_t* Kd = (const bf16_t*)(pp->ws + OFF_KD);
  const bf16_t* VdT = (const bf16_t*)(pp->ws + OFF_VDT) + (size_t)(b * 4 + h) * 64 * SB; bf16_t* Y = (bf16_t*)(pp->ws + OFF_Y);
  const int tid = get_tid(), lane = tid & 63, wid = tid >> 6, c31 = lane & 31, hi = lane >> 5;
  const int tk0 = b * SB;
  bf16x8 qf[2][2];
  { const bf16_t* qp = Qd + (size_t)(tq0 + 32 * wid + c31) * 256 + h * 64 + hi * 8;
#pragma unroll
    for (int mp = 0; mp < 2; ++mp)
#pragma unroll
      for (int ks = 0; ks < 2; ++ks) qf[mp][ks] = *(const bf16x8*)(qp + mp * 32 + ks * 16); }
  f32x16 oA[2], oB[2];
#pragma unroll
  for (int nb = 0; nb < 2; ++nb)
#pragma unroll
    for (int r = 0; r < 16; ++r) { oA[nb][r] = 0.f; oB[nb][r] = 0.f; }
  float mA = 0.f, mB = 0.f, lA = 0.f, lB = 0.f; f32x16 negA, negB;
#pragma unroll
  for (int r = 0; r < 16; ++r) { negA[r] = 0.f; negB[r] = 0.f; }
  constexpr int DV2S = 272, D2K = 128 * DF_KS, D2STAGE = D2K + 64 * DV2S;
  u32x4 rk, rk2, rv, rv2;
  const int kkey = tid >> 3, kch = tid & 7;
#define D_LOAD(key0) do { const bf16_t* kp_ = Kd + (size_t)(tk0 + (key0) + kkey) * 256 + h * 64 + kch * 8; rk = *(const u32x4*)kp_; rk2 = *(const u32x4*)(kp_ + 64 * 256); \
    const bf16_t* vp_ = VdT + (size_t)kkey * SB + (key0) + kch * 8; rv = *(const u32x4*)vp_; rv2 = *(const u32x4*)(vp_ + 64); } while (0)
#define D_STORE(s) do { char* kb_ = lds + (s) * D2STAGE; char* vb_ = kb_ + D2K; *(u32x4*)(kb_ + kkey * DF_KS + kch * 16) = rk; *(u32x4*)(kb_ + (kkey + 64) * DF_KS + kch * 16) = rk2; \
    *(u32x4*)(vb_ + kkey * DV2S + kch * 16) = rv; *(u32x4*)(vb_ + kkey * DV2S + 128 + kch * 16) = rv2; } while (0)
  const int NT2 = NT >> 1;
  D_LOAD(0); D_STORE(0); __syncthreads();
  for (int t = 0; t < NT2; ++t) {
    const int s = t & 1;
    if (t + 1 < NT2) D_LOAD((t + 1) * 128);
    const char* kb = lds + s * D2STAGE; const char* vb = kb + D2K;
#pragma unroll
    for (int sub = 0; sub < 2; ++sub) {
      const char* ka = kb + (kperm(c31) + 64 * sub) * DF_KS + hi * 16; const char* va = vb + c31 * DV2S + hi * 16 + 128 * sub;
      const bool f0 = (t == 0) && (sub == 0);
      f32x16 pA0 = qk_tile<2>(ka, qf[0], negA);
      f32x16 pB0 = qk_tile<2>(ka + 64, qf[1], negB);
      sm_pv_sv<2, DV2S>(pA0, va, negA, mA, lA, oA, f0);
      f32x16 pA1 = qk_tile<2>(ka + 32 * DF_KS, qf[0], negA);
      sm_pv_sv<2, DV2S>(pB0, va, negB, mB, lB, oB, f0);
      f32x16 pB1 = qk_tile<2>(ka + 32 * DF_KS + 64, qf[1], negB);
      sm_pv_sv<2, DV2S>(pA1, va + 64, negA, mA, lA, oA, false);
      sm_pv_sv<2, DV2S>(pB1, va + 64, negB, mB, lB, oB, false);
    }
    if (t + 1 < NT2) D_STORE(s ^ 1);
    __syncthreads();
  }
#undef D_LOAD
#undef D_STORE
  lA += __shfl_xor(lA, 32); lB += __shfl_xor(lB, 32);
  const float ia = 1.f / lA, ib = lam / lB;
  float ss = 0.f;
#pragma unroll
  for (int nb = 0; nb < 2; ++nb)
#pragma unroll
    for (int r = 0; r < 16; ++r) { const float d = oA[nb][r] * ia - oB[nb][r] * ib; oA[nb][r] = d; ss += d * d; }
  ss += __shfl_xor(ss, 32);
  const float rs = rsqrtf(ss * (1.f / 64.f) + EPS) * (1.f - lam_init);
  const float* g = pp->subln_g + l * 64;
  bf16_t* yp = Y + (size_t)(tq0 + 32 * wid + c31) * KP + 512 + h * 64;
#pragma unroll
  for (int nb = 0; nb < 2; ++nb)
#pragma unroll
    for (int i4 = 0; i4 < 4; ++i4) { const int dv = 32 * nb + 8 * i4 + 4 * hi; const f32x4 gg = *(const f32x4*)(g + dv);
      u32x2 w; w[0] = cvtpk(oA[nb][4 * i4] * rs * gg[0], oA[nb][4 * i4 + 1] * rs * gg[1]); w[1] = cvtpk(oA[nb][4 * i4 + 2] * rs * gg[2], oA[nb][4 * i4 + 3] * rs * gg[3]);
      *(u32x2*)(yp + dv) = w; }
}

__device__ __forceinline__ void phase_attn(PP pp, int l, bool need_ctx, char* lds) {
  const int n_items = 256 + (need_ctx ? 8 : 0);
  for (int it = get_bid(); it < n_items; it += gridDim.x) {
    const int bh = it & 7, b = bh >> 2, h = bh & 3; const bool lat = it < 256;
    attn_mla_item(pp, b, h, lat ? b * SB + CTX + (it >> 3) * 256 : b * SB, lat ? SB / 64 : CTX / 64, lds);
  }
  float d1 = 0.f, d2 = 0.f;
#pragma unroll 1
  for (int i = 0; i < 32; ++i) { d1 += pp->lq1[l * 32 + i] * pp->lk1[l * 32 + i]; d2 += pp->lq2[l * 32 + i] * pp->lk2[l * 32 + i]; }
  const float lam_init = 0.8f - 0.6f * __expf(-0.3f * (float)l);
  const float lam = __expf(d1) - __expf(d2) + lam_init;
  for (int it = get_bid(); it < n_items + 8; it += gridDim.x) {
    if (it >= 256 && it < 264) continue;
    const int bh = it & 7, b = bh >> 2, h = bh & 3; const bool lat = it < 256;
    attn_diff_item(pp, l, b, h, lat ? b * SB + CTX + (it >> 3) * 256 : b * SB, lat ? SB / 64 : CTX / 64, lam, lam_init, lds);
  }
}

__device__ __forceinline__ void phase_res_gemm(PP pp, int l, const bf16_t* A, int K, int ld, const bf16_t* Bt, int gchunk, bool skip_ctx, char* lds) {
  const float* mod = (const float*)(pp->ws + OFF_MOD) + (size_t)l * 3 * 6144;
  const int tid = get_tid(), lane = tid & 63, c31 = lane & 31, hi = lane >> 5;
  float* ut = (float*)lds;
  for (int it0 = get_bid(); it0 < 64 * 4; it0 += gridDim.x) {
    const int it = gridDim.x == 256 ? (((it0 & 7) * 8 + (it0 >> 5)) << 2) + ((it0 >> 3) & 3) : it0;
    const int mi = it >> 2, nt2 = it & 3, mt = (mi >> 5) * 33 + 1 + (mi & 31), row0 = mt * 256, b = mt / 33;
    const float* gv = mod + (size_t)b * 6144 + gchunk * 1024;
    auto post = [&](int h) {
      const int cc = tid & 15, col = nt2 * 256 + h * 128 + cc * 8;
      const f32x4 g0 = *(const f32x4*)(gv + col), g1 = *(const f32x4*)(gv + col + 4);
#pragma unroll 2
      for (int i = 0; i < 8; ++i) {
        const int row = (tid >> 4) + 32 * i; const float* up = ut + row * 128 + cc * 8;
        float* xp = xrow(pp, row0 + row) + col;
        const f32x4 ua = *(const f32x4*)up, ub = *(const f32x4*)(up + 4);
        f32x4 xa = *(const f32x4*)xp, xb = *(const f32x4*)(xp + 4);
        xa = xa * DN_ALPHA + g0 * ua; xb = xb * DN_ALPHA + g1 * ub;
        *(f32x4*)xp = xa; *(f32x4*)(xp + 4) = xb;
      }
    };
    gemm_tile256b(A, ld, RowId{row0}, Bt, ld, nt2 * 256, K, lds, post);
  }
  if (!skip_ctx) {
    const float* gv = mod + (size_t)2 * 6144 + gchunk * 1024;
    const int Kc = K >> 2;
    for (int it = get_bid(); it < 64; it += gridDim.x) {
      const int sp = it & 3, nt = (it >> 2) & 7, row0 = (it >> 5) * 33 * 256;
      auto epi = [&](f32x16 (&acc)[2][2], int rbase, int cbase) {
#pragma unroll
        for (int mb = 0; mb < 2; ++mb)
#pragma unroll
          for (int nb = 0; nb < 2; ++nb) { const int col = cbase + 32 * nb + c31; const float g = gv[col];
#pragma unroll
            for (int r = 0; r < 16; ++r) atomicAdd(xrow(pp, row0 + rbase + 32 * mb + crow(r, hi)) + col, g * acc[mb][nb][r]); }
      };
      gemm_tile(A + sp * Kc, ld, RowId{row0}, Bt + sp * Kc, ld, nt * 128, Kc, lds, epi);
    }
  }
}

__device__ __forceinline__ void phase_ffn_up(PP pp, int l, char* lds) {
  const bf16_t* A = (const bf16_t*)(pp->ws + OFF_HMOD);
  const bf16_t* Bt = (const bf16_t*)(pp->ws + OFF_W) + (size_t)l * W_LAYER + W_UP;
  bf16_t* A2 = (bf16_t*)(pp->ws + OFF_A2);
  const float* cw = pp->ffn_convw + (size_t)l * 3 * 5632; const float* cb = pp->ffn_convb + (size_t)l * 5632;
  const int tid = get_tid(), lane = tid & 63, c31 = lane & 31, hi = lane >> 5;
  float* ut = (float*)lds;
  const bool xmap = gridDim.x == 256; const int xq = get_bid() & 7, xj = get_bid() >> 3;
  const int n_it = xmap ? 6 * 32 : 67 * 22;
  for (int it = xmap ? xj : get_bid(); it < n_it; it += xmap ? 32 : gridDim.x) {
    int mt, nt2;
    if (xmap) { mt = 4 * (it / 11) + (xq >> 1); nt2 = 11 * (xq & 1) + it % 11; if (mt >= 67) continue; }
    else { mt = it / 22; nt2 = it % 22; }
    const int o0 = mt * 254;
    auto post = [&](int h) {
      const int nt = 2 * nt2 + h;
    {
      const int fp = tid & 31, rg = tid >> 5, f = nt * 64 + 2 * fp;
      const int cg = (fp >> 4) * 64 + ((2 * fp) & 31), cv = cg + 32;
      const f32x2 wg0 = *(const f32x2*)(cw + f), wg1 = *(const f32x2*)(cw + 5632 + f), wg2 = *(const f32x2*)(cw + 2 * 5632 + f), bg = *(const f32x2*)(cb + f);
      const f32x2 wv0 = *(const f32x2*)(cw + DFF + f), wv1 = *(const f32x2*)(cw + 5632 + DFF + f), wv2 = *(const f32x2*)(cw + 2 * 5632 + DFF + f), bv = *(const f32x2*)(cb + DFF + f);
      int i0 = rg * 16; int i1 = i0 + 16; if (i0 < 1) i0 = 1; if (i1 > 255) i1 = 255;
      if (i1 > T - (o0 - 1)) i1 = T - (o0 - 1);
      f32x2 gp = *(const f32x2*)(ut + (i0 - 1) * 128 + cg), gc = *(const f32x2*)(ut + i0 * 128 + cg);
      f32x2 vp = *(const f32x2*)(ut + (i0 - 1) * 128 + cv), vc = *(const f32x2*)(ut + i0 * 128 + cv);
      int t = o0 - 1 + i0; int j = t % SB;
      bf16_t* dst = A2 + (size_t)t * DFF + f;
      for (int i = i0; i < i1; ++i) {
        const f32x2 gn = *(const f32x2*)(ut + (i + 1) * 128 + cg), vn = *(const f32x2*)(ut + (i + 1) * 128 + cv);
        f32x2 gate = wg1 * gc + bg, val = wv1 * vc + bv;
        if (j != 0 && j != CTX) { gate += wg0 * gp; val += wv0 * vp; }
        if (j != CTX - 1 && j != SB - 1) { gate += wg2 * gn; val += wv2 * vn; }
        *(unsigned*)dst = cvtpk(silu_f(gate[0]) * val[0], silu_f(gate[1]) * val[1]);
        dst += DFF; j = (j == SB - 1) ? 0 : j + 1;
        gp = gc; gc = gn; vp = vc; vc = vn;
      }
    }
    };
    gemm_tile256b(A, KP, RowHalo{o0 - 1}, Bt, KP, nt2 * 256, DM, lds, post);
  }
}


#define XB_TMO      128
#define XB_XCNT(j)  (256  + 64 * (j))
#define XB_XSUB(j)  (1280 + 64 * (j))
#define XB_XGEN(j)  (2304 + 64 * (j))
#define XB_TOP      3328
#define XB_TOPGEN   3392
#define XCD_BAR_WORDS 3456
#define XB_SPIN_CAP (1u << 18)
#define LAS __attribute__((address_space(3)))

__device__ __forceinline__ unsigned xb_ld(unsigned* p)              { return __hip_atomic_load(p, __ATOMIC_RELAXED, __HIP_MEMORY_SCOPE_AGENT); }
__device__ __forceinline__ unsigned xb_add(unsigned* p, unsigned v) { return __hip_atomic_fetch_add(p, v, __ATOMIC_RELAXED, __HIP_MEMORY_SCOPE_AGENT); }
__device__ __forceinline__ unsigned xb_xcc_id() { return (unsigned)__builtin_amdgcn_s_getreg((3 << 11) | 20) & 0xFu; }
#define XB_SPIN(cond, bar) do { unsigned _sp = 0; while (cond) { __builtin_amdgcn_s_sleep(1); \
    if ((++_sp & 255u) == 0u) { if (xb_ld(&(bar)[XB_TMO])) break; if (_sp > XB_SPIN_CAP) { atomicAdd(&(bar)[XB_TMO], 1u); break; } } } } while (0)

struct XcdBarrier {
    unsigned* bar; unsigned x;
    volatile LAS unsigned* st;
};

__device__ __forceinline__ XcdBarrier xcd_barrier_post(unsigned* bar, volatile LAS unsigned* st) {
    XcdBarrier b; b.bar = bar; b.x = xb_xcc_id(); b.st = st;
    if (get_tid() == 0) (void)xb_add(&bar[XB_XCNT(b.x)], 1u);
    return b;
}
__device__ __forceinline__ void xcd_barrier_complete(unsigned* bar, unsigned x, unsigned& nloc, unsigned& nx) {
    const unsigned G = gridDim.x * gridDim.y * gridDim.z;
    unsigned sum, cnt, mine, sp = 0u;
    for (;;) {
        sum = 0u; cnt = 0u; mine = 0u;
#pragma unroll
        for (unsigned j = 0; j < 16; ++j) { const unsigned c = xb_ld(&bar[XB_XCNT(j)]); sum += c; cnt += (c > 0u) ? 1u : 0u; mine = (j == x) ? c : mine; }
        if (sum == G) break;
        __builtin_amdgcn_s_sleep(1);
        if ((++sp & 255u) == 0u) { if (xb_ld(&bar[XB_TMO])) break; if (sp > XB_SPIN_CAP) { atomicAdd(&bar[XB_TMO], 1u); break; } }
    }
    nloc = mine > 0u ? mine : 1u; nx = cnt > 0u ? cnt : 1u;
}

__device__ __forceinline__ void xcd_barrier(const XcdBarrier& b) {
    asm volatile("s_waitcnt vmcnt(0)" ::: "memory");
    __syncthreads();
    if (get_tid() == 0) {
        unsigned* bar = b.bar;
        __builtin_amdgcn_s_waitcnt(0);
        unsigned nloc = b.st[0], nx = b.st[1];
        if (nloc == 0u) { xcd_barrier_complete(bar, b.x, nloc, nx); b.st[0] = nloc; b.st[1] = nx; }
        const unsigned old = xb_add(&bar[XB_XSUB(b.x)], 1u);
        const unsigned gen = old / nloc;
        if (old + 1u == (gen + 1u) * nloc) {
            __builtin_amdgcn_fence(__ATOMIC_RELEASE, "agent");
            asm volatile("s_waitcnt vmcnt(0)" ::: "memory");
            const unsigned og = xb_add(&bar[XB_TOP], 1u);
            const unsigned tg = og / nx;
            if (og + 1u == (tg + 1u) * nx) xb_add(&bar[XB_TOPGEN], 1u);
            else XB_SPIN(xb_ld(&bar[XB_TOPGEN]) == tg, bar);
            __builtin_amdgcn_fence(__ATOMIC_ACQUIRE, "agent");
            xb_add(&bar[XB_XGEN(b.x)], 1u);
            asm volatile("s_waitcnt vmcnt(0)" ::: "memory");
        } else {
            XB_SPIN(xb_ld(&bar[XB_XGEN(b.x)]) == gen, bar);
            __builtin_amdgcn_fence(__ATOMIC_ACQUIRE, "agent");
            asm volatile("s_waitcnt vmcnt(0)" ::: "memory");
        }
    }
    __syncthreads();
}

constexpr size_t OFF_BAR = OFF_END;
constexpr int LDS_XB = 3 * 49152 + 1024;
__device__ __forceinline__ void grid_bar(PP pp, char* lds) {
  XcdBarrier b; b.bar = (unsigned*)(pp->ws + OFF_BAR); b.x = xb_xcc_id(); b.st = (volatile LAS unsigned*)(lds + LDS_XB);
  xcd_barrier(b);
}
__global__ void __launch_bounds__(512) fwd_megakernel(Params p_arg) {
  extern __shared__ __attribute__((aligned(16))) char lds[];
  cg::grid_group grid = cg::this_grid();
  PP pp = (PP)__builtin_amdgcn_kernarg_segment_ptr();
  { const int t0_ = get_tid(); if (t0_ < 4) ((volatile LAS unsigned*)(lds + LDS_XB))[t0_] = 0u; }
  __syncthreads();
  (void)xcd_barrier_post((unsigned*)(pp->ws + OFF_BAR), (volatile LAS unsigned*)(lds + LDS_XB));
  grid.sync();
  phase0(launder(pp), lds);
  grid_bar(launder(pp), lds);
  row_pass(launder(pp), 0, nullptr, nullptr, 0, 0, 1, true, false, NLAYER > 1);
  grid_bar(launder(pp), lds);
#pragma unroll 1
  for (int l = 0; l < NLAYER; ++l) {
    const bool last = (l == NLAYER - 1);
    const bf16_t* wl = (const bf16_t*)(pp->ws + OFF_W) + (size_t)l * W_LAYER;
    phase_win(launder(pp), l, lds);
    grid_bar(launder(pp), lds);
    phase_up2(launder(pp), l, lds);
    grid_bar(launder(pp), lds);
    phase_attn(launder(pp), l, !last, lds);
    grid_bar(launder(pp), lds);
    phase_res_gemm(launder(pp), l, (const bf16_t*)(pp->ws + OFF_Y), 1024, KP, wl + W_O, 2, last, lds);
    grid_bar(launder(pp), lds);
    row_pass(launder(pp), 1, pp->ln1_g + l * DM, pp->ln1_b + l * DM, l, 3, 4, true, last, !last);
    grid_bar(launder(pp), lds);
    phase_ffn_up(launder(pp), l, lds);
    grid_bar(launder(pp), lds);
    phase_res_gemm(launder(pp), l, (const bf16_t*)(pp->ws + OFF_A2), DFF, DFF, wl + W_DN, 5, last, lds);
    grid_bar(launder(pp), lds);
    row_pass(launder(pp), 1, pp->ln2_g + l * DM, pp->ln2_b + l * DM, l + 1, 0, 1, !last, last, l + 2 < NLAYER);
    if (!last) grid_bar(launder(pp), lds);
  }
}

extern "C" void kernel_launch(void* const* d_in, const int* in_sizes, int n_in, void* d_out, int out_size, void* d_ws, size_t ws_size, hipStream_t stream) {
  static int grid_blocks = 0;
  if (!grid_blocks) {
    int dev = 0, cus = 0, per_cu = 0;
    hipGetDevice(&dev);
    hipDeviceGetAttribute(&cus, hipDeviceAttributeMultiprocessorCount, dev);
    hipFuncSetAttribute((const void*)fwd_megakernel, hipFuncAttributeMaxDynamicSharedMemorySize, LDS_BYTES);
    hipOccupancyMaxActiveBlocksPerMultiprocessor(&per_cu, fwd_megakernel, 512, LDS_BYTES);
    if (per_cu < 1) { fprintf(stderr, "occupancy query returned %d\n", per_cu); per_cu = 1; }
    if (per_cu > 1) per_cu = 1;
    grid_blocks = cus * per_cu;
  }
  Params p{};
  const float** f = (const float**)&p;
  for (int i = 0; i < 29; ++i) f[i] = (const float*)d_in[i];
  p.out = (float*)d_out; p.ws = (char*)d_ws;
  (void)hipMemsetAsync((char*)d_ws + OFF_BAR, 0, XCD_BAR_WORDS * sizeof(unsigned), stream);
  void* args[] = {&p};
  hipError_t e = hipLaunchCooperativeKernel((void*)fwd_megakernel, dim3(grid_blocks), dim3(512), args, LDS_BYTES, stream);
  if (e != hipSuccess) fprintf(stderr, "cooperative launch failed: %s (grid %d)\n", hipGetErrorString(e), grid_blocks);
}
```

```cpp
#include <hip/hip_runtime.h>
#include <hip/hip_cooperative_groups.h>
#include <stdint.h>
#include <cstdio>
namespace cg = cooperative_groups;

typedef unsigned short bf16_t;
typedef short bf16x8 __attribute__((ext_vector_type(8)));
typedef float f32x16 __attribute__((ext_vector_type(16)));
typedef float f32x4 __attribute__((ext_vector_type(4)));
typedef float f32x2 __attribute__((ext_vector_type(2)));
typedef unsigned u32x4 __attribute__((ext_vector_type(4)));
typedef unsigned u32x2 __attribute__((ext_vector_type(2)));

constexpr int DM = 1024, NBATCH = 2, SEQ = 8192, CTX = 256, SB = SEQ + CTX  , T = NBATCH * SB  ;
constexpr int INW = 1984, DFF = 2816, NLAYER = 2;
constexpr int KP = 1088;
constexpr float EPS = 1e-6f;
constexpr float DN_ALPHA = 1.4142135623730951f;
constexpr float LOG2E = 1.4426950408889634f;
constexpr float QS_MLA = 0.07216878364870322f * LOG2E;
constexpr float QS_DIFF = 0.17677669529663687f * LOG2E;

constexpr size_t al256(size_t x) { return (x + 255) / 256 * 256; }
constexpr size_t W_IN = 0;
constexpr size_t W_UQ = W_IN + 2048ull * KP;
constexpr size_t W_UKV = W_UQ + 768ull * 384;
constexpr size_t W_O = W_UKV + 1024ull * 256;
constexpr size_t W_UP = W_O + 1024ull * KP;
constexpr size_t W_DN = W_UP + 5632ull * KP;
constexpr size_t W_SG = W_DN + 1024ull * 2816;
constexpr size_t W_LAYER = W_SG + 4ull * 128 * 128;
constexpr size_t OFF_W = 0;
constexpr size_t OFF_MOD = al256(OFF_W + W_LAYER * 2 * NLAYER);
constexpr size_t OFF_CS16 = al256(OFF_MOD + 2ull * 3 * 6144 * 4);
constexpr size_t OFF_CS8 = al256(OFF_CS16 + 128ull * 16 * 8);
constexpr size_t OFF_CTXRES = al256(OFF_CS8 + 128ull * 8 * 8);
constexpr size_t OFF_HMOD = al256(OFF_CTXRES + 512ull * 1024 * 4);
constexpr size_t OFF_R = al256(OFF_HMOD + (size_t)T * KP * 2);
constexpr size_t OFF_ZQ = OFF_R;
constexpr size_t OFF_KR = al256(OFF_ZQ + (size_t)T * 640 * 2);
constexpr size_t OFF_QD = al256(OFF_KR + (size_t)T * 64 * 2);
constexpr size_t OFF_KD = al256(OFF_QD + (size_t)T * 256 * 2);
constexpr size_t OFF_VDT = al256(OFF_KD + (size_t)T * 256 * 2);
constexpr size_t OFF_ZC = al256(OFF_VDT + (size_t)T * 256 * 2);
constexpr size_t OFF_QM = al256(OFF_ZC + (size_t)T * 512 * 2);
constexpr size_t OFF_KM = al256(OFF_QM + (size_t)T * 768 * 2);
constexpr size_t OFF_VMT = al256(OFF_KM + (size_t)T * 512 * 2);
constexpr size_t OFF_Y = al256(OFF_VMT + (size_t)T * 512 * 2);
constexpr size_t OFF_END = al256(OFF_Y + (size_t)T * KP * 2);
constexpr size_t OFF_A2 = OFF_R;
static_assert(OFF_A2 + (size_t)T * 2816 * 2 <= OFF_END, "A2 alias fits");
constexpr size_t OFF_SSQ = OFF_END + 16384;
static_assert(OFF_SSQ + (size_t)T * 8 <= 268435456ull, "workspace fits 256 MiB");

constexpr int LDS_A_STAGE = 256 * 144, LDS_B_STAGE = 128 * 144;
constexpr int LDS_GEMM = 2 * (LDS_A_STAGE + LDS_B_STAGE);
constexpr int LDS_RSTD = 3 * 49152;
constexpr int LDS_BYTES = 3 * 49152 + 1024 + 16;

struct Params {
  const float *x, *c, *ctx, *c_ctx, *ada_w, *ada_b, *w_in, *mla_gq, *mla_wuq, *mla_gkv, *mla_wukv;
  const float *lq1, *lk1, *lq2, *lk2, *subln_g, *sgu_ln_g, *sgu_ln_b, *sgu_ws, *sgu_bs, *w_o, *ln1_g, *ln1_b;
  const float *ffn_wup, *ffn_convw, *ffn_convb, *ffn_wdown, *ln2_g, *ln2_b;
  float* out; char* ws;
};
typedef const __attribute__((address_space(4))) Params* PP;
__device__ __forceinline__ PP launder(PP q) { asm volatile("" : "+s"(q)); return q; }

__device__ __forceinline__ int get_tid() { int t = threadIdx.x; asm volatile("" : "+v"(t)); return t; }
__device__ __forceinline__ int get_bid() { int t = blockIdx.x; asm volatile("" : "+s"(t)); return t; }
typedef __bf16 bf16x2_t __attribute__((ext_vector_type(2)));
__device__ __forceinline__ unsigned cvtpk(float lo, float hi) { f32x2 v = {lo, hi}; bf16x2_t b = __builtin_convertvector(v, bf16x2_t); return __builtin_bit_cast(unsigned, b); }
__device__ __forceinline__ bf16_t f2bf(float x) { return (bf16_t)(cvtpk(x, 0.f) & 0xffffu); }
__device__ __forceinline__ float bf2f(bf16_t v) { return __uint_as_float(((unsigned)v) << 16); }
__device__ __forceinline__ float bflo(unsigned w) { return __uint_as_float(w << 16); }
__device__ __forceinline__ float bfhi(unsigned w) { return __uint_as_float(w & 0xffff0000u); }
__device__ __forceinline__ int crow(int r, int hi) { return (r & 3) + 8 * (r >> 2) + 4 * hi; }
__device__ __forceinline__ float fexp2(float x) { return __builtin_amdgcn_exp2f(x); }
__device__ __forceinline__ float silu_f(float x) { return x * __builtin_amdgcn_rcpf(1.f + __expf(-x)); }
__device__ __forceinline__ float gelu_tanh(float x) {
  const float u = 0.7978845608028654f * (x + 0.044715f * x * x * x);
  return x * __builtin_amdgcn_rcpf(1.f + __expf(-2.f * u));
}
__device__ __forceinline__ float* xrow(PP pp, int t) {
  const int b = t / SB, j = t - b * SB;
  return j < CTX ? (float*)(pp->ws + OFF_CTXRES) + (size_t)(b * CTX + j) * DM : pp->out + (size_t)(b * SEQ + j - CTX) * DM;
}

constexpr int G_STAGE = 256 * 128 + 128 * 128;
template <class RowMap, class Epi>
__device__ __forceinline__ void gemm_tile(const bf16_t* __restrict__ A, int lda, RowMap rowmap, const bf16_t* __restrict__ Bt, int ldb, int col0, int K,
                                          char* lds, Epi epi) {
  const int tid = get_tid(), lane = tid & 63, wid = tid >> 6, wm = wid >> 1, wn = wid & 1, l31 = lane & 31, hi = lane >> 5;
  const int lr = tid >> 3, lc = tid & 7, kc = lc ^ ((lr >> 1) & 7);
  const bf16_t* ap0 = A + (size_t)rowmap(lr) * lda + kc * 8;
  const bf16_t* ap1 = A + (size_t)rowmap(lr + 64) * lda + kc * 8;
  const bf16_t* ap2 = A + (size_t)rowmap(lr + 128) * lda + kc * 8;
  const bf16_t* ap3 = A + (size_t)rowmap(lr + 192) * lda + kc * 8;
  const bf16_t* bp0 = Bt + (size_t)(col0 + lr) * ldb + kc * 8;
  const bf16_t* bp1 = Bt + (size_t)(col0 + lr + 64) * ldb + kc * 8;
  f32x16 acc[2][2];
#pragma unroll
  for (int i = 0; i < 2; ++i)
#pragma unroll
    for (int j = 0; j < 2; ++j)
#pragma unroll
      for (int r = 0; r < 16; ++r) acc[i][j][r] = 0.f;
#define G_DMA(gp, lp) __builtin_amdgcn_global_load_lds((const unsigned*)(gp), (__attribute__((address_space(3))) unsigned*)(lp), 16, 0, 0)
#define G_ISSUE(st, k0) do { char* sa_ = lds + (st) * G_STAGE + tid * 16; \
    G_DMA(ap0 + (k0), sa_); G_DMA(ap1 + (k0), sa_ + 8192); G_DMA(ap2 + (k0), sa_ + 16384); G_DMA(ap3 + (k0), sa_ + 24576); \
    G_DMA(bp0 + (k0), sa_ + 32768); G_DMA(bp1 + (k0), sa_ + 40960); } while (0)
  const int fsw = (l31 >> 1) & 7, g = fsw >> 1, c0 = l31 * 128 + ((hi ^ (fsw & 1)) << 4);
  const int o0 = c0 + ((0 ^ g) << 5), o1 = c0 + ((1 ^ g) << 5), o2 = c0 + ((2 ^ g) << 5), o3 = c0 + ((3 ^ g) << 5);
  const int abase = (64 * wm) * 128, bbase = 32768 + (64 * wn) * 128;
#define G_FRAG(O, A0, A1, B0, B1) do { A0 = *(const bf16x8*)(cS + abase + (O)); B0 = *(const bf16x8*)(cS + bbase + (O)); \
    A1 = *(const bf16x8*)(cS + abase + 4096 + (O)); B1 = *(const bf16x8*)(cS + bbase + 4096 + (O)); } while (0)
#define G_MMA(A0, A1, B0, B1) do { \
    acc[0][0] = __builtin_amdgcn_mfma_f32_32x32x16_bf16(A0, B0, acc[0][0], 0, 0, 0); \
    acc[0][1] = __builtin_amdgcn_mfma_f32_32x32x16_bf16(A0, B1, acc[0][1], 0, 0, 0); \
    acc[1][0] = __builtin_amdgcn_mfma_f32_32x32x16_bf16(A1, B0, acc[1][0], 0, 0, 0); \
    acc[1][1] = __builtin_amdgcn_mfma_f32_32x32x16_bf16(A1, B1, acc[1][1], 0, 0, 0); } while (0)
  const int nk = K >> 6;
  G_ISSUE(0, 0);
  if (nk > 1) G_ISSUE(1, 64);
  int st = 0, st2 = 2;
  for (int kt = 0; kt < nk; ++kt) {
    if (kt + 1 < nk) asm volatile("s_waitcnt vmcnt(6)" ::: "memory"); else asm volatile("s_waitcnt vmcnt(0)" ::: "memory");
    __builtin_amdgcn_s_barrier();
    if (kt + 2 < nk) G_ISSUE(st2, (kt + 2) * 64);
    const char* cS = lds + st * G_STAGE;
    bf16x8 pa0, pa1, pb0, pb1, qa0, qa1, qb0, qb1, ra0_, ra1_, rb0_, rb1_;
    G_FRAG(o0, pa0, pa1, pb0, pb1); G_FRAG(o1, qa0, qa1, qb0, qb1); __builtin_amdgcn_sched_barrier(0);
    G_MMA(pa0, pa1, pb0, pb1); G_FRAG(o2, ra0_, ra1_, rb0_, rb1_); __builtin_amdgcn_sched_barrier(0);
    G_MMA(qa0, qa1, qb0, qb1); G_FRAG(o3, pa0, pa1, pb0, pb1); __builtin_amdgcn_sched_barrier(0);
    G_MMA(ra0_, ra1_, rb0_, rb1_); G_MMA(pa0, pa1, pb0, pb1);
    st = st == 2 ? 0 : st + 1; st2 = st2 == 2 ? 0 : st2 + 1;
  }
#undef G_DMA
#undef G_ISSUE
#undef G_FRAG
#undef G_MMA
  __syncthreads();
  epi(acc, 64 * wm, col0 + 64 * wn);
}

template <class RowMap, class Post>
__device__ __forceinline__ void gemm_tile256b(const bf16_t* __restrict__ A, int lda, RowMap rowmap, const bf16_t* __restrict__ Bt, int ldb, int col0, int K,
                                             char* lds, Post post) {
  const int tid = get_tid(), lane = tid & 63, wid = tid >> 6, wm = wid >> 1, wn = wid & 1, l31 = lane & 31, hi = lane >> 5;
  const int lr = tid >> 3, lc = tid & 7, kc = lc ^ ((lr >> 1) & 7);
  const bf16_t* ap0 = A + (size_t)rowmap(lr) * lda + kc * 8;
  const bf16_t* ap1 = A + (size_t)rowmap(lr + 64) * lda + kc * 8;
  const bf16_t* ap2 = A + (size_t)rowmap(lr + 128) * lda + kc * 8;
  const bf16_t* ap3 = A + (size_t)rowmap(lr + 192) * lda + kc * 8;
  const bf16_t* bp0 = Bt + (size_t)(col0 + lr) * ldb + kc * 8;
  const size_t bstep = (size_t)64 * ldb;
  const int l15 = lane & 15, q4 = lane >> 4;
  f32x4 acc[4][8];
#pragma unroll
  for (int i = 0; i < 4; ++i)
#pragma unroll
    for (int j = 0; j < 8; ++j) { acc[i][j][0] = 0.f; acc[i][j][1] = 0.f; acc[i][j][2] = 0.f; acc[i][j][3] = 0.f; }
#define H_DMA(gp, lp) __builtin_amdgcn_global_load_lds((const unsigned*)(gp), (__attribute__((address_space(3))) unsigned*)(lp), 16, 0, 0)
#define H_ISSUE(st, k0) do { char* sa_ = lds + (st) * 65536 + tid * 16; \
    H_DMA(ap0 + (k0), sa_); H_DMA(ap1 + (k0), sa_ + 8192); H_DMA(ap2 + (k0), sa_ + 16384); H_DMA(ap3 + (k0), sa_ + 24576); \
    H_DMA(bp0 + (k0), sa_ + 32768); H_DMA(bp0 + bstep + (k0), sa_ + 40960); H_DMA(bp0 + 2 * bstep + (k0), sa_ + 49152); H_DMA(bp0 + 3 * bstep + (k0), sa_ + 57344); } while (0)
  const int fsw = l15 >> 1, c0 = l15 * 128;
  const int ok0 = c0 + (((0 + q4) ^ fsw) << 4), ok1 = c0 + (((4 + q4) ^ fsw) << 4);
  const int abase = (64 * wm) * 128, bbase = 32768 + (128 * wn) * 128;
#define H_FA(O, F) do { F[0] = *(const bf16x8*)(cS + abase + (O)); F[1] = *(const bf16x8*)(cS + abase + 2048 + (O)); \
    F[2] = *(const bf16x8*)(cS + abase + 4096 + (O)); F[3] = *(const bf16x8*)(cS + abase + 6144 + (O)); } while (0)
#define H_FB(O, NH, F) do { F[0] = *(const bf16x8*)(cS + bbase + (NH) * 8192 + (O)); F[1] = *(const bf16x8*)(cS + bbase + (NH) * 8192 + 2048 + (O)); \
    F[2] = *(const bf16x8*)(cS + bbase + (NH) * 8192 + 4096 + (O)); F[3] = *(const bf16x8*)(cS + bbase + (NH) * 8192 + 6144 + (O)); } while (0)
#define H_MMA(FA, FB, NH) do { _Pragma("unroll") for (int mi_ = 0; mi_ < 4; ++mi_) { _Pragma("unroll") for (int nj_ = 0; nj_ < 4; ++nj_) \
    acc[mi_][(NH) * 4 + nj_] = __builtin_amdgcn_mfma_f32_16x16x32_bf16(FA[mi_], FB[nj_], acc[mi_][(NH) * 4 + nj_], 0, 0, 0); } } while (0)
  const int nk = K >> 6;
  H_ISSUE(0, 0);
  for (int kt = 0; kt < nk; ++kt) {
    asm volatile("s_waitcnt vmcnt(0)" ::: "memory");
    __builtin_amdgcn_s_barrier();
    if (kt + 1 < nk) H_ISSUE((kt + 1) & 1, (kt + 1) * 64);
    const char* cS = lds + (kt & 1) * 65536;
    bf16x8 fa0[4], fb0[4];
    H_FA(ok0, fa0); H_FB(ok0, 0, fb0); __builtin_amdgcn_sched_barrier(0);
    H_MMA(fa0, fb0, 0); __builtin_amdgcn_sched_barrier(0);
    H_FB(ok0, 1, fb0); __builtin_amdgcn_sched_barrier(0);
    H_MMA(fa0, fb0, 1); __builtin_amdgcn_sched_barrier(0);
    H_FA(ok1, fa0); H_FB(ok1, 0, fb0); __builtin_amdgcn_sched_barrier(0);
    H_MMA(fa0, fb0, 0); __builtin_amdgcn_sched_barrier(0);
    H_FB(ok1, 1, fb0); __builtin_amdgcn_sched_barrier(0);
    H_MMA(fa0, fb0, 1);
  }
#undef H_DMA
#undef H_ISSUE
#undef H_FA
#undef H_FB
#undef H_MMA
  float* ut = (float*)lds;
#pragma unroll
  for (int h = 0; h < 2; ++h) {
    __syncthreads();
    if (wn == h) {
#pragma unroll
      for (int mi = 0; mi < 4; ++mi)
#pragma unroll
        for (int ni = 0; ni < 8; ++ni)
#pragma unroll
          for (int r = 0; r < 4; ++r) ut[(64 * wm + 16 * mi + 4 * q4 + r) * 128 + 16 * ni + l15] = acc[mi][ni][r];
    }
    __syncthreads();
    post(h);
  }
  __syncthreads();
}

template <class RowMap, class Post>
__device__ __forceinline__ void gemm_tile256(const bf16_t* __restrict__ A, int lda, RowMap rowmap, const bf16_t* __restrict__ Bt, int ldb, int col0, int K,
                                             char* lds, Post post) {
  const int tid = get_tid(), lane = tid & 63, wid = tid >> 6, wm = wid >> 1, wn = wid & 1, l31 = lane & 31, hi = lane >> 5;
  const int lr = tid >> 3, lc = tid & 7, kc = lc ^ ((lr >> 1) & 7);
  const bf16_t* ap0 = A + (size_t)rowmap(lr) * lda + kc * 8;
  const bf16_t* ap1 = A + (size_t)rowmap(lr + 64) * lda + kc * 8;
  const bf16_t* ap2 = A + (size_t)rowmap(lr + 128) * lda + kc * 8;
  const bf16_t* ap3 = A + (size_t)rowmap(lr + 192) * lda + kc * 8;
  const bf16_t* bp0 = Bt + (size_t)(col0 + lr) * ldb + kc * 8;
  const size_t bstep = (size_t)64 * ldb;
  f32x16 acc[2][4];
#pragma unroll
  for (int i = 0; i < 2; ++i)
#pragma unroll
    for (int j = 0; j < 4; ++j)
#pragma unroll
      for (int r = 0; r < 16; ++r) acc[i][j][r] = 0.f;
#define H_DMA(gp, lp) __builtin_amdgcn_global_load_lds((const unsigned*)(gp), (__attribute__((address_space(3))) unsigned*)(lp), 16, 0, 0)
#define H_ISSUE(st, k0) do { char* sa_ = lds + (st) * 65536 + tid * 16; \
    H_DMA(ap0 + (k0), sa_); H_DMA(ap1 + (k0), sa_ + 8192); H_DMA(ap2 + (k0), sa_ + 16384); H_DMA(ap3 + (k0), sa_ + 24576); \
    H_DMA(bp0 + (k0), sa_ + 32768); H_DMA(bp0 + bstep + (k0), sa_ + 40960); H_DMA(bp0 + 2 * bstep + (k0), sa_ + 49152); H_DMA(bp0 + 3 * bstep + (k0), sa_ + 57344); } while (0)
  const int fsw = (l31 >> 1) & 7, g = fsw >> 1, c0 = l31 * 128 + ((hi ^ (fsw & 1)) << 4);
  const int o0 = c0 + ((0 ^ g) << 5), o1 = c0 + ((1 ^ g) << 5), o2 = c0 + ((2 ^ g) << 5), o3 = c0 + ((3 ^ g) << 5);
  const int abase = (64 * wm) * 128, bbase = 32768 + (128 * wn) * 128;
#define H_FRAG(O, F) do { F[0] = *(const bf16x8*)(cS + abase + (O)); F[1] = *(const bf16x8*)(cS + abase + 4096 + (O)); \
    F[2] = *(const bf16x8*)(cS + bbase + (O)); F[3] = *(const bf16x8*)(cS + bbase + 4096 + (O)); \
    F[4] = *(const bf16x8*)(cS + bbase + 8192 + (O)); F[5] = *(const bf16x8*)(cS + bbase + 12288 + (O)); } while (0)
#define H_MMA(F) do { _Pragma("unroll") for (int nb_ = 0; nb_ < 4; ++nb_) { \
    acc[0][nb_] = __builtin_amdgcn_mfma_f32_32x32x16_bf16(F[0], F[2 + nb_], acc[0][nb_], 0, 0, 0); \
    acc[1][nb_] = __builtin_amdgcn_mfma_f32_32x32x16_bf16(F[1], F[2 + nb_], acc[1][nb_], 0, 0, 0); } } while (0)
  const int nk = K >> 6;
  H_ISSUE(0, 0);
  for (int kt = 0; kt < nk; ++kt) {
    asm volatile("s_waitcnt vmcnt(0)" ::: "memory");
    __builtin_amdgcn_s_barrier();
    if (kt + 1 < nk) H_ISSUE((kt + 1) & 1, (kt + 1) * 64);
    const char* cS = lds + (kt & 1) * 65536;
    bf16x8 f0[6], f1[6];
    H_FRAG(o0, f0); H_FRAG(o1, f1); __builtin_amdgcn_sched_barrier(0);
    H_MMA(f0); H_FRAG(o2, f0); __builtin_amdgcn_sched_barrier(0);
    H_MMA(f1); H_FRAG(o3, f1); __builtin_amdgcn_sched_barrier(0);
    H_MMA(f0); H_MMA(f1);
  }
#undef H_DMA
#undef H_ISSUE
#undef H_FRAG
#undef H_MMA
  float* ut = (float*)lds;
#pragma unroll
  for (int h = 0; h < 2; ++h) {
    __syncthreads();
    if (wn == h) {
#pragma unroll
      for (int mb = 0; mb < 2; ++mb)
#pragma unroll
        for (int nb = 0; nb < 4; ++nb)
#pragma unroll
          for (int r = 0; r < 16; ++r) ut[(64 * wm + 32 * mb + crow(r, hi)) * 128 + 32 * nb + l31] = acc[mb][nb][r];
    }
    __syncthreads();
    post(h);
  }
  __syncthreads();
}

struct RowId { int r0; __device__ __forceinline__ int operator()(int i) const { return r0 + i; } };
struct RowHalo { int r0; __device__ __forceinline__ int operator()(int i) const { int r = r0 + i; r = r < 0 ? 0 : r; return r > T - 1 ? T - 1 : r; } };

__device__ __forceinline__ void transpose_item(const float* __restrict__ src, int ldsrc, int K  , bf16_t* __restrict__ dst, int kt, int ntile, int mode,
                               const float* __restrict__ kscale, float* tile) {
  const int tid = get_tid(), k0 = kt * 64, n0 = ntile * 64;
#pragma unroll
  for (int i = 0; i < 2; ++i) {
    const int kk = (tid >> 4) + 32 * i, n4 = (tid & 15) * 4, nn = n0 + n4;
    const int sc = mode == 1 ? (((nn & 63) < 32) ? (nn >> 6) * 32 + (nn & 31) : DFF + (nn >> 6) * 32 + (nn & 31)) : nn;
    f32x4 v = *(const f32x4*)(src + (size_t)(k0 + kk) * ldsrc + sc);
    if (kscale) { const float g = kscale[k0 + kk]; v *= g; }
    float* tp = tile + kk * 65 + n4; tp[0] = v[0]; tp[1] = v[1]; tp[2] = v[2]; tp[3] = v[3];
  }
  __syncthreads();
  {
    const int n = tid >> 3, kc = tid & 7; const float* tp = tile + (kc * 8) * 65 + n;
    u32x4 w; w[0] = cvtpk(tp[0], tp[65]); w[1] = cvtpk(tp[130], tp[195]); w[2] = cvtpk(tp[260], tp[325]); w[3] = cvtpk(tp[390], tp[455]);
    *(u32x4*)(dst + (size_t)(n0 + n) * K + k0 + kc * 8) = w;
  }
  __syncthreads();
}

__device__ __forceinline__ void phase0(PP pp, char* lds) {
  const int tid = get_tid();
  float* svec = (float*)lds; float* red = (float*)(lds + 12288); float* tile = (float*)(lds + 20480);
  for (int i = tid; i < 3072; i += 512) { const int v = i >> 10, k = i & 1023; const float val = v < 2 ? pp->c[v * 1024 + k] : pp->c_ctx[k]; svec[i] = silu_f(val); }
  __syncthreads();
  constexpr int N_ADA = 192, N_ROPE = 1, N_TR = 3000, N_SG = 16, PER_L = N_TR + N_SG;
  constexpr int N_ITEMS = N_ADA + N_ROPE + NLAYER * PER_L;
  for (int it = get_bid(); it < N_ITEMS; it += gridDim.x) {
    if (it < N_ADA) {
      const int l = it / 96, c0 = (it % 96) * 64, col = tid & 63, kg = tid >> 6;
      const float* wp = pp->ada_w + ((size_t)l * 1024 + kg * 128) * 6144 + c0 + col;
      float a0 = 0.f, a1 = 0.f, a2 = 0.f;
#pragma unroll 8
      for (int k = 0; k < 128; ++k) { const float w = wp[(size_t)k * 6144]; const int kk = kg * 128 + k; a0 += svec[kk] * w; a1 += svec[1024 + kk] * w; a2 += svec[2048 + kk] * w; }
      red[(kg * 3 + 0) * 64 + col] = a0; red[(kg * 3 + 1) * 64 + col] = a1; red[(kg * 3 + 2) * 64 + col] = a2;
      __syncthreads();
      if (tid < 192) { const int v = tid >> 6; float s = 0.f;
#pragma unroll
        for (int g = 0; g < 8; ++g) s += red[(g * 3 + v) * 64 + col];
        ((float*)(pp->ws + OFF_MOD))[(size_t)(l * 3 + v) * 6144 + c0 + col] = s + pp->ada_b[l * 6144 + c0 + col]; }
      __syncthreads();
    } else if (it < N_ADA + N_ROPE) {
      for (int e = tid; e < 128 * 24; e += 512) {
        const int pos = e / 24, i = e % 24; const bool big = i < 16; const int ii = big ? i : i - 16;
        const float inv = exp2f(-(float)ii / (big ? 16.f : 8.f) * 13.287712379549449f);
        const float ang = (float)pos * inv;
        const double a = (double)ang; const double n = rint(a * 0.15915494309189535); const float y = (float)(a - n * 6.283185307179586);
        f32x2 cs; cs[0] = cosf(y); cs[1] = sinf(y);
        if (big) ((f32x2*)(pp->ws + OFF_CS16))[pos * 16 + ii] = cs; else ((f32x2*)(pp->ws + OFF_CS8))[pos * 8 + ii] = cs;
      }
    } else {
      const int q = it - N_ADA - N_ROPE, l = q / PER_L; int t = q % PER_L;
      bf16_t* wl = (bf16_t*)(pp->ws + OFF_W) + (size_t)l * W_LAYER;
      if (t < 496) transpose_item(pp->w_in + (size_t)l * 1024 * INW, INW, KP, wl + W_IN, t % 16, t / 16, 0, nullptr, tile);
      else if (t < 568) { t -= 496; transpose_item(pp->mla_wuq + (size_t)l * 384 * 768, 768, 384, wl + W_UQ, t % 6, t / 6, 0, pp->mla_gq + l * 384, tile); }
      else if (t < 632) { t -= 568; transpose_item(pp->mla_wukv + (size_t)l * 256 * 1024, 1024, 256, wl + W_UKV, t % 4, t / 4, 0, pp->mla_gkv + l * 256, tile); }
      else if (t < 888) { t -= 632; transpose_item(pp->w_o + (size_t)l * 1024 * 1024, 1024, KP, wl + W_O, t % 16, t / 16, 0, nullptr, tile); }
      else if (t < 2296) { t -= 888; transpose_item(pp->ffn_wup + (size_t)l * 1024 * 5632, 5632, KP, wl + W_UP, t % 16, t / 16, 1, nullptr, tile); }
      else if (t < 3000) { t -= 2296; transpose_item(pp->ffn_wdown + (size_t)l * DFF * 1024, 1024, DFF, wl + W_DN, t % 44, t / 44, 0, nullptr, tile); }
      else { t -= 3000; const size_t idx = (size_t)t * 4096 + tid * 8; const float* s = pp->sgu_ws + (size_t)l * 65536 + idx;
        const f32x4 v0 = *(const f32x4*)s, v1 = *(const f32x4*)(s + 4);
        u32x4 w; w[0] = cvtpk(v0[0], v0[1]); w[1] = cvtpk(v0[2], v0[3]); w[2] = cvtpk(v1[0], v1[1]); w[3] = cvtpk(v1[2], v1[3]);
        *(u32x4*)(wl + W_SG + idx) = w; }
    }
  }
}

__device__ __forceinline__ void row_pass(PP pp, int mode, const float* __restrict__ lg, const float* __restrict__ lb, int lm, int shc, int scc, bool want_h, bool skip_ctx, bool alpha_ctx) {
  const int lane = get_tid() & 63, wid = get_tid() >> 6;
  const float* mod = (const float*)(pp->ws + OFF_MOD) + (size_t)lm * 3 * 6144;
  bf16_t* hmod = (bf16_t*)(pp->ws + OFF_HMOD);
  for (int t = get_bid() * 8 + wid; t < T; t += gridDim.x * 8) {
    const int b = t / SB, j = t - b * SB; const bool isctx = j < CTX;
    if (isctx && skip_ctx) continue;
    float* xr = xrow(pp, t);
    const float* src = mode == 0 ? (isctx ? pp->ctx + (size_t)(b * CTX + j) * DM : pp->x + (size_t)(b * SEQ + j - CTX) * DM) : xr;
    f32x4 v[4];
#pragma unroll
    for (int i = 0; i < 4; ++i) v[i] = *(const f32x4*)(src + (i * 64 + lane) * 4);
    if (mode == 1) {
      float s = 0.f;
#pragma unroll
      for (int i = 0; i < 4; ++i) s += (v[i][0] + v[i][1]) + (v[i][2] + v[i][3]);
#pragma unroll
      for (int o = 32; o > 0; o >>= 1) s += __shfl_xor(s, o);
      const float mu = s * (1.f / 1024.f);
      float q = 0.f;
#pragma unroll
      for (int i = 0; i < 4; ++i) { v[i] -= mu; q += (v[i][0] * v[i][0] + v[i][1] * v[i][1]) + (v[i][2] * v[i][2] + v[i][3] * v[i][3]); }
#pragma unroll
      for (int o = 32; o > 0; o >>= 1) q += __shfl_xor(q, o);
      const float rstd = rsqrtf(q * (1.f / 1024.f) + EPS);
#pragma unroll
      for (int i = 0; i < 4; ++i) { const int c = (i * 64 + lane) * 4; const f32x4 g = *(const f32x4*)(lg + c), bb = *(const f32x4*)(lb + c); v[i] = v[i] * rstd * g + bb; }
    }
    { const float sca = (isctx && alpha_ctx) ? DN_ALPHA : 1.f;
#pragma unroll
      for (int i = 0; i < 4; ++i) *(f32x4*)(xr + (i * 64 + lane) * 4) = v[i] * sca; }
    if (want_h) {
      if (lane == 0) { float z0 = 0.f; asm volatile("" : "+v"(z0)); f32x2 z; z[0] = z0; z[1] = z0; *(f32x2*)(pp->ws + OFF_SSQ + (size_t)t * 8) = z; }
      const float* mv = mod + (size_t)(isctx ? 2 : b) * 6144;
#pragma unroll
      for (int i = 0; i < 4; ++i) { const int c = (i * 64 + lane) * 4; const f32x4 sh = *(const f32x4*)(mv + shc * 1024 + c), sc = *(const f32x4*)(mv + scc * 1024 + c);
        const f32x4 h = v[i] * (sc + 1.f) + sh; u32x2 w; w[0] = cvtpk(h[0], h[1]); w[1] = cvtpk(h[2], h[3]); *(u32x2*)(hmod + (size_t)t * KP + c) = w; }
    }
  }
}

__device__ __forceinline__ void dump_tile(f32x16 (&acc)[2][2], int rbase, int cl, float* ut, int c31, int hi) {
#pragma unroll
  for (int mb = 0; mb < 2; ++mb)
#pragma unroll
    for (int nb = 0; nb < 2; ++nb)
#pragma unroll
      for (int r = 0; r < 16; ++r) ut[(rbase + 32 * mb + crow(r, hi)) * 128 + cl + 32 * nb + c31] = acc[mb][nb][r];
}
__device__ __forceinline__ u32x4 pack8f(const f32x4 a, const f32x4 b) { u32x4 w; w[0] = cvtpk(a[0], a[1]); w[1] = cvtpk(a[2], a[3]); w[2] = cvtpk(b[0], b[1]); w[3] = cvtpk(b[2], b[3]); return w; }
__device__ __forceinline__ void rope8(f32x4& a, f32x4& b, const f32x4 pa, const f32x4 pb, const f32x2* cs, bool upper) {
  const float sg = upper ? 1.f : -1.f;
#pragma unroll
  for (int e = 0; e < 4; ++e) { const f32x2 c0 = cs[e], c1 = cs[4 + e]; a[e] = a[e] * c0[0] + sg * pa[e] * c0[1]; b[e] = b[e] * c1[0] + sg * pb[e] * c1[1]; }
}
template <int NCOL>
__device__ __forceinline__ void store_transposed(const float* ut, int lc0, bf16_t* dst  , const float* rscale) {
  const int tid = get_tid(), col = tid & (NCOL - 1), rc0 = tid / NCOL;
#pragma unroll 2
  for (int rc = rc0; rc < 32; rc += 512 / NCOL) {
    float v[8];
#pragma unroll
    for (int e = 0; e < 8; ++e) { v[e] = ut[(rc * 8 + e) * 128 + lc0 + col]; if (rscale) v[e] *= rscale[rc * 8 + e]; }
    u32x4 w; w[0] = cvtpk(v[0], v[1]); w[1] = cvtpk(v[2], v[3]); w[2] = cvtpk(v[4], v[5]); w[3] = cvtpk(v[6], v[7]);
    *(u32x4*)(dst + (size_t)col * SB + rc * 8) = w;
  }
}

__device__ __forceinline__ void phase_win(PP pp, int l, char* lds) {
  const bf16_t* A = (const bf16_t*)(pp->ws + OFF_HMOD);
  const bf16_t* Bt = (const bf16_t*)(pp->ws + OFF_W) + (size_t)l * W_LAYER + W_IN;
  bf16_t* zq = (bf16_t*)(pp->ws + OFF_ZQ); bf16_t* Kr = (bf16_t*)(pp->ws + OFF_KR); bf16_t* Qd = (bf16_t*)(pp->ws + OFF_QD); bf16_t* Kd = (bf16_t*)(pp->ws + OFF_KD);
  bf16_t* VdT = (bf16_t*)(pp->ws + OFF_VDT); bf16_t* zc = (bf16_t*)(pp->ws + OFF_ZC);
  const f32x2* cs16 = (const f32x2*)(pp->ws + OFF_CS16); const f32x2* cs8 = (const f32x2*)(pp->ws + OFF_CS8);
  const int tid = get_tid(), lane = tid & 63, c31 = lane & 31, hi = lane >> 5;
  float* ut = (float*)lds;
  const bool xmap = gridDim.x == 256; const int xq = get_bid() & 7, xj = get_bid() >> 3;
  for (int it0 = get_bid(); it0 < 64 * 8 + 32; it0 += gridDim.x) {
    const int it = (xmap && it0 < 512) ? ((xq * 8 + (((it0 >> 8) * 32 + xj) >> 3)) << 3) + (xj & 7) : it0;
    const bool lat = it < 512; const int mi = it >> 3;
    const int mt = lat ? (mi >> 5) * 33 + 1 + (mi & 31) : ((it - 512) >> 4) * 33, nt2 = it & 7, ntc = (it - 512) & 15;
    const int row0 = mt * 256, b = mt / 33, j0 = row0 - b * SB; const bool isctx = !lat;
    auto post_nt = [&](int nt) {
    {
      const int cc = tid & 15, seg = 2 * nt + (cc >> 3), col = nt * 128 + cc * 8;
      if (seg < 31 && !(seg >= 19 && seg < 23)) {
#pragma unroll 2
        for (int i = 0; i < 8; ++i) {
          const int row = (tid >> 4) + 32 * i, t = row0 + row; const float* up = ut + row * 128 + cc * 8;
          f32x4 va = *(const f32x4*)up, vb = *(const f32x4*)(up + 4);
          if (seg < 10) { *(u32x4*)(zq + (size_t)t * 640 + col) = pack8f(va, vb);
            float ss = (va[0] * va[0] + va[1] * va[1]) + (va[2] * va[2] + va[3] * va[3]) + (vb[0] * vb[0] + vb[1] * vb[1]) + (vb[2] * vb[2] + vb[3] * vb[3]);
            ss += __shfl_xor(ss, 1); ss += __shfl_xor(ss, 2); ss += __shfl_xor(ss, 4);
            if ((cc & 7) == 0) atomicAdd((float*)(pp->ws + OFF_SSQ) + (size_t)t * 2 + (seg < 6 ? 0 : 1), ss); }
          else if (seg == 10) {
            if (!isctx) { const float* qp = ut + row * 128 + (cc ^ 2) * 8; const f32x4 pa = *(const f32x4*)qp, pb = *(const f32x4*)(qp + 4);
              const int ppos = j0 + row - CTX, pos = ((cc & 4) == 0) ? (ppos >> 6) : (ppos & 63);
              rope8(va, vb, pa, pb, cs16 + pos * 16 + (cc & 1) * 8, (cc & 2) != 0); }
            *(u32x4*)(Kr + (size_t)t * 64 + (cc & 7) * 8) = pack8f(va, vb);
          } else if (seg < 19) {
            if (!isctx) { const float* qp = ut + row * 128 + (cc ^ 1) * 8; const f32x4 pa = *(const f32x4*)qp, pb = *(const f32x4*)(qp + 4);
              const int ppos = j0 + row - CTX, pos = ((cc & 2) == 0) ? (ppos >> 6) : (ppos & 63);
              rope8(va, vb, pa, pb, cs8 + pos * 8, (cc & 1) != 0); }
            if (seg < 15) { va *= QS_DIFF; vb *= QS_DIFF; *(u32x4*)(Qd + (size_t)t * 256 + col - 704) = pack8f(va, vb); }
            else *(u32x4*)(Kd + (size_t)t * 256 + col - 960) = pack8f(va, vb);
          } else {
#pragma unroll
            for (int e = 0; e < 4; ++e) { va[e] = gelu_tanh(va[e]); vb[e] = gelu_tanh(vb[e]); }
            *(u32x4*)(zc + (size_t)t * 512 + col - 1472) = pack8f(va, vb);
          }
        }
      }
#pragma unroll
      for (int sh = 0; sh < 2; ++sh) { const int sg = 2 * nt + sh;
        if (sg >= 19 && sg < 23) store_transposed<64>(ut, sh * 64, VdT + (size_t)(b * 4 + (sg - 19)) * 64 * SB + j0, nullptr); }
    }
    };
    if (lat) { auto post = [&](int h) { post_nt(2 * nt2 + h); }; gemm_tile256b(A, KP, RowId{row0}, Bt, KP, nt2 * 256, DM, lds, post); }
    else {
      auto epi = [&](f32x16 (&acc)[2][2], int rbase, int cbase) { dump_tile(acc, rbase, cbase - ntc * 128, ut, c31, hi); };
      gemm_tile(A, KP, RowId{row0}, Bt, KP, ntc * 128, DM, lds, epi);
      __syncthreads(); post_nt(ntc); __syncthreads();
    }
  }
}

__device__ __forceinline__ void phase_up2(PP pp, int l, char* lds) {
  const bf16_t* zq = (const bf16_t*)(pp->ws + OFF_ZQ);
  const bf16_t* wl = (const bf16_t*)(pp->ws + OFF_W) + (size_t)l * W_LAYER;
  bf16_t* Qm = (bf16_t*)(pp->ws + OFF_QM); bf16_t* Km = (bf16_t*)(pp->ws + OFF_KM); bf16_t* VmT = (bf16_t*)(pp->ws + OFF_VMT);
  const bf16_t* zc = (const bf16_t*)(pp->ws + OFF_ZC); bf16_t* Y = (bf16_t*)(pp->ws + OFF_Y);
  const f32x2* cs16 = (const f32x2*)(pp->ws + OFF_CS16);
  const int tid = get_tid(), lane = tid & 63, wid = tid >> 6, c31 = lane & 31, hi = lane >> 5;
  float* rstd = (float*)(lds + LDS_RSTD);
  constexpr int N_UQ = 66 * 3, N_UKV = 66 * 4, N_CH = 132;
  const float* ssq = (const float*)(pp->ws + OFF_SSQ);
  for (int it = get_bid(); it < N_UQ + N_UKV; it += gridDim.x) {
    {
      const bool isq = it < N_UQ; const int q = isq ? it : it - N_UQ; const int nN = isq ? 3 : 4;
      const int mt = q / nN, nt2 = q % nN, row0 = mt * 256, b = mt / 33, j0 = row0 - b * SB; const bool isctx = (mt % 33) == 0;
      if (tid < 256) rstd[tid] = rsqrtf(ssq[(size_t)(row0 + tid) * 2 + (isq ? 0 : 1)] * (isq ? 1.f / 384.f : 1.f / 256.f) + EPS);
      float* ut = (float*)lds;
      auto post = [&](int h) {
        const int nt = 2 * nt2 + h;
        if (isq || (nt & 1) == 0) {
          const int cc = tid & 15, seg = 2 * nt + (cc >> 3), col = nt * 128 + cc * 8;
#pragma unroll 2
          for (int i = 0; i < 8; ++i) {
            const int row = (tid >> 4) + 32 * i, t = row0 + row; const float* up = ut + row * 128 + cc * 8; const float rs = rstd[row];
            f32x4 va = *(const f32x4*)up, vb = *(const f32x4*)(up + 4);
            if (isq) {
              if ((seg % 3) == 2 && !isctx) { const float* qp = ut + row * 128 + (cc ^ 2) * 8; const f32x4 pa = *(const f32x4*)qp, pb = *(const f32x4*)(qp + 4);
                const int ppos = j0 + row - CTX, pos = ((cc & 4) == 0) ? (ppos >> 6) : (ppos & 63);
                rope8(va, vb, pa, pb, cs16 + pos * 16 + (cc & 1) * 8, (cc & 2) != 0); }
              va *= rs * QS_MLA; vb *= rs * QS_MLA;
              *(u32x4*)(Qm + (size_t)t * 768 + col) = pack8f(va, vb);
            } else {
              va *= rs; vb *= rs;
              *(u32x4*)(Km + (size_t)t * 512 + (nt >> 1) * 128 + cc * 8) = pack8f(va, vb);
            }
          }
        } else {
          store_transposed<128>(ut, 0, VmT + (size_t)(b * 4 + (nt >> 1)) * 128 * SB + j0, rstd);
        }
      };
      gemm_tile256(isq ? zq : zq + 384, 640, RowId{row0}, isq ? wl + W_UQ : wl + W_UKV, isq ? 384 : 256, nt2 * 256, isq ? 384 : 256, lds, post);
    }
  }
  for (int it = (get_bid() + gridDim.x - ((N_UQ + N_UKV) % gridDim.x)) % gridDim.x; it < N_CH * 4; it += gridDim.x) {
    {
      const int ch = it >> 2, g0 = it & 3, t0 = ch * 128;
      float* st = (float*)lds;
      bf16_t* vT = (bf16_t*)(lds + 1024);
      if (tid < 256) {
        const int r = tid >> 1, hf = tid & 1; const bf16_t* rp = zc + (size_t)(t0 + r) * 512 + 256 + hf * 128;
        float s = 0.f, ss = 0.f;
        for (int i = 0; i < 16; ++i) { const u32x4 w = *(const u32x4*)(rp + i * 8);
#pragma unroll
          for (int e = 0; e < 4; ++e) { const float a = bflo(w[e]), c = bfhi(w[e]); s += a + c; ss += a * a + c * c; } }
        s += __shfl_xor(s, 1); ss += __shfl_xor(ss, 1);
        const float mu = s * (1.f / 256.f); const float var = fmaxf(ss * (1.f / 256.f) - mu * mu, 0.f);
        if (hf == 0) { st[2 * r] = mu; st[2 * r + 1] = rsqrtf(var + EPS); }
      }
      __syncthreads();
      const bf16_t* Ws = wl + W_SG;
      for (int g = g0; g < g0 + 1; ++g) {
        {
          const int r = tid >> 2, q4 = tid & 3; const bf16_t* rp = zc + (size_t)(t0 + r) * 512 + 256 + g * 64 + q4 * 16;
          const float mu = st[2 * r], rs = st[2 * r + 1];
          const float* lg = pp->sgu_ln_g + l * 256 + g * 64 + q4 * 16; const float* lb = pp->sgu_ln_b + l * 256 + g * 64 + q4 * 16;
#pragma unroll
          for (int i = 0; i < 2; ++i) { const u32x4 w = *(const u32x4*)(rp + i * 8);
#pragma unroll
            for (int e = 0; e < 4; ++e) { const int c = i * 8 + 2 * e;
              vT[(q4 * 16 + c) * 136 + r] = f2bf((bflo(w[e]) - mu) * rs * lg[c] + lb[c]);
              vT[(q4 * 16 + c + 1) * 136 + r] = f2bf((bfhi(w[e]) - mu) * rs * lg[c + 1] + lb[c + 1]); } }
        }
        __syncthreads();
        if (wid < 4) {
          f32x16 a0 = {}, a1 = {};
          const bf16_t* wrow = Ws + ((size_t)g * 128 + 32 * wid + c31) * 128 + hi * 8;
#pragma unroll
          for (int ks = 0; ks < 8; ++ks) {
            const bf16x8 a = *(const bf16x8*)(wrow + ks * 16);
            const bf16x8 b0 = *(const bf16x8*)((const char*)vT + (c31) * 272 + ks * 32 + hi * 16);
            const bf16x8 b1 = *(const bf16x8*)((const char*)vT + (32 + c31) * 272 + ks * 32 + hi * 16);
            a0 = __builtin_amdgcn_mfma_f32_32x32x16_bf16(a, b0, a0, 0, 0, 0);
            a1 = __builtin_amdgcn_mfma_f32_32x32x16_bf16(a, b1, a1, 0, 0, 0);
          }
#pragma unroll
          for (int r = 0; r < 16; ++r) { const int pr = 32 * wid + crow(r, hi); const float bs = pp->sgu_bs[(l * 4 + g) * 128 + pr];
            const size_t t = (size_t)(t0 + pr);
            const float u0 = bf2f(zc[t * 512 + g * 64 + c31]), u1 = bf2f(zc[t * 512 + g * 64 + 32 + c31]);
            Y[t * KP + 768 + g * 64 + c31] = f2bf(u0 * (a0[r] + bs)); Y[t * KP + 768 + g * 64 + 32 + c31] = f2bf(u1 * (a1[r] + bs)); }
        }
        __syncthreads();
      }
    }
  }
}

__device__ __forceinline__ bf16x8 pack8(const f32x16& pv, int base) {
  u32x4 w; w[0] = cvtpk(pv[base], pv[base + 1]); w[1] = cvtpk(pv[base + 2], pv[base + 3]); w[2] = cvtpk(pv[base + 4], pv[base + 5]); w[3] = cvtpk(pv[base + 6], pv[base + 7]);
  return *(bf16x8*)&w;
}
__device__ __forceinline__ bf16x8 ld_vfrag(const char* base) { return *(const bf16x8*)base; }
__device__ __forceinline__ int kperm(int r) { return (r & ~12) | ((r & 4) << 1) | ((r & 8) >> 1); }

constexpr int MLA_KS = 400, MLA_KBYTES = 64 * MLA_KS, VT_S = 144, MLA_VBYTES = 128 * VT_S, MLA_STAGE = MLA_KBYTES + MLA_VBYTES;
constexpr int DF_KS = 144, DF_KBYTES = 64 * DF_KS, DF_VBYTES = 64 * VT_S, DF_STAGE = DF_KBYTES + DF_VBYTES;

template <int NKS>
__device__ __forceinline__ f32x16 qk_tile(const char* krow, const bf16x8* qf, const f32x16& negm) {
  f32x16 p = __builtin_amdgcn_mfma_f32_32x32x16_bf16(*(const bf16x8*)krow, qf[0], negm, 0, 0, 0);
#pragma unroll
  for (int ks = 1; ks < NKS; ++ks) p = __builtin_amdgcn_mfma_f32_32x32x16_bf16(*(const bf16x8*)(krow + ks * 32), qf[ks], p, 0, 0, 0);
  return p;
}
template <int NOB>
__device__ __forceinline__ void sm_pv(f32x16& p, const char* vrow, f32x16& negm, float& m, f32x16& lacc, f32x16* oT, bool first, f32x16* pend) {
  float pm = p[0];
#pragma unroll
  for (int r = 1; r < 16; ++r) pm = fmaxf(pm, p[r]);
  if (first || !__all(pm <= 8.f)) {
    const float pmx = fmaxf(pm, __shfl_xor(pm, 32));
    const float d = first ? pmx : fmaxf(pmx, 0.f);
    if (!first) { const float alpha = fexp2(-d); lacc *= alpha;
#pragma unroll
      for (int nb = 0; nb < NOB; ++nb) oT[nb] *= alpha; }
    m += d;
#pragma unroll
    for (int r = 0; r < 16; ++r) { negm[r] = -m; p[r] -= d; }
    if (pend) {
#pragma unroll
      for (int r = 0; r < 16; ++r) (*pend)[r] -= d; }
  }
#pragma unroll
  for (int r = 0; r < 16; ++r) p[r] = fexp2(p[r]);
  const bf16x8 pb0 = pack8(p, 0), pb1 = pack8(p, 8);
  const bf16x8 ones = {0x3F80, 0x3F80, 0x3F80, 0x3F80, 0x3F80, 0x3F80, 0x3F80, 0x3F80};
  lacc = __builtin_amdgcn_mfma_f32_32x32x16_bf16(ones, pb0, lacc, 0, 0, 0);
  lacc = __builtin_amdgcn_mfma_f32_32x32x16_bf16(ones, pb1, lacc, 0, 0, 0);
#pragma unroll
  for (int nb = 0; nb < NOB; ++nb) {
    oT[nb] = __builtin_amdgcn_mfma_f32_32x32x16_bf16(ld_vfrag(vrow + nb * 32 * VT_S), pb0, oT[nb], 0, 0, 0);
    oT[nb] = __builtin_amdgcn_mfma_f32_32x32x16_bf16(ld_vfrag(vrow + nb * 32 * VT_S + 32), pb1, oT[nb], 0, 0, 0);
  }
}

template <int NOB, int VS = VT_S>
__device__ __forceinline__ void sm_pv_sv(f32x16& p, const char* vrow, f32x16& negm, float& m, float& l, f32x16* oT, bool first) {
  float pm = p[0];
#pragma unroll
  for (int r = 1; r < 16; ++r) pm = fmaxf(pm, p[r]);
  if (first || !__all(pm <= 8.f)) {
    const float pmx = fmaxf(pm, __shfl_xor(pm, 32));
    const float d = first ? pmx : fmaxf(pmx, 0.f);
    if (!first) { const float alpha = fexp2(-d); l *= alpha;
#pragma unroll
      for (int nb = 0; nb < NOB; ++nb) oT[nb] *= alpha; }
    m += d;
#pragma unroll
    for (int r = 0; r < 16; ++r) { negm[r] = -m; p[r] -= d; }
  }
  float ps = 0.f;
#pragma unroll
  for (int r = 0; r < 16; ++r) { p[r] = fexp2(p[r]); ps += p[r]; }
  l += ps;
  const bf16x8 pb0 = pack8(p, 0), pb1 = pack8(p, 8);
#pragma unroll
  for (int nb = 0; nb < NOB; ++nb) {
    oT[nb] = __builtin_amdgcn_mfma_f32_32x32x16_bf16(ld_vfrag(vrow + nb * 32 * VS), pb0, oT[nb], 0, 0, 0);
    oT[nb] = __builtin_amdgcn_mfma_f32_32x32x16_bf16(ld_vfrag(vrow + nb * 32 * VS + 32), pb1, oT[nb], 0, 0, 0);
  }
}

template <int NOB>
__device__ __forceinline__ void sm_pv_valu(f32x16& p, const char* vrow, float& m, float& l, f32x16* oT, bool first) {
  float pm = p[0];
#pragma unroll
  for (int r = 1; r < 16; ++r) pm = fmaxf(pm, p[r]);
  if (first || !__all(pm <= m + 8.f)) {
    const float pmx = fmaxf(pm, __shfl_xor(pm, 32));
    const float mn = first ? pmx : fmaxf(m, pmx);
    if (!first) { const float alpha = fexp2(m - mn); l *= alpha;
#pragma unroll
      for (int nb = 0; nb < NOB; ++nb) oT[nb] *= alpha; }
    m = mn;
  }
  float ps = 0.f;
#pragma unroll
  for (int r = 0; r < 16; ++r) { p[r] = fexp2(p[r] - m); ps += p[r]; }
  l += ps;
  const bf16x8 pb0 = pack8(p, 0), pb1 = pack8(p, 8);
#pragma unroll
  for (int nb = 0; nb < NOB; ++nb) {
    oT[nb] = __builtin_amdgcn_mfma_f32_32x32x16_bf16(ld_vfrag(vrow + nb * 32 * VT_S), pb0, oT[nb], 0, 0, 0);
    oT[nb] = __builtin_amdgcn_mfma_f32_32x32x16_bf16(ld_vfrag(vrow + nb * 32 * VT_S + 32), pb1, oT[nb], 0, 0, 0);
  }
}

__device__ __forceinline__ void attn_mla_item(PP pp, int b, int h, int tq0, int NT, char* lds) {
  const bf16_t* Qm = (const bf16_t*)(pp->ws + OFF_QM); const bf16_t* Km = (const bf16_t*)(pp->ws + OFF_KM); const bf16_t* Kr = (const bf16_t*)(pp->ws + OFF_KR);
  const bf16_t* VmT = (const bf16_t*)(pp->ws + OFF_VMT) + (size_t)(b * 4 + h) * 128 * SB; bf16_t* Y = (bf16_t*)(pp->ws + OFF_Y);
  const int tid = get_tid(), lane = tid & 63, wid = tid >> 6, c31 = lane & 31, hi = lane >> 5;
  const int tk0 = b * SB;
  bf16x8 qf[12];
  { const bf16_t* qp = Qm + (size_t)(tq0 + 32 * wid + c31) * 768 + h * 192 + hi * 8;
#pragma unroll
    for (int ks = 0; ks < 12; ++ks) qf[ks] = *(const bf16x8*)(qp + ks * 16); }
  f32x16 oT[4];
#pragma unroll
  for (int nb = 0; nb < 4; ++nb)
#pragma unroll
    for (int r = 0; r < 16; ++r) oT[nb][r] = 0.f;
  float m = 0.f, l = 0.f; f32x16 negm;
#pragma unroll
  for (int r = 0; r < 16; ++r) negm[r] = 0.f;
  u32x4 rk0, rk1, rk2, rv0, rv1;
  int kkey[3], kc[3];
#pragma unroll
  for (int i = 0; i < 3; ++i) { const int id = tid + 512 * i; kkey[i] = id / 24; kc[i] = id % 24; }
  const int vdv0 = tid >> 3, vkc = tid & 7;
#define A_KSRC(i, key0) (kc[i] < 16 ? Km + (size_t)(tk0 + (key0) + kkey[i]) * 512 + h * 128 + kc[i] * 8 : Kr + (size_t)(tk0 + (key0) + kkey[i]) * 64 + (kc[i] - 16) * 8)
#define A_LOAD(key0) do { rk0 = *(const u32x4*)A_KSRC(0, key0); rk1 = *(const u32x4*)A_KSRC(1, key0); rk2 = *(const u32x4*)A_KSRC(2, key0); \
    rv0 = *(const u32x4*)(VmT + (size_t)vdv0 * SB + (key0) + vkc * 8); rv1 = *(const u32x4*)(VmT + (size_t)(vdv0 + 64) * SB + (key0) + vkc * 8); } while (0)
#define A_STORE(s) do { char* kb_ = lds + (s) * MLA_STAGE; char* vb_ = kb_ + MLA_KBYTES; \
    *(u32x4*)(kb_ + kkey[0] * MLA_KS + kc[0] * 16) = rk0; *(u32x4*)(kb_ + kkey[1] * MLA_KS + kc[1] * 16) = rk1; *(u32x4*)(kb_ + kkey[2] * MLA_KS + kc[2] * 16) = rk2; \
    { char* d_ = vb_ + vdv0 * VT_S + vkc * 16; *(u32x4*)d_ = rv0; *(u32x4*)(d_ + 64 * VT_S) = rv1; } } while (0)
  A_LOAD(0); A_STORE(0); __syncthreads();
  for (int t = 0; t < NT; ++t) {
    const int s = t & 1;
    if (t + 1 < NT) A_LOAD((t + 1) * 64);
    const char* kb = lds + s * MLA_STAGE; const char* vb = kb + MLA_KBYTES;
    const char* ka = kb + kperm(c31) * MLA_KS + hi * 16; const char* va = vb + c31 * VT_S + hi * 16;
    f32x16 pa = qk_tile<12>(ka, qf, negm);
    sm_pv_sv<4>(pa, va, negm, m, l, oT, t == 0);
    f32x16 pbb = qk_tile<12>(ka + 32 * MLA_KS, qf, negm);
    sm_pv_sv<4>(pbb, va + 64, negm, m, l, oT, false);
    if (t + 1 < NT) A_STORE(s ^ 1);
    __syncthreads();
  }
#undef A_KSRC
#undef A_LOAD
#undef A_STORE
  l += __shfl_xor(l, 32);
  const float il = 1.f / l;
  bf16_t* yp = Y + (size_t)(tq0 + 32 * wid + c31) * KP + h * 128;
#pragma unroll
  for (int nb = 0; nb < 4; ++nb)
#pragma unroll
    for (int i4 = 0; i4 < 4; ++i4) { u32x2 w; w[0] = cvtpk(oT[nb][4 * i4] * il, oT[nb][4 * i4 + 1] * il); w[1] = cvtpk(oT[nb][4 * i4 + 2] * il, oT[nb][4 * i4 + 3] * il);
      *(u32x2*)(yp + 32 * nb + 8 * i4 + 4 * hi) = w; }
}

constexpr int MD_K = 64 * 384, MD_STAGE = MD_K + 128 * 128;
__device__ __forceinline__ void attn_mla_item_dma(PP pp, int b, int h, int tq0, int NT, char* lds) {
  const bf16_t* Qm = (const bf16_t*)(pp->ws + OFF_QM); const bf16_t* Km = (const bf16_t*)(pp->ws + OFF_KM); const bf16_t* Kr = (const bf16_t*)(pp->ws + OFF_KR);
  const bf16_t* VmT = (const bf16_t*)(pp->ws + OFF_VMT) + (size_t)(b * 4 + h) * 128 * SB; bf16_t* Y = (bf16_t*)(pp->ws + OFF_Y);
  const int tid = get_tid(), lane = tid & 63, wid = tid >> 6, c31 = lane & 31, hi = lane >> 5;
  const int tk0 = b * SB;
  bf16x8 qf[12];
  { const bf16_t* qp = Qm + (size_t)(tq0 + 32 * wid + c31) * 768 + h * 192 + hi * 8;
#pragma unroll
    for (int ks = 0; ks < 12; ++ks) qf[ks] = *(const bf16x8*)(qp + ks * 16); }
  f32x16 oT[4];
#pragma unroll
  for (int nb = 0; nb < 4; ++nb)
#pragma unroll
    for (int r = 0; r < 16; ++r) oT[nb][r] = 0.f;
  float m = 0.f, l = 0.f; f32x16 negm;
#pragma unroll
  for (int r = 0; r < 16; ++r) negm[r] = 0.f;
  const bf16_t* kp0; const bf16_t* kp1; const bf16_t* kp2; int ks0, ks1, ks2;
#define MD_KPTR(i, P, S) do { const int sl_ = tid + 512 * (i), key_ = sl_ / 24, pc_ = sl_ % 24, c_ = (pc_ & ~7) | ((pc_ & 7) ^ ((key_ >> 1) & 7)); \
    if (c_ < 16) { P = Km + (size_t)(tk0 + key_) * 512 + h * 128 + c_ * 8; S = 512; } else { P = Kr + (size_t)(tk0 + key_) * 64 + (c_ - 16) * 8; S = 64; } } while (0)
  MD_KPTR(0, kp0, ks0); MD_KPTR(1, kp1, ks1); MD_KPTR(2, kp2, ks2);
#undef MD_KPTR
  const int vdv = tid >> 3, vc = (tid & 7) ^ ((vdv >> 1) & 7);
  const bf16_t* vp0 = VmT + (size_t)vdv * SB + vc * 8; const bf16_t* vp1 = vp0 + (size_t)64 * SB;
#define MD_DMA(gp, lp) __builtin_amdgcn_global_load_lds((const unsigned*)(gp), (__attribute__((address_space(3))) unsigned*)(lp), 16, 0, 0)
#define MD_ISSUE(st, key0) do { char* sb_ = lds + (st) * MD_STAGE + tid * 16; \
    MD_DMA(kp0 + (size_t)(key0) * ks0, sb_); MD_DMA(kp1 + (size_t)(key0) * ks1, sb_ + 8192); MD_DMA(kp2 + (size_t)(key0) * ks2, sb_ + 16384); \
    MD_DMA(vp0 + (key0), sb_ + MD_K); MD_DMA(vp1 + (key0), sb_ + MD_K + 8192); } while (0)
  const int kr = kperm(c31), fk = (kr >> 1) & 7, gk = fk >> 1, ek = (hi ^ (fk & 1)) << 4;
  const int ko0 = kr * 384 + (((0 ^ gk) << 5) | ek), ko1 = kr * 384 + (((1 ^ gk) << 5) | ek), ko2 = kr * 384 + (((2 ^ gk) << 5) | ek), ko3 = kr * 384 + (((3 ^ gk) << 5) | ek);
  const int fv = (c31 >> 1) & 7, gv = fv >> 1, ev = (hi ^ (fv & 1)) << 4;
  const int vo0 = c31 * 128 + (((0 ^ gv) << 5) | ev), vo1 = c31 * 128 + (((1 ^ gv) << 5) | ev), vo2 = c31 * 128 + (((2 ^ gv) << 5) | ev), vo3 = c31 * 128 + (((3 ^ gv) << 5) | ev);
#define MD_QK(P, KB) do { P = __builtin_amdgcn_mfma_f32_32x32x16_bf16(*(const bf16x8*)((KB) + ko0), qf[0], negm, 0, 0, 0); \
    P = __builtin_amdgcn_mfma_f32_32x32x16_bf16(*(const bf16x8*)((KB) + ko1), qf[1], P, 0, 0, 0); \
    P = __builtin_amdgcn_mfma_f32_32x32x16_bf16(*(const bf16x8*)((KB) + ko2), qf[2], P, 0, 0, 0); \
    P = __builtin_amdgcn_mfma_f32_32x32x16_bf16(*(const bf16x8*)((KB) + ko3), qf[3], P, 0, 0, 0); \
    P = __builtin_amdgcn_mfma_f32_32x32x16_bf16(*(const bf16x8*)((KB) + 128 + ko0), qf[4], P, 0, 0, 0); \
    P = __builtin_amdgcn_mfma_f32_32x32x16_bf16(*(const bf16x8*)((KB) + 128 + ko1), qf[5], P, 0, 0, 0); \
    P = __builtin_amdgcn_mfma_f32_32x32x16_bf16(*(const bf16x8*)((KB) + 128 + ko2), qf[6], P, 0, 0, 0); \
    P = __builtin_amdgcn_mfma_f32_32x32x16_bf16(*(const bf16x8*)((KB) + 128 + ko3), qf[7], P, 0, 0, 0); \
    P = __builtin_amdgcn_mfma_f32_32x32x16_bf16(*(const bf16x8*)((KB) + 256 + ko0), qf[8], P, 0, 0, 0); \
    P = __builtin_amdgcn_mfma_f32_32x32x16_bf16(*(const bf16x8*)((KB) + 256 + ko1), qf[9], P, 0, 0, 0); \
    P = __builtin_amdgcn_mfma_f32_32x32x16_bf16(*(const bf16x8*)((KB) + 256 + ko2), qf[10], P, 0, 0, 0); \
    P = __builtin_amdgcn_mfma_f32_32x32x16_bf16(*(const bf16x8*)((KB) + 256 + ko3), qf[11], P, 0, 0, 0); } while (0)
#define MD_SMPV(P, VB, VO_A, VO_B, FIRST) do { \
    float pm_ = P[0]; _Pragma("unroll") for (int r = 1; r < 16; ++r) pm_ = fmaxf(pm_, P[r]); \
    if ((FIRST) || !__all(pm_ <= 8.f)) { const float pmx_ = fmaxf(pm_, __shfl_xor(pm_, 32)); const float d_ = (FIRST) ? pmx_ : fmaxf(pmx_, 0.f); \
      if (!(FIRST)) { const float al_ = fexp2(-d_); l *= al_; _Pragma("unroll") for (int nb = 0; nb < 4; ++nb) oT[nb] *= al_; } \
      m += d_; _Pragma("unroll") for (int r = 0; r < 16; ++r) { negm[r] = -m; P[r] -= d_; } } \
    float ps_ = 0.f; _Pragma("unroll") for (int r = 0; r < 16; ++r) { P[r] = fexp2(P[r]); ps_ += P[r]; } l += ps_; \
    const bf16x8 pb0_ = pack8(P, 0), pb1_ = pack8(P, 8); \
    _Pragma("unroll") for (int nb = 0; nb < 4; ++nb) oT[nb] = __builtin_amdgcn_mfma_f32_32x32x16_bf16(*(const bf16x8*)((VB) + nb * 4096 + (VO_A)), pb0_, oT[nb], 0, 0, 0); \
    _Pragma("unroll") for (int nb = 0; nb < 4; ++nb) oT[nb] = __builtin_amdgcn_mfma_f32_32x32x16_bf16(*(const bf16x8*)((VB) + nb * 4096 + (VO_B)), pb1_, oT[nb], 0, 0, 0); } while (0)
  MD_ISSUE(0, 0);
  if (NT > 1) MD_ISSUE(1, 64);
  int st = 0, st2 = 2;
  for (int t = 0; t < NT; ++t) {
    if (t + 1 < NT) asm volatile("s_waitcnt vmcnt(5)" ::: "memory"); else asm volatile("s_waitcnt vmcnt(0)" ::: "memory");
    __builtin_amdgcn_s_barrier();
    if (t + 2 < NT) MD_ISSUE(st2, (t + 2) * 64);
    const char* kb = lds + st * MD_STAGE; const char* vb = kb + MD_K;
    f32x16 pa, pbb;
    MD_QK(pa, kb);
    MD_SMPV(pa, vb, vo0, vo1, t == 0);
    MD_QK(pbb, kb + 32 * 384);
    MD_SMPV(pbb, vb, vo2, vo3, false);
    st = st == 2 ? 0 : st + 1; st2 = st2 == 2 ? 0 : st2 + 1;
  }
#undef MD_DMA
#undef MD_ISSUE
#undef MD_QK
#undef MD_SMPV
  __syncthreads();
  l += __shfl_xor(l, 32);
  const float il = 1.f / l;
  bf16_t* yp = Y + (size_t)(tq0 + 32 * wid + c31) * KP + h * 128;
#pragma unroll
  for (int nb = 0; nb < 4; ++nb)
#pragma unroll
    for (int i4 = 0; i4 < 4; ++i4) { u32x2 w; w[0] = cvtpk(oT[nb][4 * i4] * il, oT[nb][4 * i4 + 1] * il); w[1] = cvtpk(oT[nb][4 * i4 + 2] * il, oT[nb][4 * i4 + 3] * il);
      *(u32x2*)(yp + 32 * nb + 8 * i4 + 4 * hi) = w; }
}

__device__ __forceinline__ void attn_diff_item(PP pp, int l, int b, int h, int tq0, int NT, float lam, float lam_init, char* lds) {
  const bf16_t* Qd = (const bf16_t*)(pp->ws + OFF_QD); const bf16_t* Kd = (const bf16_t*)(pp->ws + OFF_KD);
  const bf16_t* VdT = (const bf16_t*)(pp->ws + OFF_VDT) + (size_t)(b * 4 + h) * 64 * SB; bf16_t* Y = (bf16_t*)(pp->ws + OFF_Y);
  const int tid = get_tid(), lane = tid & 63, wid = tid >> 6, c31 = lane & 31, hi = lane >> 5;
  const int tk0 = b * SB;
  bf16x8 qf[2][2];
  { const bf16_t* qp = Qd + (size_t)(tq0 + 32 * wid + c31) * 256 + h * 64 + hi * 8;
#pragma unroll
    for (int mp = 0; mp < 2; ++mp)
#pragma unroll
      for (int ks = 0; ks < 2; ++ks) qf[mp][ks] = *(const bf16x8*)(qp + mp * 32 + ks * 16); }
  f32x16 oA[2], oB[2];
#pragma unroll
  for (int nb = 0; nb < 2; ++nb)
#pragma unroll
    for (int r = 0; r < 16; ++r) { oA[nb][r] = 0.f; oB[nb][r] = 0.f; }
  float mA = 0.f, mB = 0.f, lA = 0.f, lB = 0.f; f32x16 negA, negB;
#pragma unroll
  for (int r = 0; r < 16; ++r) { negA[r] = 0.f; negB[r] = 0.f; }
  constexpr int DV2S = 272, D2K = 128 * DF_KS, D2STAGE = D2K + 64 * DV2S;
  u32x4 rk, rk2, rv, rv2;
  const int kkey = tid >> 3, kch = tid & 7;
#define D_LOAD(key0) do { const bf16_t* kp_ = Kd + (size_t)(tk0 + (key0) + kkey) * 256 + h * 64 + kch * 8; rk = *(const u32x4*)kp_; rk2 = *(const u32x4*)(kp_ + 64 * 256); \
    const bf16_t* vp_ = VdT + (size_t)kkey * SB + (key0) + kch * 8; rv = *(const u32x4*)vp_; rv2 = *(const u32x4*)(vp_ + 64); } while (0)
#define D_STORE(s) do { char* kb_ = lds + (s) * D2STAGE; char* vb_ = kb_ + D2K; *(u32x4*)(kb_ + kkey * DF_KS + kch * 16) = rk; *(u32x4*)(kb_ + (kkey + 64) * DF_KS + kch * 16) = rk2; \
    *(u32x4*)(vb_ + kkey * DV2S + kch * 16) = rv; *(u32x4*)(vb_ + kkey * DV2S + 128 + kch * 16) = rv2; } while (0)
  const int NT2 = NT >> 1;
  D_LOAD(0); D_STORE(0); __syncthreads();
  for (int t = 0; t < NT2; ++t) {
    const int s = t & 1;
    if (t + 1 < NT2) D_LOAD((t + 1) * 128);
    const char* kb = lds + s * D2STAGE; const char* vb = kb + D2K;
#pragma unroll
    for (int sub = 0; sub < 2; ++sub) {
      const char* ka = kb + (kperm(c31) + 64 * sub) * DF_KS + hi * 16; const char* va = vb + c31 * DV2S + hi * 16 + 128 * sub;
      const bool f0 = (t == 0) && (sub == 0);
      f32x16 pA0 = qk_tile<2>(ka, qf[0], negA);
      f32x16 pB0 = qk_tile<2>(ka + 64, qf[1], negB);
      sm_pv_sv<2, DV2S>(pA0, va, negA, mA, lA, oA, f0);
      f32x16 pA1 = qk_tile<2>(ka + 32 * DF_KS, qf[0], negA);
      sm_pv_sv<2, DV2S>(pB0, va, negB, mB, lB, oB, f0);
      f32x16 pB1 = qk_tile<2>(ka + 32 * DF_KS + 64, qf[1], negB);
      sm_pv_sv<2, DV2S>(pA1, va + 64, negA, mA, lA, oA, false);
      sm_pv_sv<2, DV2S>(pB1, va + 64, negB, mB, lB, oB, false);
    }
    if (t + 1 < NT2) D_STORE(s ^ 1);
    __syncthreads();
  }
#undef D_LOAD
#undef D_STORE
  lA += __shfl_xor(lA, 32); lB += __shfl_xor(lB, 32);
  const float ia = 1.f / lA, ib = lam / lB;
  float ss = 0.f;
#pragma unroll
  for (int nb = 0; nb < 2; ++nb)
#pragma unroll
    for (int r = 0; r < 16; ++r) { const float d = oA[nb][r] * ia - oB[nb][r] * ib; oA[nb][r] = d; ss += d * d; }
  ss += __shfl_xor(ss, 32);
  const float rs = rsqrtf(ss * (1.f / 64.f) + EPS) * (1.f - lam_init);
  const float* g = pp->subln_g + l * 64;
  bf16_t* yp = Y + (size_t)(tq0 + 32 * wid + c31) * KP + 512 + h * 64;
#pragma unroll
  for (int nb = 0; nb < 2; ++nb)
#pragma unroll
    for (int i4 = 0; i4 < 4; ++i4) { const int dv = 32 * nb + 8 * i4 + 4 * hi; const f32x4 gg = *(const f32x4*)(g + dv);
      u32x2 w; w[0] = cvtpk(oA[nb][4 * i4] * rs * gg[0], oA[nb][4 * i4 + 1] * rs * gg[1]); w[1] = cvtpk(oA[nb][4 * i4 + 2] * rs * gg[2], oA[nb][4 * i4 + 3] * rs * gg[3]);
      *(u32x2*)(yp + dv) = w; }
}

__device__ __forceinline__ void phase_attn(PP pp, int l, bool need_ctx, char* lds) {
  const int n_items = 256 + (need_ctx ? 8 : 0);
  for (int it = get_bid(); it < n_items; it += gridDim.x) {
    const int bh = it & 7, b = bh >> 2, h = bh & 3; const bool lat = it < 256;
    attn_mla_item_dma(pp, b, h, lat ? b * SB + CTX + (it >> 3) * 256 : b * SB, lat ? SB / 64 : CTX / 64, lds);
  }
  float d1 = 0.f, d2 = 0.f;
#pragma unroll 1
  for (int i = 0; i < 32; ++i) { d1 += pp->lq1[l * 32 + i] * pp->lk1[l * 32 + i]; d2 += pp->lq2[l * 32 + i] * pp->lk2[l * 32 + i]; }
  const float lam_init = 0.8f - 0.6f * __expf(-0.3f * (float)l);
  const float lam = __expf(d1) - __expf(d2) + lam_init;
  for (int it = get_bid(); it < n_items + 8; it += gridDim.x) {
    if (it >= 256 && it < 264) continue;
    const int bh = it & 7, b = bh >> 2, h = bh & 3; const bool lat = it < 256;
    attn_diff_item(pp, l, b, h, lat ? b * SB + CTX + (it >> 3) * 256 : b * SB, lat ? SB / 64 : CTX / 64, lam, lam_init, lds);
  }
}

__device__ __forceinline__ void phase_res_gemm(PP pp, int l, const bf16_t* A, int K, int ld, const bf16_t* Bt, int gchunk, bool skip_ctx, char* lds) {
  const float* mod = (const float*)(pp->ws + OFF_MOD) + (size_t)l * 3 * 6144;
  const int tid = get_tid(), lane = tid & 63, c31 = lane & 31, hi = lane >> 5;
  float* ut = (float*)lds;
  for (int it0 = get_bid(); it0 < 64 * 4; it0 += gridDim.x) {
    const int it = gridDim.x == 256 ? (((it0 & 7) * 8 + (it0 >> 5)) << 2) + ((it0 >> 3) & 3) : it0;
    const int mi = it >> 2, nt2 = it & 3, mt = (mi >> 5) * 33 + 1 + (mi & 31), row0 = mt * 256, b = mt / 33;
    const float* gv = mod + (size_t)b * 6144 + gchunk * 1024;
    auto post = [&](int h) {
      const int cc = tid & 15, col = nt2 * 256 + h * 128 + cc * 8;
      const f32x4 g0 = *(const f32x4*)(gv + col), g1 = *(const f32x4*)(gv + col + 4);
#pragma unroll 2
      for (int i = 0; i < 8; ++i) {
        const int row = (tid >> 4) + 32 * i; const float* up = ut + row * 128 + cc * 8;
        float* xp = xrow(pp, row0 + row) + col;
        const f32x4 ua = *(const f32x4*)up, ub = *(const f32x4*)(up + 4);
        f32x4 xa = *(const f32x4*)xp, xb = *(const f32x4*)(xp + 4);
        xa = xa * DN_ALPHA + g0 * ua; xb = xb * DN_ALPHA + g1 * ub;
        *(f32x4*)xp = xa; *(f32x4*)(xp + 4) = xb;
      }
    };
    gemm_tile256b(A, ld, RowId{row0}, Bt, ld, nt2 * 256, K, lds, post);
  }
  if (!skip_ctx) {
    const float* gv = mod + (size_t)2 * 6144 + gchunk * 1024;
    const int Kc = K >> 2;
    for (int it = get_bid(); it < 64; it += gridDim.x) {
      const int sp = it & 3, nt = (it >> 2) & 7, row0 = (it >> 5) * 33 * 256;
      auto epi = [&](f32x16 (&acc)[2][2], int rbase, int cbase) {
#pragma unroll
        for (int mb = 0; mb < 2; ++mb)
#pragma unroll
          for (int nb = 0; nb < 2; ++nb) { const int col = cbase + 32 * nb + c31; const float g = gv[col];
#pragma unroll
            for (int r = 0; r < 16; ++r) atomicAdd(xrow(pp, row0 + rbase + 32 * mb + crow(r, hi)) + col, g * acc[mb][nb][r]); }
      };
      gemm_tile(A + sp * Kc, ld, RowId{row0}, Bt + sp * Kc, ld, nt * 128, Kc, lds, epi);
    }
  }
}

__device__ __forceinline__ void phase_ffn_up(PP pp, int l, char* lds) {
  const bf16_t* A = (const bf16_t*)(pp->ws + OFF_HMOD);
  const bf16_t* Bt = (const bf16_t*)(pp->ws + OFF_W) + (size_t)l * W_LAYER + W_UP;
  bf16_t* A2 = (bf16_t*)(pp->ws + OFF_A2);
  const float* cw = pp->ffn_convw + (size_t)l * 3 * 5632; const float* cb = pp->ffn_convb + (size_t)l * 5632;
  const int tid = get_tid(), lane = tid & 63, c31 = lane & 31, hi = lane >> 5;
  float* ut = (float*)lds;
  const bool xmap = gridDim.x == 256; const int xq = get_bid() & 7, xj = get_bid() >> 3;
  const int n_it = xmap ? 6 * 32 : 67 * 22;
  for (int it = xmap ? xj : get_bid(); it < n_it; it += xmap ? 32 : gridDim.x) {
    int mt, nt2;
    if (xmap) { mt = 4 * (it / 11) + (xq >> 1); nt2 = 11 * (xq & 1) + it % 11; if (mt >= 67) continue; }
    else { mt = it / 22; nt2 = it % 22; }
    const int o0 = mt * 254;
    auto post = [&](int h) {
      const int nt = 2 * nt2 + h;
    {
      const int fp = tid & 31, rg = tid >> 5, f = nt * 64 + 2 * fp;
      const int cg = (fp >> 4) * 64 + ((2 * fp) & 31), cv = cg + 32;
      const f32x2 wg0 = *(const f32x2*)(cw + f), wg1 = *(const f32x2*)(cw + 5632 + f), wg2 = *(const f32x2*)(cw + 2 * 5632 + f), bg = *(const f32x2*)(cb + f);
      const f32x2 wv0 = *(const f32x2*)(cw + DFF + f), wv1 = *(const f32x2*)(cw + 5632 + DFF + f), wv2 = *(const f32x2*)(cw + 2 * 5632 + DFF + f), bv = *(const f32x2*)(cb + DFF + f);
      int i0 = rg * 16; int i1 = i0 + 16; if (i0 < 1) i0 = 1; if (i1 > 255) i1 = 255;
      if (i1 > T - (o0 - 1)) i1 = T - (o0 - 1);
      f32x2 gp = *(const f32x2*)(ut + (i0 - 1) * 128 + cg), gc = *(const f32x2*)(ut + i0 * 128 + cg);
      f32x2 vp = *(const f32x2*)(ut + (i0 - 1) * 128 + cv), vc = *(const f32x2*)(ut + i0 * 128 + cv);
      int t = o0 - 1 + i0; int j = t % SB;
      bf16_t* dst = A2 + (size_t)t * DFF + f;
      for (int i = i0; i < i1; ++i) {
        const f32x2 gn = *(const f32x2*)(ut + (i + 1) * 128 + cg), vn = *(const f32x2*)(ut + (i + 1) * 128 + cv);
        f32x2 gate = wg1 * gc + bg, val = wv1 * vc + bv;
        if (j != 0 && j != CTX) { gate += wg0 * gp; val += wv0 * vp; }
        if (j != CTX - 1 && j != SB - 1) { gate += wg2 * gn; val += wv2 * vn; }
        *(unsigned*)dst = cvtpk(silu_f(gate[0]) * val[0], silu_f(gate[1]) * val[1]);
        dst += DFF; j = (j == SB - 1) ? 0 : j + 1;
        gp = gc; gc = gn; vp = vc; vc = vn;
      }
    }
    };
    gemm_tile256b(A, KP, RowHalo{o0 - 1}, Bt, KP, nt2 * 256, DM, lds, post);
  }
}


#define XB_TMO      128
#define XB_XCNT(j)  (256  + 64 * (j))
#define XB_XSUB(j)  (1280 + 64 * (j))
#define XB_XGEN(j)  (2304 + 64 * (j))
#define XB_TOP      3328
#define XB_TOPGEN   3392
#define XCD_BAR_WORDS 3456
#define XB_SPIN_CAP (1u << 18)
#define LAS __attribute__((address_space(3)))

__device__ __forceinline__ unsigned xb_ld(unsigned* p)              { return __hip_atomic_load(p, __ATOMIC_RELAXED, __HIP_MEMORY_SCOPE_AGENT); }
__device__ __forceinline__ unsigned xb_add(unsigned* p, unsigned v) { return __hip_atomic_fetch_add(p, v, __ATOMIC_RELAXED, __HIP_MEMORY_SCOPE_AGENT); }
__device__ __forceinline__ unsigned xb_xcc_id() { return (unsigned)__builtin_amdgcn_s_getreg((3 << 11) | 20) & 0xFu; }
#define XB_SPIN(cond, bar) do { unsigned _sp = 0; while (cond) { __builtin_amdgcn_s_sleep(1); \
    if ((++_sp & 255u) == 0u) { if (xb_ld(&(bar)[XB_TMO])) break; if (_sp > XB_SPIN_CAP) { atomicAdd(&(bar)[XB_TMO], 1u); break; } } } } while (0)

struct XcdBarrier {
    unsigned* bar; unsigned x;
    volatile LAS unsigned* st;
};

__device__ __forceinline__ XcdBarrier xcd_barrier_post(unsigned* bar, volatile LAS unsigned* st) {
    XcdBarrier b; b.bar = bar; b.x = xb_xcc_id(); b.st = st;
    if (get_tid() == 0) (void)xb_add(&bar[XB_XCNT(b.x)], 1u);
    return b;
}
__device__ __forceinline__ void xcd_barrier_complete(unsigned* bar, unsigned x, unsigned& nloc, unsigned& nx) {
    const unsigned G = gridDim.x * gridDim.y * gridDim.z;
    unsigned sum, cnt, mine, sp = 0u;
    for (;;) {
        sum = 0u; cnt = 0u; mine = 0u;
#pragma unroll
        for (unsigned j = 0; j < 16; ++j) { const unsigned c = xb_ld(&bar[XB_XCNT(j)]); sum += c; cnt += (c > 0u) ? 1u : 0u; mine = (j == x) ? c : mine; }
        if (sum == G) break;
        __builtin_amdgcn_s_sleep(1);
        if ((++sp & 255u) == 0u) { if (xb_ld(&bar[XB_TMO])) break; if (sp > XB_SPIN_CAP) { atomicAdd(&bar[XB_TMO], 1u); break; } }
    }
    nloc = mine > 0u ? mine : 1u; nx = cnt > 0u ? cnt : 1u;
}

__device__ __forceinline__ void xcd_barrier(const XcdBarrier& b) {
    asm volatile("s_waitcnt vmcnt(0)" ::: "memory");
    __syncthreads();
    if (get_tid() == 0) {
        unsigned* bar = b.bar;
        __builtin_amdgcn_s_waitcnt(0);
        unsigned nloc = b.st[0], nx = b.st[1];
        if (nloc == 0u) { xcd_barrier_complete(bar, b.x, nloc, nx); b.st[0] = nloc; b.st[1] = nx; }
        const unsigned old = xb_add(&bar[XB_XSUB(b.x)], 1u);
        const unsigned gen = old / nloc;
        if (old + 1u == (gen + 1u) * nloc) {
            __builtin_amdgcn_fence(__ATOMIC_RELEASE, "agent");
            asm volatile("s_waitcnt vmcnt(0)" ::: "memory");
            const unsigned og = xb_add(&bar[XB_TOP], 1u);
            const unsigned tg = og / nx;
            if (og + 1u == (tg + 1u) * nx) xb_add(&bar[XB_TOPGEN], 1u);
            else XB_SPIN(xb_ld(&bar[XB_TOPGEN]) == tg, bar);
            __builtin_amdgcn_fence(__ATOMIC_ACQUIRE, "agent");
            xb_add(&bar[XB_XGEN(b.x)], 1u);
            asm volatile("s_waitcnt vmcnt(0)" ::: "memory");
        } else {
            XB_SPIN(xb_ld(&bar[XB_XGEN(b.x)]) == gen, bar);
            __builtin_amdgcn_fence(__ATOMIC_ACQUIRE, "agent");
            asm volatile("s_waitcnt vmcnt(0)" ::: "memory");
        }
    }
    __syncthreads();
}

constexpr size_t OFF_BAR = OFF_END;
constexpr int LDS_XB = 3 * 49152 + 1024;
__device__ __forceinline__ void grid_bar(PP pp, char* lds) {
  XcdBarrier b; b.bar = (unsigned*)(pp->ws + OFF_BAR); b.x = xb_xcc_id(); b.st = (volatile LAS unsigned*)(lds + LDS_XB);
  xcd_barrier(b);
}
__global__ void __launch_bounds__(512) fwd_megakernel(Params p_arg) {
  extern __shared__ __attribute__((aligned(16))) char lds[];
  cg::grid_group grid = cg::this_grid();
  PP pp = (PP)__builtin_amdgcn_kernarg_segment_ptr();
  { const int t0_ = get_tid(); if (t0_ < 4) ((volatile LAS unsigned*)(lds + LDS_XB))[t0_] = 0u; }
  __syncthreads();
  (void)xcd_barrier_post((unsigned*)(pp->ws + OFF_BAR), (volatile LAS unsigned*)(lds + LDS_XB));
  grid.sync();
  phase0(launder(pp), lds);
  grid_bar(launder(pp), lds);
  row_pass(launder(pp), 0, nullptr, nullptr, 0, 0, 1, true, false, NLAYER > 1);
  grid_bar(launder(pp), lds);
#pragma unroll 1
  for (int l = 0; l < NLAYER; ++l) {
    const bool last = (l == NLAYER - 1);
    const bf16_t* wl = (const bf16_t*)(pp->ws + OFF_W) + (size_t)l * W_LAYER;
    phase_win(launder(pp), l, lds);
    grid_bar(launder(pp), lds);
    phase_up2(launder(pp), l, lds);
    grid_bar(launder(pp), lds);
    phase_attn(launder(pp), l, !last, lds);
    grid_bar(launder(pp), lds);
    phase_res_gemm(launder(pp), l, (const bf16_t*)(pp->ws + OFF_Y), 1024, KP, wl + W_O, 2, last, lds);
    grid_bar(launder(pp), lds);
    row_pass(launder(pp), 1, pp->ln1_g + l * DM, pp->ln1_b + l * DM, l, 3, 4, true, last, !last);
    grid_bar(launder(pp), lds);
    phase_ffn_up(launder(pp), l, lds);
    grid_bar(launder(pp), lds);
    phase_res_gemm(launder(pp), l, (const bf16_t*)(pp->ws + OFF_A2), DFF, DFF, wl + W_DN, 5, last, lds);
    grid_bar(launder(pp), lds);
    row_pass(launder(pp), 1, pp->ln2_g + l * DM, pp->ln2_b + l * DM, l + 1, 0, 1, !last, last, l + 2 < NLAYER);
    if (!last) grid_bar(launder(pp), lds);
  }
}

extern "C" void kernel_launch(void* const* d_in, const int* in_sizes, int n_in, void* d_out, int out_size, void* d_ws, size_t ws_size, hipStream_t stream) {
  static int grid_blocks = 0;
  if (!grid_blocks) {
    int dev = 0, cus = 0, per_cu = 0;
    hipGetDevice(&dev);
    hipDeviceGetAttribute(&cus, hipDeviceAttributeMultiprocessorCount, dev);
    hipFuncSetAttribute((const void*)fwd_megakernel, hipFuncAttributeMaxDynamicSharedMemorySize, LDS_BYTES);
    hipOccupancyMaxActiveBlocksPerMultiprocessor(&per_cu, fwd_megakernel, 512, LDS_BYTES);
    if (per_cu < 1) { fprintf(stderr, "occupancy query returned %d\n", per_cu); per_cu = 1; }
    if (per_cu > 1) per_cu = 1;
    grid_blocks = cus * per_cu;
  }
  Params p{};
  const float** f = (const float**)&p;
  for (int i = 0; i < 29; ++i) f[i] = (const float*)d_in[i];
  p.out = (float*)d_out; p.ws = (char*)d_ws;
  (void)hipMemsetAsync((char*)d_ws + OFF_BAR, 0, XCD_BAR_WORDS * sizeof(unsigned), stream);
  void* args[] = {&p};
  hipError_t e = hipLaunchCooperativeKernel((void*)fwd_megakernel, dim3(grid_blocks), dim3(512), args, LDS_BYTES, stream);
  if (e != hipSuccess) fprintf(stderr, "cooperative launch failed: %s (grid %d)\n", hipGetErrorString(e), grid_blocks);
}
```

```cpp
#include <hip/hip_runtime.h>
#include <hip/hip_cooperative_groups.h>
#include <stdint.h>
#include <cstdio>
namespace cg = cooperative_groups;

typedef unsigned short bf16_t;
typedef short bf16x8 __attribute__((ext_vector_type(8)));
typedef float f32x16 __attribute__((ext_vector_type(16)));
typedef float f32x4 __attribute__((ext_vector_type(4)));
typedef float f32x2 __attribute__((ext_vector_type(2)));
typedef unsigned u32x4 __attribute__((ext_vector_type(4)));
typedef unsigned u32x2 __attribute__((ext_vector_type(2)));

constexpr int DM = 1024, NBATCH = 2, SEQ = 8192, CTX = 256, SB = SEQ + CTX  , T = NBATCH * SB  ;
constexpr int INW = 1984, DFF = 2816, NLAYER = 2;
constexpr int KP = 1088;
constexpr float EPS = 1e-6f;
constexpr float DN_ALPHA = 1.4142135623730951f;
constexpr float LOG2E = 1.4426950408889634f;
constexpr float QS_MLA = 0.07216878364870322f * LOG2E;
constexpr float QS_DIFF = 0.17677669529663687f * LOG2E;

constexpr size_t al256(size_t x) { return (x + 255) / 256 * 256; }
constexpr size_t W_IN = 0;
constexpr size_t W_UQ = W_IN + 2048ull * KP;
constexpr size_t W_UKV = W_UQ + 768ull * 384;
constexpr size_t W_O = W_UKV + 1024ull * 256;
constexpr size_t W_UP = W_O + 1024ull * KP;
constexpr size_t W_DN = W_UP + 5632ull * KP;
constexpr size_t W_SG = W_DN + 1024ull * 2816;
constexpr size_t W_LAYER = W_SG + 4ull * 128 * 128;
constexpr size_t OFF_W = 0;
constexpr size_t OFF_MOD = al256(OFF_W + W_LAYER * 2 * NLAYER);
constexpr size_t OFF_CS16 = al256(OFF_MOD + 2ull * 3 * 6144 * 4);
constexpr size_t OFF_CS8 = al256(OFF_CS16 + 128ull * 16 * 8);
constexpr size_t OFF_CTXRES = al256(OFF_CS8 + 128ull * 8 * 8);
constexpr size_t OFF_HMOD = al256(OFF_CTXRES + 512ull * 1024 * 4);
constexpr size_t OFF_R = al256(OFF_HMOD + (size_t)T * KP * 2);
constexpr size_t OFF_ZQ = OFF_R;
constexpr size_t OFF_KR = al256(OFF_ZQ + (size_t)T * 640 * 2);
constexpr size_t OFF_QD = al256(OFF_KR + (size_t)T * 64 * 2);
constexpr size_t OFF_KD = al256(OFF_QD + (size_t)T * 256 * 2);
constexpr size_t OFF_VDT = al256(OFF_KD + (size_t)T * 256 * 2);
constexpr size_t OFF_ZC = al256(OFF_VDT + (size_t)T * 256 * 2);
constexpr size_t OFF_QM = al256(OFF_ZC + (size_t)T * 512 * 2);
constexpr size_t OFF_KM = al256(OFF_QM + (size_t)T * 768 * 2);
constexpr size_t OFF_VMT = al256(OFF_KM + (size_t)T * 512 * 2);
constexpr size_t OFF_Y = al256(OFF_VMT + (size_t)T * 512 * 2);
constexpr size_t OFF_END = al256(OFF_Y + (size_t)T * KP * 2);
constexpr size_t OFF_A2 = OFF_R;
static_assert(OFF_A2 + (size_t)T * 2816 * 2 <= OFF_END, "A2 alias fits");
constexpr size_t OFF_SSQ = OFF_END + 16384;
static_assert(OFF_SSQ + (size_t)T * 8 <= 268435456ull, "workspace fits 256 MiB");

constexpr int LDS_A_STAGE = 256 * 144, LDS_B_STAGE = 128 * 144;
constexpr int LDS_GEMM = 2 * (LDS_A_STAGE + LDS_B_STAGE);
constexpr int LDS_RSTD = 3 * 49152;
constexpr int LDS_BYTES = 3 * 49152 + 1024 + 16;

struct Params {
  const float *x, *c, *ctx, *c_ctx, *ada_w, *ada_b, *w_in, *mla_gq, *mla_wuq, *mla_gkv, *mla_wukv;
  const float *lq1, *lk1, *lq2, *lk2, *subln_g, *sgu_ln_g, *sgu_ln_b, *sgu_ws, *sgu_bs, *w_o, *ln1_g, *ln1_b;
  const float *ffn_wup, *ffn_convw, *ffn_convb, *ffn_wdown, *ln2_g, *ln2_b;
  float* out; char* ws;
};
typedef const __attribute__((address_space(4))) Params* PP;
__device__ __forceinline__ PP launder(PP q) { asm volatile("" : "+s"(q)); return q; }

__device__ __forceinline__ int get_tid() { int t = threadIdx.x; asm volatile("" : "+v"(t)); return t; }
__device__ __forceinline__ int get_bid() { int t = blockIdx.x; asm volatile("" : "+s"(t)); return t; }
typedef __bf16 bf16x2_t __attribute__((ext_vector_type(2)));
__device__ __forceinline__ unsigned cvtpk(float lo, float hi) { f32x2 v = {lo, hi}; bf16x2_t b = __builtin_convertvector(v, bf16x2_t); return __builtin_bit_cast(unsigned, b); }
__device__ __forceinline__ bf16_t f2bf(float x) { return (bf16_t)(cvtpk(x, 0.f) & 0xffffu); }
__device__ __forceinline__ float bf2f(bf16_t v) { return __uint_as_float(((unsigned)v) << 16); }
__device__ __forceinline__ float bflo(unsigned w) { return __uint_as_float(w << 16); }
__device__ __forceinline__ float bfhi(unsigned w) { return __uint_as_float(w & 0xffff0000u); }
__device__ __forceinline__ int crow(int r, int hi) { return (r & 3) + 8 * (r >> 2) + 4 * hi; }
__device__ __forceinline__ float fexp2(float x) { return __builtin_amdgcn_exp2f(x); }
__device__ __forceinline__ float silu_f(float x) { return x * __builtin_amdgcn_rcpf(1.f + __expf(-x)); }
__device__ __forceinline__ float gelu_tanh(float x) {
  const float u = 0.7978845608028654f * (x + 0.044715f * x * x * x);
  return x * __builtin_amdgcn_rcpf(1.f + __expf(-2.f * u));
}
__device__ __forceinline__ float* xrow(PP pp, int t) {
  const int b = t / SB, j = t - b * SB;
  return j < CTX ? (float*)(pp->ws + OFF_CTXRES) + (size_t)(b * CTX + j) * DM : pp->out + (size_t)(b * SEQ + j - CTX) * DM;
}

constexpr int G_STAGE = 256 * 128 + 128 * 128;
template <class RowMap, class Epi>
__device__ __forceinline__ void gemm_tile(const bf16_t* __restrict__ A, int lda, RowMap rowmap, const bf16_t* __restrict__ Bt, int ldb, int col0, int K,
                                          char* lds, Epi epi) {
  const int tid = get_tid(), lane = tid & 63, wid = tid >> 6, wm = wid >> 1, wn = wid & 1, l31 = lane & 31, hi = lane >> 5;
  const int lr = tid >> 3, lc = tid & 7, kc = lc ^ ((lr >> 1) & 7);
  const bf16_t* ap0 = A + (size_t)rowmap(lr) * lda + kc * 8;
  const bf16_t* ap1 = A + (size_t)rowmap(lr + 64) * lda + kc * 8;
  const bf16_t* ap2 = A + (size_t)rowmap(lr + 128) * lda + kc * 8;
  const bf16_t* ap3 = A + (size_t)rowmap(lr + 192) * lda + kc * 8;
  const bf16_t* bp0 = Bt + (size_t)(col0 + lr) * ldb + kc * 8;
  const bf16_t* bp1 = Bt + (size_t)(col0 + lr + 64) * ldb + kc * 8;
  f32x16 acc[2][2];
#pragma unroll
  for (int i = 0; i < 2; ++i)
#pragma unroll
    for (int j = 0; j < 2; ++j)
#pragma unroll
      for (int r = 0; r < 16; ++r) acc[i][j][r] = 0.f;
#define G_DMA(gp, lp) __builtin_amdgcn_global_load_lds((const unsigned*)(gp), (__attribute__((address_space(3))) unsigned*)(lp), 16, 0, 0)
#define G_ISSUE(st, k0) do { char* sa_ = lds + (st) * G_STAGE + tid * 16; \
    G_DMA(ap0 + (k0), sa_); G_DMA(ap1 + (k0), sa_ + 8192); G_DMA(ap2 + (k0), sa_ + 16384); G_DMA(ap3 + (k0), sa_ + 24576); \
    G_DMA(bp0 + (k0), sa_ + 32768); G_DMA(bp1 + (k0), sa_ + 40960); } while (0)
  const int fsw = (l31 >> 1) & 7, g = fsw >> 1, c0 = l31 * 128 + ((hi ^ (fsw & 1)) << 4);
  const int o0 = c0 + ((0 ^ g) << 5), o1 = c0 + ((1 ^ g) << 5), o2 = c0 + ((2 ^ g) << 5), o3 = c0 + ((3 ^ g) << 5);
  const int abase = (64 * wm) * 128, bbase = 32768 + (64 * wn) * 128;
#define G_FRAG(O, A0, A1, B0, B1) do { A0 = *(const bf16x8*)(cS + abase + (O)); B0 = *(const bf16x8*)(cS + bbase + (O)); \
    A1 = *(const bf16x8*)(cS + abase + 4096 + (O)); B1 = *(const bf16x8*)(cS + bbase + 4096 + (O)); } while (0)
#define G_MMA(A0, A1, B0, B1) do { \
    acc[0][0] = __builtin_amdgcn_mfma_f32_32x32x16_bf16(A0, B0, acc[0][0], 0, 0, 0); \
    acc[0][1] = __builtin_amdgcn_mfma_f32_32x32x16_bf16(A0, B1, acc[0][1], 0, 0, 0); \
    acc[1][0] = __builtin_amdgcn_mfma_f32_32x32x16_bf16(A1, B0, acc[1][0], 0, 0, 0); \
    acc[1][1] = __builtin_amdgcn_mfma_f32_32x32x16_bf16(A1, B1, acc[1][1], 0, 0, 0); } while (0)
  const int nk = K >> 6;
  G_ISSUE(0, 0);
  if (nk > 1) G_ISSUE(1, 64);
  int st = 0, st2 = 2;
  for (int kt = 0; kt < nk; ++kt) {
    if (kt + 1 < nk) asm volatile("s_waitcnt vmcnt(6)" ::: "memory"); else asm volatile("s_waitcnt vmcnt(0)" ::: "memory");
    __builtin_amdgcn_s_barrier();
    if (kt + 2 < nk) G_ISSUE(st2, (kt + 2) * 64);
    const char* cS = lds + st * G_STAGE;
    bf16x8 pa0, pa1, pb0, pb1, qa0, qa1, qb0, qb1, ra0_, ra1_, rb0_, rb1_;
    G_FRAG(o0, pa0, pa1, pb0, pb1); G_FRAG(o1, qa0, qa1, qb0, qb1); __builtin_amdgcn_sched_barrier(0);
    G_MMA(pa0, pa1, pb0, pb1); G_FRAG(o2, ra0_, ra1_, rb0_, rb1_); __builtin_amdgcn_sched_barrier(0);
    G_MMA(qa0, qa1, qb0, qb1); G_FRAG(o3, pa0, pa1, pb0, pb1); __builtin_amdgcn_sched_barrier(0);
    G_MMA(ra0_, ra1_, rb0_, rb1_); G_MMA(pa0, pa1, pb0, pb1);
    st = st == 2 ? 0 : st + 1; st2 = st2 == 2 ? 0 : st2 + 1;
  }
#undef G_DMA
#undef G_ISSUE
#undef G_FRAG
#undef G_MMA
  __syncthreads();
  epi(acc, 64 * wm, col0 + 64 * wn);
}

template <class RowMap, class Post>
__device__ __forceinline__ void gemm_tile256b(const bf16_t* __restrict__ A, int lda, RowMap rowmap, const bf16_t* __restrict__ Bt, int ldb, int col0, int K,
                                             char* lds, Post post) {
  const int tid = get_tid(), lane = tid & 63, wid = tid >> 6, wm = wid >> 1, wn = wid & 1, l31 = lane & 31, hi = lane >> 5;
  const int lr = tid >> 3, lc = tid & 7, kc = lc ^ ((lr >> 1) & 7);
  const bf16_t* ap0 = A + (size_t)rowmap(lr) * lda + kc * 8;
  const bf16_t* ap1 = A + (size_t)rowmap(lr + 64) * lda + kc * 8;
  const bf16_t* ap2 = A + (size_t)rowmap(lr + 128) * lda + kc * 8;
  const bf16_t* ap3 = A + (size_t)rowmap(lr + 192) * lda + kc * 8;
  const bf16_t* bp0 = Bt + (size_t)(col0 + lr) * ldb + kc * 8;
  const size_t bstep = (size_t)64 * ldb;
  const int l15 = lane & 15, q4 = lane >> 4;
  f32x4 acc[4][8];
#pragma unroll
  for (int i = 0; i < 4; ++i)
#pragma unroll
    for (int j = 0; j < 8; ++j) { acc[i][j][0] = 0.f; acc[i][j][1] = 0.f; acc[i][j][2] = 0.f; acc[i][j][3] = 0.f; }
#define H_DMA(gp, lp) __builtin_amdgcn_global_load_lds((const unsigned*)(gp), (__attribute__((address_space(3))) unsigned*)(lp), 16, 0, 0)
#define H_ISSUE(st, k0) do { char* sa_ = lds + (st) * 65536 + tid * 16; \
    H_DMA(ap0 + (k0), sa_); H_DMA(ap1 + (k0), sa_ + 8192); H_DMA(ap2 + (k0), sa_ + 16384); H_DMA(ap3 + (k0), sa_ + 24576); \
    H_DMA(bp0 + (k0), sa_ + 32768); H_DMA(bp0 + bstep + (k0), sa_ + 40960); H_DMA(bp0 + 2 * bstep + (k0), sa_ + 49152); H_DMA(bp0 + 3 * bstep + (k0), sa_ + 57344); } while (0)
  const int fsw = l15 >> 1, c0 = l15 * 128;
  const int ok0 = c0 + (((0 + q4) ^ fsw) << 4), ok1 = c0 + (((4 + q4) ^ fsw) << 4);
  const int abase = (64 * wm) * 128, bbase = 32768 + (128 * wn) * 128;
#define H_FA(O, F) do { F[0] = *(const bf16x8*)(cS + abase + (O)); F[1] = *(const bf16x8*)(cS + abase + 2048 + (O)); \
    F[2] = *(const bf16x8*)(cS + abase + 4096 + (O)); F[3] = *(const bf16x8*)(cS + abase + 6144 + (O)); } while (0)
#define H_FB(O, NH, F) do { F[0] = *(const bf16x8*)(cS + bbase + (NH) * 8192 + (O)); F[1] = *(const bf16x8*)(cS + bbase + (NH) * 8192 + 2048 + (O)); \
    F[2] = *(const bf16x8*)(cS + bbase + (NH) * 8192 + 4096 + (O)); F[3] = *(const bf16x8*)(cS + bbase + (NH) * 8192 + 6144 + (O)); } while (0)
#define H_MMA(FA, FB, NH) do { _Pragma("unroll") for (int mi_ = 0; mi_ < 4; ++mi_) { _Pragma("unroll") for (int nj_ = 0; nj_ < 4; ++nj_) \
    acc[mi_][(NH) * 4 + nj_] = __builtin_amdgcn_mfma_f32_16x16x32_bf16(FA[mi_], FB[nj_], acc[mi_][(NH) * 4 + nj_], 0, 0, 0); } } while (0)
  const int nk = K >> 6;
  H_ISSUE(0, 0);
  for (int kt = 0; kt < nk; ++kt) {
    asm volatile("s_waitcnt vmcnt(0)" ::: "memory");
    __builtin_amdgcn_s_barrier();
    if (kt + 1 < nk) H_ISSUE((kt + 1) & 1, (kt + 1) * 64);
    const char* cS = lds + (kt & 1) * 65536;
    bf16x8 fa0[4], fb0[4];
    H_FA(ok0, fa0); H_FB(ok0, 0, fb0); __builtin_amdgcn_sched_barrier(0);
    H_MMA(fa0, fb0, 0); __builtin_amdgcn_sched_barrier(0);
    H_FB(ok0, 1, fb0); __builtin_amdgcn_sched_barrier(0);
    H_MMA(fa0, fb0, 1); __builtin_amdgcn_sched_barrier(0);
    H_FA(ok1, fa0); H_FB(ok1, 0, fb0); __builtin_amdgcn_sched_barrier(0);
    H_MMA(fa0, fb0, 0); __builtin_amdgcn_sched_barrier(0);
    H_FB(ok1, 1, fb0); __builtin_amdgcn_sched_barrier(0);
    H_MMA(fa0, fb0, 1);
  }
#undef H_DMA
#undef H_ISSUE
#undef H_FA
#undef H_FB
#undef H_MMA
  float* ut = (float*)lds;
#pragma unroll
  for (int h = 0; h < 2; ++h) {
    __syncthreads();
    if (wn == h) {
#pragma unroll
      for (int mi = 0; mi < 4; ++mi)
#pragma unroll
        for (int ni = 0; ni < 8; ++ni)
#pragma unroll
          for (int r = 0; r < 4; ++r) ut[(64 * wm + 16 * mi + 4 * q4 + r) * 128 + 16 * ni + l15] = acc[mi][ni][r];
    }
    __syncthreads();
    post(h);
  }
  __syncthreads();
}

template <class RowMap, class Post>
__device__ __forceinline__ void gemm_tile256(const bf16_t* __restrict__ A, int lda, RowMap rowmap, const bf16_t* __restrict__ Bt, int ldb, int col0, int K,
                                             char* lds, Post post) {
  const int tid = get_tid(), lane = tid & 63, wid = tid >> 6, wm = wid >> 1, wn = wid & 1, l31 = lane & 31, hi = lane >> 5;
  const int lr = tid >> 3, lc = tid & 7, kc = lc ^ ((lr >> 1) & 7);
  const bf16_t* ap0 = A + (size_t)rowmap(lr) * lda + kc * 8;
  const bf16_t* ap1 = A + (size_t)rowmap(lr + 64) * lda + kc * 8;
  const bf16_t* ap2 = A + (size_t)rowmap(lr + 128) * lda + kc * 8;
  const bf16_t* ap3 = A + (size_t)rowmap(lr + 192) * lda + kc * 8;
  const bf16_t* bp0 = Bt + (size_t)(col0 + lr) * ldb + kc * 8;
  const size_t bstep = (size_t)64 * ldb;
  f32x16 acc[2][4];
#pragma unroll
  for (int i = 0; i < 2; ++i)
#pragma unroll
    for (int j = 0; j < 4; ++j)
#pragma unroll
      for (int r = 0; r < 16; ++r) acc[i][j][r] = 0.f;
#define H_DMA(gp, lp) __builtin_amdgcn_global_load_lds((const unsigned*)(gp), (__attribute__((address_space(3))) unsigned*)(lp), 16, 0, 0)
#define H_ISSUE(st, k0) do { char* sa_ = lds + (st) * 65536 + tid * 16; \
    H_DMA(ap0 + (k0), sa_); H_DMA(ap1 + (k0), sa_ + 8192); H_DMA(ap2 + (k0), sa_ + 16384); H_DMA(ap3 + (k0), sa_ + 24576); \
    H_DMA(bp0 + (k0), sa_ + 32768); H_DMA(bp0 + bstep + (k0), sa_ + 40960); H_DMA(bp0 + 2 * bstep + (k0), sa_ + 49152); H_DMA(bp0 + 3 * bstep + (k0), sa_ + 57344); } while (0)
  const int fsw = (l31 >> 1) & 7, g = fsw >> 1, c0 = l31 * 128 + ((hi ^ (fsw & 1)) << 4);
  const int o0 = c0 + ((0 ^ g) << 5), o1 = c0 + ((1 ^ g) << 5), o2 = c0 + ((2 ^ g) << 5), o3 = c0 + ((3 ^ g) << 5);
  const int abase = (64 * wm) * 128, bbase = 32768 + (128 * wn) * 128;
#define H_FRAG(O, F) do { F[0] = *(const bf16x8*)(cS + abase + (O)); F[1] = *(const bf16x8*)(cS + abase + 4096 + (O)); \
    F[2] = *(const bf16x8*)(cS + bbase + (O)); F[3] = *(const bf16x8*)(cS + bbase + 4096 + (O)); \
    F[4] = *(const bf16x8*)(cS + bbase + 8192 + (O)); F[5] = *(const bf16x8*)(cS + bbase + 12288 + (O)); } while (0)
#define H_MMA(F) do { _Pragma("unroll") for (int nb_ = 0; nb_ < 4; ++nb_) { \
    acc[0][nb_] = __builtin_amdgcn_mfma_f32_32x32x16_bf16(F[0], F[2 + nb_], acc[0][nb_], 0, 0, 0); \
    acc[1][nb_] = __builtin_amdgcn_mfma_f32_32x32x16_bf16(F[1], F[2 + nb_], acc[1][nb_], 0, 0, 0); } } while (0)
  const int nk = K >> 6;
  H_ISSUE(0, 0);
  for (int kt = 0; kt < nk; ++kt) {
    asm volatile("s_waitcnt vmcnt(0)" ::: "memory");
    __builtin_amdgcn_s_barrier();
    if (kt + 1 < nk) H_ISSUE((kt + 1) & 1, (kt + 1) * 64);
    const char* cS = lds + (kt & 1) * 65536;
    bf16x8 f0[6], f1[6];
    H_FRAG(o0, f0); H_FRAG(o1, f1); __builtin_amdgcn_sched_barrier(0);
    H_MMA(f0); H_FRAG(o2, f0); __builtin_amdgcn_sched_barrier(0);
    H_MMA(f1); H_FRAG(o3, f1); __builtin_amdgcn_sched_barrier(0);
    H_MMA(f0); H_MMA(f1);
  }
#undef H_DMA
#undef H_ISSUE
#undef H_FRAG
#undef H_MMA
  float* ut = (float*)lds;
#pragma unroll
  for (int h = 0; h < 2; ++h) {
    __syncthreads();
    if (wn == h) {
#pragma unroll
      for (int mb = 0; mb < 2; ++mb)
#pragma unroll
        for (int nb = 0; nb < 4; ++nb)
#pragma unroll
          for (int r = 0; r < 16; ++r) ut[(64 * wm + 32 * mb + crow(r, hi)) * 128 + 32 * nb + l31] = acc[mb][nb][r];
    }
    __syncthreads();
    post(h);
  }
  __syncthreads();
}

struct RowId { int r0; __device__ __forceinline__ int operator()(int i) const { return r0 + i; } };
struct RowHalo { int r0; __device__ __forceinline__ int operator()(int i) const { int r = r0 + i; r = r < 0 ? 0 : r; return r > T - 1 ? T - 1 : r; } };

__device__ __forceinline__ void transpose_item(const float* __restrict__ src, int ldsrc, int K  , bf16_t* __restrict__ dst, int kt, int ntile, int mode,
                               const float* __restrict__ kscale, float* tile) {
  const int tid = get_tid(), k0 = kt * 64, n0 = ntile * 64;
#pragma unroll
  for (int i = 0; i < 2; ++i) {
    const int kk = (tid >> 4) + 32 * i, n4 = (tid & 15) * 4, nn = n0 + n4;
    const int sc = mode == 1 ? (((nn & 63) < 32) ? (nn >> 6) * 32 + (nn & 31) : DFF + (nn >> 6) * 32 + (nn & 31)) : nn;
    f32x4 v = *(const f32x4*)(src + (size_t)(k0 + kk) * ldsrc + sc);
    if (kscale) { const float g = kscale[k0 + kk]; v *= g; }
    float* tp = tile + kk * 65 + n4; tp[0] = v[0]; tp[1] = v[1]; tp[2] = v[2]; tp[3] = v[3];
  }
  __syncthreads();
  {
    const int n = tid >> 3, kc = tid & 7; const float* tp = tile + (kc * 8) * 65 + n;
    u32x4 w; w[0] = cvtpk(tp[0], tp[65]); w[1] = cvtpk(tp[130], tp[195]); w[2] = cvtpk(tp[260], tp[325]); w[3] = cvtpk(tp[390], tp[455]);
    *(u32x4*)(dst + (size_t)(n0 + n) * K + k0 + kc * 8) = w;
  }
  __syncthreads();
}

__device__ __forceinline__ void phase0(PP pp, char* lds) {
  const int tid = get_tid();
  float* svec = (float*)lds; float* red = (float*)(lds + 12288); float* tile = (float*)(lds + 20480);
  for (int i = tid; i < 3072; i += 512) { const int v = i >> 10, k = i & 1023; const float val = v < 2 ? pp->c[v * 1024 + k] : pp->c_ctx[k]; svec[i] = silu_f(val); }
  __syncthreads();
  constexpr int N_ADA = 192, N_ROPE = 1, N_TR = 3000, N_SG = 16, PER_L = N_TR + N_SG;
  constexpr int N_ITEMS = N_ADA + N_ROPE + NLAYER * PER_L;
  for (int it = get_bid(); it < N_ITEMS; it += gridDim.x) {
    if (it < N_ADA) {
      const int l = it / 96, c0 = (it % 96) * 64, col = tid & 63, kg = tid >> 6;
      const float* wp = pp->ada_w + ((size_t)l * 1024 + kg * 128) * 6144 + c0 + col;
      float a0 = 0.f, a1 = 0.f, a2 = 0.f;
#pragma unroll 8
      for (int k = 0; k < 128; ++k) { const float w = wp[(size_t)k * 6144]; const int kk = kg * 128 + k; a0 += svec[kk] * w; a1 += svec[1024 + kk] * w; a2 += svec[2048 + kk] * w; }
      red[(kg * 3 + 0) * 64 + col] = a0; red[(kg * 3 + 1) * 64 + col] = a1; red[(kg * 3 + 2) * 64 + col] = a2;
      __syncthreads();
      if (tid < 192) { const int v = tid >> 6; float s = 0.f;
#pragma unroll
        for (int g = 0; g < 8; ++g) s += red[(g * 3 + v) * 64 + col];
        ((float*)(pp->ws + OFF_MOD))[(size_t)(l * 3 + v) * 6144 + c0 + col] = s + pp->ada_b[l * 6144 + c0 + col]; }
      __syncthreads();
    } else if (it < N_ADA + N_ROPE) {
      for (int e = tid; e < 128 * 24; e += 512) {
        const int pos = e / 24, i = e % 24; const bool big = i < 16; const int ii = big ? i : i - 16;
        const float inv = exp2f(-(float)ii / (big ? 16.f : 8.f) * 13.287712379549449f);
        const float ang = (float)pos * inv;
        const double a = (double)ang; const double n = rint(a * 0.15915494309189535); const float y = (float)(a - n * 6.283185307179586);
        f32x2 cs; cs[0] = cosf(y); cs[1] = sinf(y);
        if (big) ((f32x2*)(pp->ws + OFF_CS16))[pos * 16 + ii] = cs; else ((f32x2*)(pp->ws + OFF_CS8))[pos * 8 + ii] = cs;
      }
    } else {
      const int q = it - N_ADA - N_ROPE, l = q / PER_L; int t = q % PER_L;
      bf16_t* wl = (bf16_t*)(pp->ws + OFF_W) + (size_t)l * W_LAYER;
      if (t < 496) transpose_item(pp->w_in + (size_t)l * 1024 * INW, INW, KP, wl + W_IN, t % 16, t / 16, 0, nullptr, tile);
      else if (t < 568) { t -= 496; transpose_item(pp->mla_wuq + (size_t)l * 384 * 768, 768, 384, wl + W_UQ, t % 6, t / 6, 0, pp->mla_gq + l * 384, tile); }
      else if (t < 632) { t -= 568; transpose_item(pp->mla_wukv + (size_t)l * 256 * 1024, 1024, 256, wl + W_UKV, t % 4, t / 4, 0, pp->mla_gkv + l * 256, tile); }
      else if (t < 888) { t -= 632; transpose_item(pp->w_o + (size_t)l * 1024 * 1024, 1024, KP, wl + W_O, t % 16, t / 16, 0, nullptr, tile); }
      else if (t < 2296) { t -= 888; transpose_item(pp->ffn_wup + (size_t)l * 1024 * 5632, 5632, KP, wl + W_UP, t % 16, t / 16, 1, nullptr, tile); }
      else if (t < 3000) { t -= 2296; transpose_item(pp->ffn_wdown + (size_t)l * DFF * 1024, 1024, DFF, wl + W_DN, t % 44, t / 44, 0, nullptr, tile); }
      else { t -= 3000; const size_t idx = (size_t)t * 4096 + tid * 8; const float* s = pp->sgu_ws + (size_t)l * 65536 + idx;
        const f32x4 v0 = *(const f32x4*)s, v1 = *(const f32x4*)(s + 4);
        u32x4 w; w[0] = cvtpk(v0[0], v0[1]); w[1] = cvtpk(v0[2], v0[3]); w[2] = cvtpk(v1[0], v1[1]); w[3] = cvtpk(v1[2], v1[3]);
        *(u32x4*)(wl + W_SG + idx) = w; }
    }
  }
}

__device__ __forceinline__ void row_pass(PP pp, int mode, const float* __restrict__ lg, const float* __restrict__ lb, int lm, int shc, int scc, bool want_h, bool skip_ctx, bool alpha_ctx) {
  const int lane = get_tid() & 63, wid = get_tid() >> 6;
  const float* mod = (const float*)(pp->ws + OFF_MOD) + (size_t)lm * 3 * 6144;
  bf16_t* hmod = (bf16_t*)(pp->ws + OFF_HMOD);
  for (int t = get_bid() * 8 + wid; t < T; t += gridDim.x * 8) {
    const int b = t / SB, j = t - b * SB; const bool isctx = j < CTX;
    if (isctx && skip_ctx) continue;
    float* xr = xrow(pp, t);
    const float* src = mode == 0 ? (isctx ? pp->ctx + (size_t)(b * CTX + j) * DM : pp->x + (size_t)(b * SEQ + j - CTX) * DM) : xr;
    f32x4 v[4];
#pragma unroll
    for (int i = 0; i < 4; ++i) v[i] = *(const f32x4*)(src + (i * 64 + lane) * 4);
    if (mode == 1) {
      float s = 0.f;
#pragma unroll
      for (int i = 0; i < 4; ++i) s += (v[i][0] + v[i][1]) + (v[i][2] + v[i][3]);
#pragma unroll
      for (int o = 32; o > 0; o >>= 1) s += __shfl_xor(s, o);
      const float mu = s * (1.f / 1024.f);
      float q = 0.f;
#pragma unroll
      for (int i = 0; i < 4; ++i) { v[i] -= mu; q += (v[i][0] * v[i][0] + v[i][1] * v[i][1]) + (v[i][2] * v[i][2] + v[i][3] * v[i][3]); }
#pragma unroll
      for (int o = 32; o > 0; o >>= 1) q += __shfl_xor(q, o);
      const float rstd = rsqrtf(q * (1.f / 1024.f) + EPS);
#pragma unroll
      for (int i = 0; i < 4; ++i) { const int c = (i * 64 + lane) * 4; const f32x4 g = *(const f32x4*)(lg + c), bb = *(const f32x4*)(lb + c); v[i] = v[i] * rstd * g + bb; }
    }
    { const float sca = (isctx && alpha_ctx) ? DN_ALPHA : 1.f;
#pragma unroll
      for (int i = 0; i < 4; ++i) *(f32x4*)(xr + (i * 64 + lane) * 4) = v[i] * sca; }
    if (want_h) {
      if (lane == 0) { float z0 = 0.f; asm volatile("" : "+v"(z0)); f32x2 z; z[0] = z0; z[1] = z0; *(f32x2*)(pp->ws + OFF_SSQ + (size_t)t * 8) = z; }
      const float* mv = mod + (size_t)(isctx ? 2 : b) * 6144;
#pragma unroll
      for (int i = 0; i < 4; ++i) { const int c = (i * 64 + lane) * 4; const f32x4 sh = *(const f32x4*)(mv + shc * 1024 + c), sc = *(const f32x4*)(mv + scc * 1024 + c);
        const f32x4 h = v[i] * (sc + 1.f) + sh; u32x2 w; w[0] = cvtpk(h[0], h[1]); w[1] = cvtpk(h[2], h[3]); *(u32x2*)(hmod + (size_t)t * KP + c) = w; }
    }
  }
}

__device__ __forceinline__ void dump_tile(f32x16 (&acc)[2][2], int rbase, int cl, float* ut, int c31, int hi) {
#pragma unroll
  for (int mb = 0; mb < 2; ++mb)
#pragma unroll
    for (int nb = 0; nb < 2; ++nb)
#pragma unroll
      for (int r = 0; r < 16; ++r) ut[(rbase + 32 * mb + crow(r, hi)) * 128 + cl + 32 * nb + c31] = acc[mb][nb][r];
}
__device__ __forceinline__ u32x4 pack8f(const f32x4 a, const f32x4 b) { u32x4 w; w[0] = cvtpk(a[0], a[1]); w[1] = cvtpk(a[2], a[3]); w[2] = cvtpk(b[0], b[1]); w[3] = cvtpk(b[2], b[3]); return w; }
__device__ __forceinline__ void rope8(f32x4& a, f32x4& b, const f32x4 pa, const f32x4 pb, const f32x2* cs, bool upper) {
  const float sg = upper ? 1.f : -1.f;
#pragma unroll
  for (int e = 0; e < 4; ++e) { const f32x2 c0 = cs[e], c1 = cs[4 + e]; a[e] = a[e] * c0[0] + sg * pa[e] * c0[1]; b[e] = b[e] * c1[0] + sg * pb[e] * c1[1]; }
}
template <int NCOL>
__device__ __forceinline__ void store_transposed(const float* ut, int lc0, bf16_t* dst  , const float* rscale) {
  const int tid = get_tid(), col = tid & (NCOL - 1), rc0 = tid / NCOL;
#pragma unroll 2
  for (int rc = rc0; rc < 32; rc += 512 / NCOL) {
    float v[8];
#pragma unroll
    for (int e = 0; e < 8; ++e) { v[e] = ut[(rc * 8 + e) * 128 + lc0 + col]; if (rscale) v[e] *= rscale[rc * 8 + e]; }
    u32x4 w; w[0] = cvtpk(v[0], v[1]); w[1] = cvtpk(v[2], v[3]); w[2] = cvtpk(v[4], v[5]); w[3] = cvtpk(v[6], v[7]);
    *(u32x4*)(dst + (size_t)col * SB + rc * 8) = w;
  }
}

__device__ __forceinline__ void phase_win(PP pp, int l, char* lds) {
  const bf16_t* A = (const bf16_t*)(pp->ws + OFF_HMOD);
  const bf16_t* Bt = (const bf16_t*)(pp->ws + OFF_W) + (size_t)l * W_LAYER + W_IN;
  bf16_t* zq = (bf16_t*)(pp->ws + OFF_ZQ); bf16_t* Kr = (bf16_t*)(pp->ws + OFF_KR); bf16_t* Qd = (bf16_t*)(pp->ws + OFF_QD); bf16_t* Kd = (bf16_t*)(pp->ws + OFF_KD);
  bf16_t* VdT = (bf16_t*)(pp->ws + OFF_VDT); bf16_t* zc = (bf16_t*)(pp->ws + OFF_ZC);
  const f32x2* cs16 = (const f32x2*)(pp->ws + OFF_CS16); const f32x2* cs8 = (const f32x2*)(pp->ws + OFF_CS8);
  const int tid = get_tid(), lane = tid & 63, c31 = lane & 31, hi = lane >> 5;
  float* ut = (float*)lds;
  const bool xmap = gridDim.x == 256; const int xq = get_bid() & 7, xj = get_bid() >> 3;
  for (int it0 = get_bid(); it0 < 64 * 8 + 32; it0 += gridDim.x) {
    const int it = (xmap && it0 < 512) ? ((xq * 8 + (((it0 >> 8) * 32 + xj) >> 3)) << 3) + (xj & 7) : it0;
    const bool lat = it < 512; const int mi = it >> 3;
    const int mt = lat ? (mi >> 5) * 33 + 1 + (mi & 31) : ((it - 512) >> 4) * 33, nt2 = it & 7, ntc = (it - 512) & 15;
    const int row0 = mt * 256, b = mt / 33, j0 = row0 - b * SB; const bool isctx = !lat;
    auto post_nt = [&](int nt) {
    {
      const int cc = tid & 15, seg = 2 * nt + (cc >> 3), col = nt * 128 + cc * 8;
      if (seg < 31 && !(seg >= 19 && seg < 23)) {
#pragma unroll 2
        for (int i = 0; i < 8; ++i) {
          const int row = (tid >> 4) + 32 * i, t = row0 + row; const float* up = ut + row * 128 + cc * 8;
          f32x4 va = *(const f32x4*)up, vb = *(const f32x4*)(up + 4);
          if (seg < 10) { *(u32x4*)(zq + (size_t)t * 640 + col) = pack8f(va, vb);
            float ss = (va[0] * va[0] + va[1] * va[1]) + (va[2] * va[2] + va[3] * va[3]) + (vb[0] * vb[0] + vb[1] * vb[1]) + (vb[2] * vb[2] + vb[3] * vb[3]);
            ss += __shfl_xor(ss, 1); ss += __shfl_xor(ss, 2); ss += __shfl_xor(ss, 4);
            if ((cc & 7) == 0) atomicAdd((float*)(pp->ws + OFF_SSQ) + (size_t)t * 2 + (seg < 6 ? 0 : 1), ss); }
          else if (seg == 10) {
            if (!isctx) { const float* qp = ut + row * 128 + (cc ^ 2) * 8; const f32x4 pa = *(const f32x4*)qp, pb = *(const f32x4*)(qp + 4);
              const int ppos = j0 + row - CTX, pos = ((cc & 4) == 0) ? (ppos >> 6) : (ppos & 63);
              rope8(va, vb, pa, pb, cs16 + pos * 16 + (cc & 1) * 8, (cc & 2) != 0); }
            *(u32x4*)(Kr + (size_t)t * 64 + (cc & 7) * 8) = pack8f(va, vb);
          } else if (seg < 19) {
            if (!isctx) { const float* qp = ut + row * 128 + (cc ^ 1) * 8; const f32x4 pa = *(const f32x4*)qp, pb = *(const f32x4*)(qp + 4);
              const int ppos = j0 + row - CTX, pos = ((cc & 2) == 0) ? (ppos >> 6) : (ppos & 63);
              rope8(va, vb, pa, pb, cs8 + pos * 8, (cc & 1) != 0); }
            if (seg < 15) { va *= QS_DIFF; vb *= QS_DIFF; *(u32x4*)(Qd + (size_t)t * 256 + col - 704) = pack8f(va, vb); }
            else *(u32x4*)(Kd + (size_t)t * 256 + col - 960) = pack8f(va, vb);
          } else {
#pragma unroll
            for (int e = 0; e < 4; ++e) { va[e] = gelu_tanh(va[e]); vb[e] = gelu_tanh(vb[e]); }
            *(u32x4*)(zc + (size_t)t * 512 + col - 1472) = pack8f(va, vb);
          }
        }
      }
#pragma unroll
      for (int sh = 0; sh < 2; ++sh) { const int sg = 2 * nt + sh;
        if (sg >= 19 && sg < 23) store_transposed<64>(ut, sh * 64, VdT + (size_t)(b * 4 + (sg - 19)) * 64 * SB + j0, nullptr); }
    }
    };
    if (lat) { auto post = [&](int h) { post_nt(2 * nt2 + h); }; gemm_tile256b(A, KP, RowId{row0}, Bt, KP, nt2 * 256, DM, lds, post); }
    else {
      auto epi = [&](f32x16 (&acc)[2][2], int rbase, int cbase) { dump_tile(acc, rbase, cbase - ntc * 128, ut, c31, hi); };
      gemm_tile(A, KP, RowId{row0}, Bt, KP, ntc * 128, DM, lds, epi);
      __syncthreads(); post_nt(ntc); __syncthreads();
    }
  }
}

__device__ __forceinline__ void phase_up2(PP pp, int l, char* lds) {
  const bf16_t* zq = (const bf16_t*)(pp->ws + OFF_ZQ);
  const bf16_t* wl = (const bf16_t*)(pp->ws + OFF_W) + (size_t)l * W_LAYER;
  bf16_t* Qm = (bf16_t*)(pp->ws + OFF_QM); bf16_t* Km = (bf16_t*)(pp->ws + OFF_KM); bf16_t* VmT = (bf16_t*)(pp->ws + OFF_VMT);
  const bf16_t* zc = (const bf16_t*)(pp->ws + OFF_ZC); bf16_t* Y = (bf16_t*)(pp->ws + OFF_Y);
  const f32x2* cs16 = (const f32x2*)(pp->ws + OFF_CS16);
  const int tid = get_tid(), lane = tid & 63, wid = tid >> 6, c31 = lane & 31, hi = lane >> 5;
  float* rstd = (float*)(lds + LDS_RSTD);
  constexpr int N_UQ = 66 * 3, N_UKV = 66 * 4, N_CH = 132;
  const float* ssq = (const float*)(pp->ws + OFF_SSQ);
  for (int it = get_bid(); it < N_UQ + N_UKV; it += gridDim.x) {
    {
      const bool isq = it < N_UQ; const int q = isq ? it : it - N_UQ; const int nN = isq ? 3 : 4;
      const int mt = q / nN, nt2 = q % nN, row0 = mt * 256, b = mt / 33, j0 = row0 - b * SB; const bool isctx = (mt % 33) == 0;
      if (tid < 256) rstd[tid] = rsqrtf(ssq[(size_t)(row0 + tid) * 2 + (isq ? 0 : 1)] * (isq ? 1.f / 384.f : 1.f / 256.f) + EPS);
      float* ut = (float*)lds;
      auto post = [&](int h) {
        const int nt = 2 * nt2 + h;
        if (isq || (nt & 1) == 0) {
          const int cc = tid & 15, seg = 2 * nt + (cc >> 3), col = nt * 128 + cc * 8;
#pragma unroll 2
          for (int i = 0; i < 8; ++i) {
            const int row = (tid >> 4) + 32 * i, t = row0 + row; const float* up = ut + row * 128 + cc * 8; const float rs = rstd[row];
            f32x4 va = *(const f32x4*)up, vb = *(const f32x4*)(up + 4);
            if (isq) {
              if ((seg % 3) == 2 && !isctx) { const float* qp = ut + row * 128 + (cc ^ 2) * 8; const f32x4 pa = *(const f32x4*)qp, pb = *(const f32x4*)(qp + 4);
                const int ppos = j0 + row - CTX, pos = ((cc & 4) == 0) ? (ppos >> 6) : (ppos & 63);
                rope8(va, vb, pa, pb, cs16 + pos * 16 + (cc & 1) * 8, (cc & 2) != 0); }
              va *= rs * QS_MLA; vb *= rs * QS_MLA;
              *(u32x4*)(Qm + (size_t)t * 768 + col) = pack8f(va, vb);
            } else {
              va *= rs; vb *= rs;
              *(u32x4*)(Km + (size_t)t * 512 + (nt >> 1) * 128 + cc * 8) = pack8f(va, vb);
            }
          }
        } else {
          store_transposed<128>(ut, 0, VmT + (size_t)(b * 4 + (nt >> 1)) * 128 * SB + j0, rstd);
        }
      };
      gemm_tile256(isq ? zq : zq + 384, 640, RowId{row0}, isq ? wl + W_UQ : wl + W_UKV, isq ? 384 : 256, nt2 * 256, isq ? 384 : 256, lds, post);
    }
  }
  for (int it = (get_bid() + gridDim.x - ((N_UQ + N_UKV) % gridDim.x)) % gridDim.x; it < N_CH * 4; it += gridDim.x) {
    {
      const int ch = it >> 2, g0 = it & 3, t0 = ch * 128;
      float* st = (float*)lds;
      bf16_t* vT = (bf16_t*)(lds + 1024);
      if (tid < 256) {
        const int r = tid >> 1, hf = tid & 1; const bf16_t* rp = zc + (size_t)(t0 + r) * 512 + 256 + hf * 128;
        float s = 0.f, ss = 0.f;
        for (int i = 0; i < 16; ++i) { const u32x4 w = *(const u32x4*)(rp + i * 8);
#pragma unroll
          for (int e = 0; e < 4; ++e) { const float a = bflo(w[e]), c = bfhi(w[e]); s += a + c; ss += a * a + c * c; } }
        s += __shfl_xor(s, 1); ss += __shfl_xor(ss, 1);
        const float mu = s * (1.f / 256.f); const float var = fmaxf(ss * (1.f / 256.f) - mu * mu, 0.f);
        if (hf == 0) { st[2 * r] = mu; st[2 * r + 1] = rsqrtf(var + EPS); }
      }
      __syncthreads();
      const bf16_t* Ws = wl + W_SG;
      for (int g = g0; g < g0 + 1; ++g) {
        {
          const int r = tid >> 2, q4 = tid & 3; const bf16_t* rp = zc + (size_t)(t0 + r) * 512 + 256 + g * 64 + q4 * 16;
          const float mu = st[2 * r], rs = st[2 * r + 1];
          const float* lg = pp->sgu_ln_g + l * 256 + g * 64 + q4 * 16; const float* lb = pp->sgu_ln_b + l * 256 + g * 64 + q4 * 16;
#pragma unroll
          for (int i = 0; i < 2; ++i) { const u32x4 w = *(const u32x4*)(rp + i * 8);
#pragma unroll
            for (int e = 0; e < 4; ++e) { const int c = i * 8 + 2 * e;
              vT[(q4 * 16 + c) * 136 + r] = f2bf((bflo(w[e]) - mu) * rs * lg[c] + lb[c]);
              vT[(q4 * 16 + c + 1) * 136 + r] = f2bf((bfhi(w[e]) - mu) * rs * lg[c + 1] + lb[c + 1]); } }
        }
        __syncthreads();
        if (wid < 4) {
          f32x16 a0 = {}, a1 = {};
          const bf16_t* wrow = Ws + ((size_t)g * 128 + 32 * wid + c31) * 128 + hi * 8;
#pragma unroll
          for (int ks = 0; ks < 8; ++ks) {
            const bf16x8 a = *(const bf16x8*)(wrow + ks * 16);
            const bf16x8 b0 = *(const bf16x8*)((const char*)vT + (c31) * 272 + ks * 32 + hi * 16);
            const bf16x8 b1 = *(const bf16x8*)((const char*)vT + (32 + c31) * 272 + ks * 32 + hi * 16);
            a0 = __builtin_amdgcn_mfma_f32_32x32x16_bf16(a, b0, a0, 0, 0, 0);
            a1 = __builtin_amdgcn_mfma_f32_32x32x16_bf16(a, b1, a1, 0, 0, 0);
          }
#pragma unroll
          for (int r = 0; r < 16; ++r) { const int pr = 32 * wid + crow(r, hi); const float bs = pp->sgu_bs[(l * 4 + g) * 128 + pr];
            const size_t t = (size_t)(t0 + pr);
            const float u0 = bf2f(zc[t * 512 + g * 64 + c31]), u1 = bf2f(zc[t * 512 + g * 64 + 32 + c31]);
            Y[t * KP + 768 + g * 64 + c31] = f2bf(u0 * (a0[r] + bs)); Y[t * KP + 768 + g * 64 + 32 + c31] = f2bf(u1 * (a1[r] + bs)); }
        }
        __syncthreads();
      }
    }
  }
}

__device__ __forceinline__ bf16x8 pack8(const f32x16& pv, int base) {
  u32x4 w; w[0] = cvtpk(pv[base], pv[base + 1]); w[1] = cvtpk(pv[base + 2], pv[base + 3]); w[2] = cvtpk(pv[base + 4], pv[base + 5]); w[3] = cvtpk(pv[base + 6], pv[base + 7]);
  return *(bf16x8*)&w;
}
__device__ __forceinline__ bf16x8 ld_vfrag(const char* base) { return *(const bf16x8*)base; }
__device__ __forceinline__ int kperm(int r) { return (r & ~12) | ((r & 4) << 1) | ((r & 8) >> 1); }

constexpr int MLA_KS = 400, MLA_KBYTES = 64 * MLA_KS, VT_S = 144, MLA_VBYTES = 128 * VT_S, MLA_STAGE = MLA_KBYTES + MLA_VBYTES;
constexpr int DF_KS = 144, DF_KBYTES = 64 * DF_KS, DF_VBYTES = 64 * VT_S, DF_STAGE = DF_KBYTES + DF_VBYTES;

template <int NKS>
__device__ __forceinline__ f32x16 qk_tile(const char* krow, const bf16x8* qf, const f32x16& negm) {
  f32x16 p = __builtin_amdgcn_mfma_f32_32x32x16_bf16(*(const bf16x8*)krow, qf[0], negm, 0, 0, 0);
#pragma unroll
  for (int ks = 1; ks < NKS; ++ks) p = __builtin_amdgcn_mfma_f32_32x32x16_bf16(*(const bf16x8*)(krow + ks * 32), qf[ks], p, 0, 0, 0);
  return p;
}
template <int NOB>
__device__ __forceinline__ void sm_pv(f32x16& p, const char* vrow, f32x16& negm, float& m, f32x16& lacc, f32x16* oT, bool first, f32x16* pend) {
  float pm = p[0];
#pragma unroll
  for (int r = 1; r < 16; ++r) pm = fmaxf(pm, p[r]);
  if (first || !__all(pm <= 8.f)) {
    const float pmx = fmaxf(pm, __shfl_xor(pm, 32));
    const float d = first ? pmx : fmaxf(pmx, 0.f);
    if (!first) { const float alpha = fexp2(-d); lacc *= alpha;
#pragma unroll
      for (int nb = 0; nb < NOB; ++nb) oT[nb] *= alpha; }
    m += d;
#pragma unroll
    for (int r = 0; r < 16; ++r) { negm[r] = -m; p[r] -= d; }
    if (pend) {
#pragma unroll
      for (int r = 0; r < 16; ++r) (*pend)[r] -= d; }
  }
#pragma unroll
  for (int r = 0; r < 16; ++r) p[r] = fexp2(p[r]);
  const bf16x8 pb0 = pack8(p, 0), pb1 = pack8(p, 8);
  const bf16x8 ones = {0x3F80, 0x3F80, 0x3F80, 0x3F80, 0x3F80, 0x3F80, 0x3F80, 0x3F80};
  lacc = __builtin_amdgcn_mfma_f32_32x32x16_bf16(ones, pb0, lacc, 0, 0, 0);
  lacc = __builtin_amdgcn_mfma_f32_32x32x16_bf16(ones, pb1, lacc, 0, 0, 0);
#pragma unroll
  for (int nb = 0; nb < NOB; ++nb) {
    oT[nb] = __builtin_amdgcn_mfma_f32_32x32x16_bf16(ld_vfrag(vrow + nb * 32 * VT_S), pb0, oT[nb], 0, 0, 0);
    oT[nb] = __builtin_amdgcn_mfma_f32_32x32x16_bf16(ld_vfrag(vrow + nb * 32 * VT_S + 32), pb1, oT[nb], 0, 0, 0);
  }
}

template <int NOB, int VS = VT_S>
__device__ __forceinline__ void sm_pv_sv(f32x16& p, const char* vrow, f32x16& negm, float& m, float& l, f32x16* oT, bool first) {
  float pm = p[0];
#pragma unroll
  for (int r = 1; r < 16; ++r) pm = fmaxf(pm, p[r]);
  if (first || !__all(pm <= 8.f)) {
    const float pmx = fmaxf(pm, __shfl_xor(pm, 32));
    const float d = first ? pmx : fmaxf(pmx, 0.f);
    if (!first) { const float alpha = fexp2(-d); l *= alpha;
#pragma unroll
      for (int nb = 0; nb < NOB; ++nb) oT[nb] *= alpha; }
    m += d;
#pragma unroll
    for (int r = 0; r < 16; ++r) { negm[r] = -m; p[r] -= d; }
  }
  float ps = 0.f;
#pragma unroll
  for (int r = 0; r < 16; ++r) { p[r] = fexp2(p[r]); ps += p[r]; }
  l += ps;
  const bf16x8 pb0 = pack8(p, 0), pb1 = pack8(p, 8);
#pragma unroll
  for (int nb = 0; nb < NOB; ++nb) {
    oT[nb] = __builtin_amdgcn_mfma_f32_32x32x16_bf16(ld_vfrag(vrow + nb * 32 * VS), pb0, oT[nb], 0, 0, 0);
    oT[nb] = __builtin_amdgcn_mfma_f32_32x32x16_bf16(ld_vfrag(vrow + nb * 32 * VS + 32), pb1, oT[nb], 0, 0, 0);
  }
}

template <int NOB>
__device__ __forceinline__ void sm_pv_valu(f32x16& p, const char* vrow, float& m, float& l, f32x16* oT, bool first) {
  float pm = p[0];
#pragma unroll
  for (int r = 1; r < 16; ++r) pm = fmaxf(pm, p[r]);
  if (first || !__all(pm <= m + 8.f)) {
    const float pmx = fmaxf(pm, __shfl_xor(pm, 32));
    const float mn = first ? pmx : fmaxf(m, pmx);
    if (!first) { const float alpha = fexp2(m - mn); l *= alpha;
#pragma unroll
      for (int nb = 0; nb < NOB; ++nb) oT[nb] *= alpha; }
    m = mn;
  }
  float ps = 0.f;
#pragma unroll
  for (int r = 0; r < 16; ++r) { p[r] = fexp2(p[r] - m); ps += p[r]; }
  l += ps;
  const bf16x8 pb0 = pack8(p, 0), pb1 = pack8(p, 8);
#pragma unroll
  for (int nb = 0; nb < NOB; ++nb) {
    oT[nb] = __builtin_amdgcn_mfma_f32_32x32x16_bf16(ld_vfrag(vrow + nb * 32 * VT_S), pb0, oT[nb], 0, 0, 0);
    oT[nb] = __builtin_amdgcn_mfma_f32_32x32x16_bf16(ld_vfrag(vrow + nb * 32 * VT_S + 32), pb1, oT[nb], 0, 0, 0);
  }
}

__device__ __forceinline__ void attn_mla_item(PP pp, int b, int h, int tq0, int NT, char* lds) {
  const bf16_t* Qm = (const bf16_t*)(pp->ws + OFF_QM); const bf16_t* Km = (const bf16_t*)(pp->ws + OFF_KM); const bf16_t* Kr = (const bf16_t*)(pp->ws + OFF_KR);
  const bf16_t* VmT = (const bf16_t*)(pp->ws + OFF_VMT) + (size_t)(b * 4 + h) * 128 * SB; bf16_t* Y = (bf16_t*)(pp->ws + OFF_Y);
  const int tid = get_tid(), lane = tid & 63, wid = tid >> 6, c31 = lane & 31, hi = lane >> 5;
  const int tk0 = b * SB;
  bf16x8 qf[12];
  { const bf16_t* qp = Qm + (size_t)(tq0 + 32 * wid + c31) * 768 + h * 192 + hi * 8;
#pragma unroll
    for (int ks = 0; ks < 12; ++ks) qf[ks] = *(const bf16x8*)(qp + ks * 16); }
  f32x16 oT[4];
#pragma unroll
  for (int nb = 0; nb < 4; ++nb)
#pragma unroll
    for (int r = 0; r < 16; ++r) oT[nb][r] = 0.f;
  float m = 0.f, l = 0.f; f32x16 negm;
#pragma unroll
  for (int r = 0; r < 16; ++r) negm[r] = 0.f;
  u32x4 rk0, rk1, rk2, rv0, rv1;
  int kkey[3], kc[3];
#pragma unroll
  for (int i = 0; i < 3; ++i) { const int id = tid + 512 * i; kkey[i] = id / 24; kc[i] = id % 24; }
  const int vdv0 = tid >> 3, vkc = tid & 7;
#define A_KSRC(i, key0) (kc[i] < 16 ? Km + (size_t)(tk0 + (key0) + kkey[i]) * 512 + h * 128 + kc[i] * 8 : Kr + (size_t)(tk0 + (key0) + kkey[i]) * 64 + (kc[i] - 16) * 8)
#define A_LOAD(key0) do { rk0 = *(const u32x4*)A_KSRC(0, key0); rk1 = *(const u32x4*)A_KSRC(1, key0); rk2 = *(const u32x4*)A_KSRC(2, key0); \
    rv0 = *(const u32x4*)(VmT + (size_t)vdv0 * SB + (key0) + vkc * 8); rv1 = *(const u32x4*)(VmT + (size_t)(vdv0 + 64) * SB + (key0) + vkc * 8); } while (0)
#define A_STORE(s) do { char* kb_ = lds + (s) * MLA_STAGE; char* vb_ = kb_ + MLA_KBYTES; \
    *(u32x4*)(kb_ + kkey[0] * MLA_KS + kc[0] * 16) = rk0; *(u32x4*)(kb_ + kkey[1] * MLA_KS + kc[1] * 16) = rk1; *(u32x4*)(kb_ + kkey[2] * MLA_KS + kc[2] * 16) = rk2; \
    { char* d_ = vb_ + vdv0 * VT_S + vkc * 16; *(u32x4*)d_ = rv0; *(u32x4*)(d_ + 64 * VT_S) = rv1; } } while (0)
  A_LOAD(0); A_STORE(0); __syncthreads();
  for (int t = 0; t < NT; ++t) {
    const int s = t & 1;
    if (t + 1 < NT) A_LOAD((t + 1) * 64);
    const char* kb = lds + s * MLA_STAGE; const char* vb = kb + MLA_KBYTES;
    const char* ka = kb + kperm(c31) * MLA_KS + hi * 16; const char* va = vb + c31 * VT_S + hi * 16;
    f32x16 pa = qk_tile<12>(ka, qf, negm);
    sm_pv_sv<4>(pa, va, negm, m, l, oT, t == 0);
    f32x16 pbb = qk_tile<12>(ka + 32 * MLA_KS, qf, negm);
    sm_pv_sv<4>(pbb, va + 64, negm, m, l, oT, false);
    if (t + 1 < NT) A_STORE(s ^ 1);
    __syncthreads();
  }
#undef A_KSRC
#undef A_LOAD
#undef A_STORE
  l += __shfl_xor(l, 32);
  const float il = 1.f / l;
  bf16_t* yp = Y + (size_t)(tq0 + 32 * wid + c31) * KP + h * 128;
#pragma unroll
  for (int nb = 0; nb < 4; ++nb)
#pragma unroll
    for (int i4 = 0; i4 < 4; ++i4) { u32x2 w; w[0] = cvtpk(oT[nb][4 * i4] * il, oT[nb][4 * i4 + 1] * il); w[1] = cvtpk(oT[nb][4 * i4 + 2] * il, oT[nb][4 * i4 + 3] * il);
      *(u32x2*)(yp + 32 * nb + 8 * i4 + 4 * hi) = w; }
}

constexpr int MD_K = 64 * 384, MD_STAGE = MD_K + 128 * 128;
__device__ __forceinline__ void attn_mla_item_dma(PP pp, int b, int h, int tq0, int NT, char* lds) {
  const bf16_t* Qm = (const bf16_t*)(pp->ws + OFF_QM); const bf16_t* Km = (const bf16_t*)(pp->ws + OFF_KM); const bf16_t* Kr = (const bf16_t*)(pp->ws + OFF_KR);
  const bf16_t* VmT = (const bf16_t*)(pp->ws + OFF_VMT) + (size_t)(b * 4 + h) * 128 * SB; bf16_t* Y = (bf16_t*)(pp->ws + OFF_Y);
  const int tid = get_tid(), lane = tid & 63, wid = tid >> 6, c31 = lane & 31, hi = lane >> 5;
  const int tk0 = b * SB;
  bf16x8 qf[12];
  { const bf16_t* qp = Qm + (size_t)(tq0 + 32 * wid + c31) * 768 + h * 192 + hi * 8;
#pragma unroll
    for (int ks = 0; ks < 12; ++ks) qf[ks] = *(const bf16x8*)(qp + ks * 16); }
  f32x16 oT[4];
#pragma unroll
  for (int nb = 0; nb < 4; ++nb)
#pragma unroll
    for (int r = 0; r < 16; ++r) oT[nb][r] = 0.f;
  float m = 0.f, l = 0.f; f32x16 negm;
#pragma unroll
  for (int r = 0; r < 16; ++r) negm[r] = 0.f;
  const bf16_t* kp0; const bf16_t* kp1; const bf16_t* kp2; int ks0, ks1, ks2;
#define MD_KPTR(i, P, S) do { const int sl_ = tid + 512 * (i), key_ = sl_ / 24, pc_ = sl_ % 24, c_ = (pc_ & ~7) | ((pc_ & 7) ^ ((key_ >> 1) & 7)); \
    if (c_ < 16) { P = Km + (size_t)(tk0 + key_) * 512 + h * 128 + c_ * 8; S = 512; } else { P = Kr + (size_t)(tk0 + key_) * 64 + (c_ - 16) * 8; S = 64; } } while (0)
  MD_KPTR(0, kp0, ks0); MD_KPTR(1, kp1, ks1); MD_KPTR(2, kp2, ks2);
#undef MD_KPTR
  const int vdv = tid >> 3, vc = (tid & 7) ^ ((vdv >> 1) & 7);
  const bf16_t* vp0 = VmT + (size_t)vdv * SB + vc * 8; const bf16_t* vp1 = vp0 + (size_t)64 * SB;
#define MD_DMA(gp, lp) __builtin_amdgcn_global_load_lds((const unsigned*)(gp), (__attribute__((address_space(3))) unsigned*)(lp), 16, 0, 0)
#define MD_ISSUE(st, key0) do { char* sb_ = lds + (st) * MD_STAGE + tid * 16; \
    MD_DMA(kp0 + (size_t)(key0) * ks0, sb_); MD_DMA(kp1 + (size_t)(key0) * ks1, sb_ + 8192); MD_DMA(kp2 + (size_t)(key0) * ks2, sb_ + 16384); \
    MD_DMA(vp0 + (key0), sb_ + MD_K); MD_DMA(vp1 + (key0), sb_ + MD_K + 8192); } while (0)
  const int kr = kperm(c31), fk = (kr >> 1) & 7, gk = fk >> 1, ek = (hi ^ (fk & 1)) << 4;
  const int ko0 = kr * 384 + (((0 ^ gk) << 5) | ek), ko1 = kr * 384 + (((1 ^ gk) << 5) | ek), ko2 = kr * 384 + (((2 ^ gk) << 5) | ek), ko3 = kr * 384 + (((3 ^ gk) << 5) | ek);
  const int fv = (c31 >> 1) & 7, gv = fv >> 1, ev = (hi ^ (fv & 1)) << 4;
  const int vo0 = c31 * 128 + (((0 ^ gv) << 5) | ev), vo1 = c31 * 128 + (((1 ^ gv) << 5) | ev), vo2 = c31 * 128 + (((2 ^ gv) << 5) | ev), vo3 = c31 * 128 + (((3 ^ gv) << 5) | ev);
#define MD_QK(P, KB) do { P = __builtin_amdgcn_mfma_f32_32x32x16_bf16(*(const bf16x8*)((KB) + ko0), qf[0], negm, 0, 0, 0); \
    P = __builtin_amdgcn_mfma_f32_32x32x16_bf16(*(const bf16x8*)((KB) + ko1), qf[1], P, 0, 0, 0); \
    P = __builtin_amdgcn_mfma_f32_32x32x16_bf16(*(const bf16x8*)((KB) + ko2), qf[2], P, 0, 0, 0); \
    P = __builtin_amdgcn_mfma_f32_32x32x16_bf16(*(const bf16x8*)((KB) + ko3), qf[3], P, 0, 0, 0); \
    P = __builtin_amdgcn_mfma_f32_32x32x16_bf16(*(const bf16x8*)((KB) + 128 + ko0), qf[4], P, 0, 0, 0); \
    P = __builtin_amdgcn_mfma_f32_32x32x16_bf16(*(const bf16x8*)((KB) + 128 + ko1), qf[5], P, 0, 0, 0); \
    P = __builtin_amdgcn_mfma_f32_32x32x16_bf16(*(const bf16x8*)((KB) + 128 + ko2), qf[6], P, 0, 0, 0); \
    P = __builtin_amdgcn_mfma_f32_32x32x16_bf16(*(const bf16x8*)((KB) + 128 + ko3), qf[7], P, 0, 0, 0); \
    P = __builtin_amdgcn_mfma_f32_32x32x16_bf16(*(const bf16x8*)((KB) + 256 + ko0), qf[8], P, 0, 0, 0); \
    P = __builtin_amdgcn_mfma_f32_32x32x16_bf16(*(const bf16x8*)((KB) + 256 + ko1), qf[9], P, 0, 0, 0); \
    P = __builtin_amdgcn_mfma_f32_32x32x16_bf16(*(const bf16x8*)((KB) + 256 + ko2), qf[10], P, 0, 0, 0); \
    P = __builtin_amdgcn_mfma_f32_32x32x16_bf16(*(const bf16x8*)((KB) + 256 + ko3), qf[11], P, 0, 0, 0); } while (0)
#define MD_SMPV(P, VB, VO_A, VO_B, FIRST) do { \
    float pm_ = P[0]; _Pragma("unroll") for (int r = 1; r < 16; ++r) pm_ = fmaxf(pm_, P[r]); \
    if ((FIRST) || !__all(pm_ <= 8.f)) { const float pmx_ = fmaxf(pm_, __shfl_xor(pm_, 32)); const float d_ = (FIRST) ? pmx_ : fmaxf(pmx_, 0.f); \
      if (!(FIRST)) { const float al_ = fexp2(-d_); l *= al_; _Pragma("unroll") for (int nb = 0; nb < 4; ++nb) oT[nb] *= al_; } \
      m += d_; _Pragma("unroll") for (int r = 0; r < 16; ++r) { negm[r] = -m; P[r] -= d_; } } \
    float ps_ = 0.f; _Pragma("unroll") for (int r = 0; r < 16; ++r) { P[r] = fexp2(P[r]); ps_ += P[r]; } l += ps_; \
    const bf16x8 pb0_ = pack8(P, 0), pb1_ = pack8(P, 8); \
    _Pragma("unroll") for (int nb = 0; nb < 4; ++nb) oT[nb] = __builtin_amdgcn_mfma_f32_32x32x16_bf16(*(const bf16x8*)((VB) + nb * 4096 + (VO_A)), pb0_, oT[nb], 0, 0, 0); \
    _Pragma("unroll") for (int nb = 0; nb < 4; ++nb) oT[nb] = __builtin_amdgcn_mfma_f32_32x32x16_bf16(*(const bf16x8*)((VB) + nb * 4096 + (VO_B)), pb1_, oT[nb], 0, 0, 0); } while (0)
  MD_ISSUE(0, 0);
  if (NT > 1) MD_ISSUE(1, 64);
  int st = 0, st2 = 2;
  for (int t = 0; t < NT; ++t) {
    if (t + 1 < NT) asm volatile("s_waitcnt vmcnt(5)" ::: "memory"); else asm volatile("s_waitcnt vmcnt(0)" ::: "memory");
    __builtin_amdgcn_s_barrier();
    if (t + 2 < NT) MD_ISSUE(st2, (t + 2) * 64);
    const char* kb = lds + st * MD_STAGE; const char* vb = kb + MD_K;
    f32x16 pa, pbb;
    MD_QK(pa, kb);
    MD_SMPV(pa, vb, vo0, vo1, t == 0);
    MD_QK(pbb, kb + 32 * 384);
    MD_SMPV(pbb, vb, vo2, vo3, false);
    st = st == 2 ? 0 : st + 1; st2 = st2 == 2 ? 0 : st2 + 1;
  }
#undef MD_DMA
#undef MD_ISSUE
#undef MD_QK
#undef MD_SMPV
  __syncthreads();
  l += __shfl_xor(l, 32);
  const float il = 1.f / l;
  bf16_t* yp = Y + (size_t)(tq0 + 32 * wid + c31) * KP + h * 128;
#pragma unroll
  for (int nb = 0; nb < 4; ++nb)
#pragma unroll
    for (int i4 = 0; i4 < 4; ++i4) { u32x2 w; w[0] = cvtpk(oT[nb][4 * i4] * il, oT[nb][4 * i4 + 1] * il); w[1] = cvtpk(oT[nb][4 * i4 + 2] * il, oT[nb][4 * i4 + 3] * il);
      *(u32x2*)(yp + 32 * nb + 8 * i4 + 4 * hi) = w; }
}

__device__ __forceinline__ void attn_diff_item(PP pp, int l, int b, int h, int tq0, int NT, float lam, float lam_init, char* lds) {
  const bf16_t* Qd = (const bf16_t*)(pp->ws + OFF_QD); const bf16_t* Kd = (const bf16_t*)(pp->ws + OFF_KD);
  const bf16_t* VdT = (const bf16_t*)(pp->ws + OFF_VDT) + (size_t)(b * 4 + h) * 64 * SB; bf16_t* Y = (bf16_t*)(pp->ws + OFF_Y);
  const int tid = get_tid(), lane = tid & 63, wid = tid >> 6, c31 = lane & 31, hi = lane >> 5;
  const int tk0 = b * SB;
  bf16x8 qf[2][2];
  { const bf16_t* qp = Qd + (size_t)(tq0 + 32 * wid + c31) * 256 + h * 64 + hi * 8;
#pragma unroll
    for (int mp = 0; mp < 2; ++mp)
#pragma unroll
      for (int ks = 0; ks < 2; ++ks) qf[mp][ks] = *(const bf16x8*)(qp + mp * 32 + ks * 16); }
  f32x16 oA[2], oB[2];
#pragma unroll
  for (int nb = 0; nb < 2; ++nb)
#pragma unroll
    for (int r = 0; r < 16; ++r) { oA[nb][r] = 0.f; oB[nb][r] = 0.f; }
  float mA = 0.f, mB = 0.f, lA = 0.f, lB = 0.f; f32x16 negA, negB;
#pragma unroll
  for (int r = 0; r < 16; ++r) { negA[r] = 0.f; negB[r] = 0.f; }
  constexpr int DD_K = 128 * 128, DD_STAGE = DD_K + 64 * 256;
  const int dkey = tid >> 3, dkc = (tid & 7) ^ ((dkey >> 1) & 7);
  const bf16_t* kp0 = Kd + (size_t)(tk0 + dkey) * 256 + h * 64 + dkc * 8;
  const int ddv = tid >> 4, dvc = (tid & 15) ^ (ddv & 15);
  const bf16_t* vp0 = VdT + (size_t)ddv * SB + dvc * 8;
#define DD_DMA(gp, lp) __builtin_amdgcn_global_load_lds((const unsigned*)(gp), (__attribute__((address_space(3))) unsigned*)(lp), 16, 0, 0)
#define DD_ISSUE(st, key0) do { char* sb_ = lds + (st) * DD_STAGE + tid * 16; \
    DD_DMA(kp0 + (size_t)(key0) * 256, sb_); DD_DMA(kp0 + (size_t)((key0) + 64) * 256, sb_ + 8192); \
    DD_DMA(vp0 + (key0), sb_ + DD_K); DD_DMA(vp0 + (size_t)32 * SB + (key0), sb_ + DD_K + 8192); } while (0)
  const int kr = kperm(c31), fk = (kr >> 1) & 7, gk = fk >> 1, ek = (hi ^ (fk & 1)) << 4;
  const int ko0 = kr * 128 + (((0 ^ gk) << 5) | ek), ko1 = kr * 128 + (((1 ^ gk) << 5) | ek), ko2 = kr * 128 + (((2 ^ gk) << 5) | ek), ko3 = kr * 128 + (((3 ^ gk) << 5) | ek);
  const int fv = c31 & 15, gv = fv >> 1, vbase = c31 * 256 + ((hi ^ (fv & 1)) << 4);
  int vo[8];
#pragma unroll
  for (int i = 0; i < 8; ++i) vo[i] = vbase + ((i ^ gv) << 5);
#define DD_QK(P, KB, OA_, OB_, Q0, Q1, SEED) do { P = __builtin_amdgcn_mfma_f32_32x32x16_bf16(*(const bf16x8*)((KB) + (OA_)), Q0, SEED, 0, 0, 0); \
    P = __builtin_amdgcn_mfma_f32_32x32x16_bf16(*(const bf16x8*)((KB) + (OB_)), Q1, P, 0, 0, 0); } while (0)
#define DD_SMPV(P, VB, VO_A, VO_B, FIRST, NEG, M_, L_, O_) do { \
    float pm_ = P[0]; _Pragma("unroll") for (int r = 1; r < 16; ++r) pm_ = fmaxf(pm_, P[r]); \
    if ((FIRST) || !__all(pm_ <= 8.f)) { const float pmx_ = fmaxf(pm_, __shfl_xor(pm_, 32)); const float d_ = (FIRST) ? pmx_ : fmaxf(pmx_, 0.f); \
      if (!(FIRST)) { const float al_ = fexp2(-d_); L_ *= al_; O_[0] *= al_; O_[1] *= al_; } \
      M_ += d_; _Pragma("unroll") for (int r = 0; r < 16; ++r) { NEG[r] = -M_; P[r] -= d_; } } \
    float ps_ = 0.f; _Pragma("unroll") for (int r = 0; r < 16; ++r) { P[r] = fexp2(P[r]); ps_ += P[r]; } L_ += ps_; \
    const bf16x8 pb0_ = pack8(P, 0), pb1_ = pack8(P, 8); \
    O_[0] = __builtin_amdgcn_mfma_f32_32x32x16_bf16(*(const bf16x8*)((VB) + (VO_A)), pb0_, O_[0], 0, 0, 0); \
    O_[1] = __builtin_amdgcn_mfma_f32_32x32x16_bf16(*(const bf16x8*)((VB) + 8192 + (VO_A)), pb0_, O_[1], 0, 0, 0); \
    O_[0] = __builtin_amdgcn_mfma_f32_32x32x16_bf16(*(const bf16x8*)((VB) + (VO_B)), pb1_, O_[0], 0, 0, 0); \
    O_[1] = __builtin_amdgcn_mfma_f32_32x32x16_bf16(*(const bf16x8*)((VB) + 8192 + (VO_B)), pb1_, O_[1], 0, 0, 0); } while (0)
  const int NT2 = NT >> 1;
  DD_ISSUE(0, 0);
  if (NT2 > 1) DD_ISSUE(1, 128);
  int st = 0, st2 = 2;
  for (int t = 0; t < NT2; ++t) {
    if (t + 1 < NT2) asm volatile("s_waitcnt vmcnt(4)" ::: "memory"); else asm volatile("s_waitcnt vmcnt(0)" ::: "memory");
    __builtin_amdgcn_s_barrier();
    if (t + 2 < NT2) DD_ISSUE(st2, (t + 2) * 128);
    const char* kb = lds + st * DD_STAGE; const char* vb = kb + DD_K;
#pragma unroll
    for (int sub = 0; sub < 2; ++sub) {
      const char* k0 = kb + sub * 64 * 128; const char* k1 = k0 + 32 * 128;
      const bool f0 = (t == 0) && (sub == 0);
      f32x16 pA0, pB0, pA1, pB1;
      DD_QK(pA0, k0, ko0, ko1, qf[0][0], qf[0][1], negA);
      DD_QK(pB0, k0, ko2, ko3, qf[1][0], qf[1][1], negB);
      DD_SMPV(pA0, vb, vo[4 * sub + 0], vo[4 * sub + 1], f0, negA, mA, lA, oA);
      DD_QK(pA1, k1, ko0, ko1, qf[0][0], qf[0][1], negA);
      DD_SMPV(pB0, vb, vo[4 * sub + 0], vo[4 * sub + 1], f0, negB, mB, lB, oB);
      DD_QK(pB1, k1, ko2, ko3, qf[1][0], qf[1][1], negB);
      DD_SMPV(pA1, vb, vo[4 * sub + 2], vo[4 * sub + 3], false, negA, mA, lA, oA);
      DD_SMPV(pB1, vb, vo[4 * sub + 2], vo[4 * sub + 3], false, negB, mB, lB, oB);
    }
    st = st == 2 ? 0 : st + 1; st2 = st2 == 2 ? 0 : st2 + 1;
  }
#undef DD_DMA
#undef DD_ISSUE
#undef DD_QK
#undef DD_SMPV
  __syncthreads();
  lA += __shfl_xor(lA, 32); lB += __shfl_xor(lB, 32);
  const float ia = 1.f / lA, ib = lam / lB;
  float ss = 0.f;
#pragma unroll
  for (int nb = 0; nb < 2; ++nb)
#pragma unroll
    for (int r = 0; r < 16; ++r) { const float d = oA[nb][r] * ia - oB[nb][r] * ib; oA[nb][r] = d; ss += d * d; }
  ss += __shfl_xor(ss, 32);
  const float rs = rsqrtf(ss * (1.f / 64.f) + EPS) * (1.f - lam_init);
  const float* g = pp->subln_g + l * 64;
  bf16_t* yp = Y + (size_t)(tq0 + 32 * wid + c31) * KP + 512 + h * 64;
#pragma unroll
  for (int nb = 0; nb < 2; ++nb)
#pragma unroll
    for (int i4 = 0; i4 < 4; ++i4) { const int dv = 32 * nb + 8 * i4 + 4 * hi; const f32x4 gg = *(const f32x4*)(g + dv);
      u32x2 w; w[0] = cvtpk(oA[nb][4 * i4] * rs * gg[0], oA[nb][4 * i4 + 1] * rs * gg[1]); w[1] = cvtpk(oA[nb][4 * i4 + 2] * rs * gg[2], oA[nb][4 * i4 + 3] * rs * gg[3]);
      *(u32x2*)(yp + dv) = w; }
}

__device__ __forceinline__ void phase_attn(PP pp, int l, bool need_ctx, char* lds) {
  const int n_items = 256 + (need_ctx ? 8 : 0);
  for (int it = get_bid(); it < n_items; it += gridDim.x) {
    const int bh = it & 7, b = bh >> 2, h = bh & 3; const bool lat = it < 256;
    attn_mla_item_dma(pp, b, h, lat ? b * SB + CTX + (it >> 3) * 256 : b * SB, lat ? SB / 64 : CTX / 64, lds);
  }
  float d1 = 0.f, d2 = 0.f;
#pragma unroll 1
  for (int i = 0; i < 32; ++i) { d1 += pp->lq1[l * 32 + i] * pp->lk1[l * 32 + i]; d2 += pp->lq2[l * 32 + i] * pp->lk2[l * 32 + i]; }
  const float lam_init = 0.8f - 0.6f * __expf(-0.3f * (float)l);
  const float lam = __expf(d1) - __expf(d2) + lam_init;
  for (int it = get_bid(); it < n_items + 8; it += gridDim.x) {
    if (it >= 256 && it < 264) continue;
    const int bh = it & 7, b = bh >> 2, h = bh & 3; const bool lat = it < 256;
    attn_diff_item(pp, l, b, h, lat ? b * SB + CTX + (it >> 3) * 256 : b * SB, lat ? SB / 64 : CTX / 64, lam, lam_init, lds);
  }
}

__device__ __forceinline__ void phase_res_gemm(PP pp, int l, const bf16_t* A, int K, int ld, const bf16_t* Bt, int gchunk, bool skip_ctx, char* lds) {
  const float* mod = (const float*)(pp->ws + OFF_MOD) + (size_t)l * 3 * 6144;
  const int tid = get_tid(), lane = tid & 63, c31 = lane & 31, hi = lane >> 5;
  float* ut = (float*)lds;
  for (int it0 = get_bid(); it0 < 64 * 4; it0 += gridDim.x) {
    const int it = gridDim.x == 256 ? (((it0 & 7) * 8 + (it0 >> 5)) << 2) + ((it0 >> 3) & 3) : it0;
    const int mi = it >> 2, nt2 = it & 3, mt = (mi >> 5) * 33 + 1 + (mi & 31), row0 = mt * 256, b = mt / 33;
    const float* gv = mod + (size_t)b * 6144 + gchunk * 1024;
    auto post = [&](int h) {
      const int cc = tid & 15, col = nt2 * 256 + h * 128 + cc * 8;
      const f32x4 g0 = *(const f32x4*)(gv + col), g1 = *(const f32x4*)(gv + col + 4);
#pragma unroll 2
      for (int i = 0; i < 8; ++i) {
        const int row = (tid >> 4) + 32 * i; const float* up = ut + row * 128 + cc * 8;
        float* xp = xrow(pp, row0 + row) + col;
        const f32x4 ua = *(const f32x4*)up, ub = *(const f32x4*)(up + 4);
        f32x4 xa = *(const f32x4*)xp, xb = *(const f32x4*)(xp + 4);
        xa = xa * DN_ALPHA + g0 * ua; xb = xb * DN_ALPHA + g1 * ub;
        *(f32x4*)xp = xa; *(f32x4*)(xp + 4) = xb;
      }
    };
    gemm_tile256b(A, ld, RowId{row0}, Bt, ld, nt2 * 256, K, lds, post);
  }
  if (!skip_ctx) {
    const float* gv = mod + (size_t)2 * 6144 + gchunk * 1024;
    const int Kc = K >> 2;
    for (int it = get_bid(); it < 64; it += gridDim.x) {
      const int sp = it & 3, nt = (it >> 2) & 7, row0 = (it >> 5) * 33 * 256;
      auto epi = [&](f32x16 (&acc)[2][2], int rbase, int cbase) {
#pragma unroll
        for (int mb = 0; mb < 2; ++mb)
#pragma unroll
          for (int nb = 0; nb < 2; ++nb) { const int col = cbase + 32 * nb + c31; const float g = gv[col];
#pragma unroll
            for (int r = 0; r < 16; ++r) atomicAdd(xrow(pp, row0 + rbase + 32 * mb + crow(r, hi)) + col, g * acc[mb][nb][r]); }
      };
      gemm_tile(A + sp * Kc, ld, RowId{row0}, Bt + sp * Kc, ld, nt * 128, Kc, lds, epi);
    }
  }
}

__device__ __forceinline__ void phase_ffn_up(PP pp, int l, char* lds) {
  const bf16_t* A = (const bf16_t*)(pp->ws + OFF_HMOD);
  const bf16_t* Bt = (const bf16_t*)(pp->ws + OFF_W) + (size_t)l * W_LAYER + W_UP;
  bf16_t* A2 = (bf16_t*)(pp->ws + OFF_A2);
  const float* cw = pp->ffn_convw + (size_t)l * 3 * 5632; const float* cb = pp->ffn_convb + (size_t)l * 5632;
  const int tid = get_tid(), lane = tid & 63, c31 = lane & 31, hi = lane >> 5;
  float* ut = (float*)lds;
  const bool xmap = gridDim.x == 256; const int xq = get_bid() & 7, xj = get_bid() >> 3;
  const int n_it = xmap ? 6 * 32 : 67 * 22;
  for (int it = xmap ? xj : get_bid(); it < n_it; it += xmap ? 32 : gridDim.x) {
    int mt, nt2;
    if (xmap) { mt = 4 * (it / 11) + (xq >> 1); nt2 = 11 * (xq & 1) + it % 11; if (mt >= 67) continue; }
    else { mt = it / 22; nt2 = it % 22; }
    const int o0 = mt * 254;
    auto post = [&](int h) {
      const int nt = 2 * nt2 + h;
    {
      const int fp = tid & 31, rg = tid >> 5, f = nt * 64 + 2 * fp;
      const int cg = (fp >> 4) * 64 + ((2 * fp) & 31), cv = cg + 32;
      const f32x2 wg0 = *(const f32x2*)(cw + f), wg1 = *(const f32x2*)(cw + 5632 + f), wg2 = *(const f32x2*)(cw + 2 * 5632 + f), bg = *(const f32x2*)(cb + f);
      const f32x2 wv0 = *(const f32x2*)(cw + DFF + f), wv1 = *(const f32x2*)(cw + 5632 + DFF + f), wv2 = *(const f32x2*)(cw + 2 * 5632 + DFF + f), bv = *(const f32x2*)(cb + DFF + f);
      int i0 = rg * 16; int i1 = i0 + 16; if (i0 < 1) i0 = 1; if (i1 > 255) i1 = 255;
      if (i1 > T - (o0 - 1)) i1 = T - (o0 - 1);
      f32x2 gp = *(const f32x2*)(ut + (i0 - 1) * 128 + cg), gc = *(const f32x2*)(ut + i0 * 128 + cg);
      f32x2 vp = *(const f32x2*)(ut + (i0 - 1) * 128 + cv), vc = *(const f32x2*)(ut + i0 * 128 + cv);
      int t = o0 - 1 + i0; int j = t % SB;
      bf16_t* dst = A2 + (size_t)t * DFF + f;
      for (int i = i0; i < i1; ++i) {
        const f32x2 gn = *(const f32x2*)(ut + (i + 1) * 128 + cg), vn = *(const f32x2*)(ut + (i + 1) * 128 + cv);
        f32x2 gate = wg1 * gc + bg, val = wv1 * vc + bv;
        if (j != 0 && j != CTX) { gate += wg0 * gp; val += wv0 * vp; }
        if (j != CTX - 1 && j != SB - 1) { gate += wg2 * gn; val += wv2 * vn; }
        *(unsigned*)dst = cvtpk(silu_f(gate[0]) * val[0], silu_f(gate[1]) * val[1]);
        dst += DFF; j = (j == SB - 1) ? 0 : j + 1;
        gp = gc; gc = gn; vp = vc; vc = vn;
      }
    }
    };
    gemm_tile256b(A, KP, RowHalo{o0 - 1}, Bt, KP, nt2 * 256, DM, lds, post);
  }
}


#define XB_TMO      128
#define XB_XCNT(j)  (256  + 64 * (j))
#define XB_XSUB(j)  (1280 + 64 * (j))
#define XB_XGEN(j)  (2304 + 64 * (j))
#define XB_TOP      3328
#define XB_TOPGEN   3392
#define XCD_BAR_WORDS 3456
#define XB_SPIN_CAP (1u << 18)
#define LAS __attribute__((address_space(3)))

__device__ __forceinline__ unsigned xb_ld(unsigned* p)              { return __hip_atomic_load(p, __ATOMIC_RELAXED, __HIP_MEMORY_SCOPE_AGENT); }
__device__ __forceinline__ unsigned xb_add(unsigned* p, unsigned v) { return __hip_atomic_fetch_add(p, v, __ATOMIC_RELAXED, __HIP_MEMORY_SCOPE_AGENT); }
__device__ __forceinline__ unsigned xb_xcc_id() { return (unsigned)__builtin_amdgcn_s_getreg((3 << 11) | 20) & 0xFu; }
#define XB_SPIN(cond, bar) do { unsigned _sp = 0; while (cond) { __builtin_amdgcn_s_sleep(1); \
    if ((++_sp & 255u) == 0u) { if (xb_ld(&(bar)[XB_TMO])) break; if (_sp > XB_SPIN_CAP) { atomicAdd(&(bar)[XB_TMO], 1u); break; } } } } while (0)

struct XcdBarrier {
    unsigned* bar; unsigned x;
    volatile LAS unsigned* st;
};

__device__ __forceinline__ XcdBarrier xcd_barrier_post(unsigned* bar, volatile LAS unsigned* st) {
    XcdBarrier b; b.bar = bar; b.x = xb_xcc_id(); b.st = st;
    if (get_tid() == 0) (void)xb_add(&bar[XB_XCNT(b.x)], 1u);
    return b;
}
__device__ __forceinline__ void xcd_barrier_complete(unsigned* bar, unsigned x, unsigned& nloc, unsigned& nx) {
    const unsigned G = gridDim.x * gridDim.y * gridDim.z;
    unsigned sum, cnt, mine, sp = 0u;
    for (;;) {
        sum = 0u; cnt = 0u; mine = 0u;
#pragma unroll
        for (unsigned j = 0; j < 16; ++j) { const unsigned c = xb_ld(&bar[XB_XCNT(j)]); sum += c; cnt += (c > 0u) ? 1u : 0u; mine = (j == x) ? c : mine; }
        if (sum == G) break;
        __builtin_amdgcn_s_sleep(1);
        if ((++sp & 255u) == 0u) { if (xb_ld(&bar[XB_TMO])) break; if (sp > XB_SPIN_CAP) { atomicAdd(&bar[XB_TMO], 1u); break; } }
    }
    nloc = mine > 0u ? mine : 1u; nx = cnt > 0u ? cnt : 1u;
}

__device__ __forceinline__ void xcd_barrier(const XcdBarrier& b) {
    asm volatile("s_waitcnt vmcnt(0)" ::: "memory");
    __syncthreads();
    if (get_tid() == 0) {
        unsigned* bar = b.bar;
        __builtin_amdgcn_s_waitcnt(0);
        unsigned nloc = b.st[0], nx = b.st[1];
        if (nloc == 0u) { xcd_barrier_complete(bar, b.x, nloc, nx); b.st[0] = nloc; b.st[1] = nx; }
        const unsigned old = xb_add(&bar[XB_XSUB(b.x)], 1u);
        const unsigned gen = old / nloc;
        if (old + 1u == (gen + 1u) * nloc) {
            __builtin_amdgcn_fence(__ATOMIC_RELEASE, "agent");
            asm volatile("s_waitcnt vmcnt(0)" ::: "memory");
            const unsigned og = xb_add(&bar[XB_TOP], 1u);
            const unsigned tg = og / nx;
            if (og + 1u == (tg + 1u) * nx) xb_add(&bar[XB_TOPGEN], 1u);
            else XB_SPIN(xb_ld(&bar[XB_TOPGEN]) == tg, bar);
            __builtin_amdgcn_fence(__ATOMIC_ACQUIRE, "agent");
            xb_add(&bar[XB_XGEN(b.x)], 1u);
            asm volatile("s_waitcnt vmcnt(0)" ::: "memory");
        } else {
            XB_SPIN(xb_ld(&bar[XB_XGEN(b.x)]) == gen, bar);
            __builtin_amdgcn_fence(__ATOMIC_ACQUIRE, "agent");
            asm volatile("s_waitcnt vmcnt(0)" ::: "memory");
        }
    }
    __syncthreads();
}

constexpr size_t OFF_BAR = OFF_END;
constexpr int LDS_XB = 3 * 49152 + 1024;
__device__ __forceinline__ void grid_bar(PP pp, char* lds) {
  XcdBarrier b; b.bar = (unsigned*)(pp->ws + OFF_BAR); b.x = xb_xcc_id(); b.st = (volatile LAS unsigned*)(lds + LDS_XB);
  xcd_barrier(b);
}
__global__ void __launch_bounds__(512) fwd_megakernel(Params p_arg) {
  extern __shared__ __attribute__((aligned(16))) char lds[];
  cg::grid_group grid = cg::this_grid();
  PP pp = (PP)__builtin_amdgcn_kernarg_segment_ptr();
  { const int t0_ = get_tid(); if (t0_ < 4) ((volatile LAS unsigned*)(lds + LDS_XB))[t0_] = 0u; }
  __syncthreads();
  (void)xcd_barrier_post((unsigned*)(pp->ws + OFF_BAR), (volatile LAS unsigned*)(lds + LDS_XB));
  grid.sync();
  phase0(launder(pp), lds);
  grid_bar(launder(pp), lds);
  row_pass(launder(pp), 0, nullptr, nullptr, 0, 0, 1, true, false, NLAYER > 1);
  grid_bar(launder(pp), lds);
#pragma unroll 1
  for (int l = 0; l < NLAYER; ++l) {
    const bool last = (l == NLAYER - 1);
    const bf16_t* wl = (const bf16_t*)(pp->ws + OFF_W) + (size_t)l * W_LAYER;
    phase_win(launder(pp), l, lds);
    grid_bar(launder(pp), lds);
    phase_up2(launder(pp), l, lds);
    grid_bar(launder(pp), lds);
    phase_attn(launder(pp), l, !last, lds);
    grid_bar(launder(pp), lds);
    phase_res_gemm(launder(pp), l, (const bf16_t*)(pp->ws + OFF_Y), 1024, KP, wl + W_O, 2, last, lds);
    grid_bar(launder(pp), lds);
    row_pass(launder(pp), 1, pp->ln1_g + l * DM, pp->ln1_b + l * DM, l, 3, 4, true, last, !last);
    grid_bar(launder(pp), lds);
    phase_ffn_up(launder(pp), l, lds);
    grid_bar(launder(pp), lds);
    phase_res_gemm(launder(pp), l, (const bf16_t*)(pp->ws + OFF_A2), DFF, DFF, wl + W_DN, 5, last, lds);
    grid_bar(launder(pp), lds);
    row_pass(launder(pp), 1, pp->ln2_g + l * DM, pp->ln2_b + l * DM, l + 1, 0, 1, !last, last, l + 2 < NLAYER);
    if (!last) grid_bar(launder(pp), lds);
  }
}

extern "C" void kernel_launch(void* const* d_in, const int* in_sizes, int n_in, void* d_out, int out_size, void* d_ws, size_t ws_size, hipStream_t stream) {
  static int grid_blocks = 0;
  if (!grid_blocks) {
    int dev = 0, cus = 0, per_cu = 0;
    hipGetDevice(&dev);
    hipDeviceGetAttribute(&cus, hipDeviceAttributeMultiprocessorCount, dev);
    hipFuncSetAttribute((const void*)fwd_megakernel, hipFuncAttributeMaxDynamicSharedMemorySize, LDS_BYTES);
    hipOccupancyMaxActiveBlocksPerMultiprocessor(&per_cu, fwd_megakernel, 512, LDS_BYTES);
    if (per_cu < 1) { fprintf(stderr, "occupancy query returned %d\n", per_cu); per_cu = 1; }
    if (per_cu > 1) per_cu = 1;
    grid_blocks = cus * per_cu;
  }
  Params p{};
  const float** f = (const float**)&p;
  for (int i = 0; i < 29; ++i) f[i] = (const float*)d_in[i];
  p.out = (float*)d_out; p.ws = (char*)d_ws;
  (void)hipMemsetAsync((char*)d_ws + OFF_BAR, 0, XCD_BAR_WORDS * sizeof(unsigned), stream);
  void* args[] = {&p};
  hipError_t e = hipLaunchCooperativeKernel((void*)fwd_megakernel, dim3(grid_blocks), dim3(512), args, LDS_BYTES, stream);
  if (e != hipSuccess) fprintf(stderr, "cooperative launch failed: %s (grid %d)\n", hipGetErrorString(e), grid_blocks);
}
```
